# Optimizing an MI355X kernel written in HIP

```python
import jax, jax.numpy as jnp
from jax import lax
import numpy as np

D_MODEL = 1024
BATCH = 4
SEQ = 4096
DEPTH = 2

GRID_W = 64
CTX_LEN = 256

HEAD_DIM = 64
ROPE_BASE = 10000.0
NORM_EPS = 1e-6
GN_EPS = 1e-5
NEG_INF = -1e30

NA_HEADS = D_MODEL // HEAD_DIM // 2
NA_ROWS = 8
NA_COLS = 16
RET_HEADS = D_MODEL // HEAD_DIM // 2
RET_CHUNK = 128
W_A = NA_HEADS * HEAD_DIM
W_B = RET_HEADS * HEAD_DIM
AB_SPLITS = (W_A, 2 * W_A, 3 * W_A, 3 * W_A + W_B, 3 * W_A + 2 * W_B, 3 * W_A + 3 * W_B)
AB_IN = 3 * W_A + 4 * W_B
AB_OUT = W_A + W_B

SWA_Q_HEADS = D_MODEL // HEAD_DIM
SWA_KV_HEADS = 4
SWA_WINDOW = 128
SWA_Q_W = SWA_Q_HEADS * HEAD_DIM
SWA_KV_W = SWA_KV_HEADS * HEAD_DIM
SWA_IN = SWA_Q_W + 2 * SWA_KV_W
SWA_OUT = SWA_Q_W

PEER_HEADS = 8
PEER_KEYS = 128
PEER_EXPERTS = PEER_KEYS * PEER_KEYS
PEER_TOPK = 16
PEER_QDIM = 256
PEER_BLOCK = 128

kernel_name = 'hybrid_na_retention_swa_peer'


def rms_norm(x, g):
    xf = x.astype(jnp.float32)
    y = xf * lax.rsqrt(jnp.mean(xf * xf, axis=-1, keepdims=True) + NORM_EPS)
    return (y * g.astype(jnp.float32)).astype(x.dtype)


def modulate(x, gain, shift, scale):
    return rms_norm(x, gain) * (1.0 + scale) + shift


def adaln(cond, w, b):
    return jnp.split(jax.nn.silu(cond) @ w + b, 6, axis=-1)


def axial_rope(n_tokens, head_dim):
    t = jnp.arange(n_tokens)
    row = (t // GRID_W).astype(jnp.float32)
    col = (t % GRID_W).astype(jnp.float32)
    n_freq = head_dim // 4
    inv_freq = jnp.power(ROPE_BASE, -jnp.arange(n_freq, dtype=jnp.float32) / n_freq)
    ang = jnp.concatenate([row[:, None] * inv_freq, col[:, None] * inv_freq], axis=-1)
    return jnp.cos(ang), jnp.sin(ang)


def apply_rope(x, cos, sin):
    half = x.shape[-1] // 2
    x1, x2 = x[..., :half], x[..., half:]
    c = cos[None, :, None, :].astype(x.dtype)
    s = sin[None, :, None, :].astype(x.dtype)
    return jnp.concatenate([x1 * c - x2 * s, x1 * s + x2 * c], axis=-1)


def context_attention(q, k, v, sink=None):
    B, L, Hq, d = q.shape
    Hkv = k.shape[2]
    G = Hq // Hkv
    s = jnp.einsum('bqkgd,blkd->bkgql', q.reshape(B, L, Hkv, G, d), k).astype(jnp.float32)
    if sink is not None:
        sink_col = jnp.broadcast_to(sink.reshape(Hkv, G, 1, 1).astype(jnp.float32), (B, Hkv, G, L, 1))
        s = jnp.concatenate([s, sink_col], axis=-1)
    p = jax.nn.softmax(s, axis=-1)[..., :L].astype(v.dtype)
    return jnp.einsum('bkgql,blkd->bqkgd', p, v).reshape(B, L, Hq, d)


def neighbourhood_attention(q, k, v, k_ctx, v_ctx, rpb):
    B, S, H, d = q.shape
    rows = S // GRID_W
    kr = min(NA_ROWS, rows)
    n_keys = kr * NA_COLS
    r = jnp.arange(rows)
    col = jnp.arange(GRID_W)
    key_rows = jnp.clip(r - kr // 2, 0, rows - kr)[:, None] + jnp.arange(kr)
    key_cols = jnp.clip(col - NA_COLS // 2, 0, GRID_W - NA_COLS)[:, None] + jnp.arange(NA_COLS)
    key_tok = (key_rows[:, None, :, None] * GRID_W + key_cols[None, :, None, :]).reshape(rows, GRID_W, n_keys)
    dr = key_rows - r[:, None] + (NA_ROWS - 1)
    dc = key_cols - col[:, None] + (NA_COLS - 1)
    bias = rpb[:, dr[:, None, :, None], dc[None, :, None, :]]
    bias = bias.reshape(H, rows, GRID_W, n_keys).transpose(1, 0, 2, 3)
    q_rows = q.reshape(B, rows, GRID_W, H, d).transpose(1, 0, 2, 3, 4)

    def one_row(args):
        q_r, tok_r, bias_r = args
        k_w = k[:, tok_r]
        v_w = v[:, tok_r]
        s_loc = jnp.einsum('bwhd,bwkhd->bhwk', q_r, k_w).astype(jnp.float32) + bias_r.astype(jnp.float32)
        s_ctx = jnp.einsum('bwhd,blhd->bhwl', q_r, k_ctx).astype(jnp.float32)
        p = jax.nn.softmax(jnp.concatenate([s_loc, s_ctx], axis=-1), axis=-1).astype(v.dtype)
        return (jnp.einsum('bhwk,bwkhd->bwhd', p[..., :n_keys], v_w)
                + jnp.einsum('bhwl,blhd->bwhd', p[..., n_keys:], v_ctx))

    out = lax.map(one_row, (q_rows, key_tok, bias))
    return out.transpose(1, 0, 2, 3, 4).reshape(B, S, H, d)


def retention_scan(q, k, v, log_gamma, state0):
    B, T, H, dk = q.shape
    dv = v.shape[-1]
    C = RET_CHUNK
    n = T // C
    to_chunks = lambda t: t.reshape(B, n, C, H, t.shape[-1]).transpose(1, 0, 3, 2, 4)
    i = jnp.arange(C, dtype=jnp.float32)
    diff = i[:, None] - i[None, :]
    lg = log_gamma[:, None, None]
    decay_intra = jnp.where(diff >= 0, jnp.exp(lg * jnp.maximum(diff, 0.0)), 0.0)
    decay_q = jnp.exp(log_gamma[:, None] * (i + 1.0))[None, :, :, None]
    decay_k = jnp.exp(log_gamma[:, None] * (C - 1.0 - i))[None, :, :, None]
    decay_chunk = jnp.exp(log_gamma * C)[None, :, None, None]

    def step(S, xs):
        qb, kb, vb = xs
        intra = jnp.einsum('bhid,bhjd->bhij', qb, kb) * decay_intra
        o = jnp.einsum('bhij,bhjv->bhiv', intra, vb) + jnp.einsum('bhid,bhdv->bhiv', qb * decay_q, S)
        S = S * decay_chunk + jnp.einsum('bhjd,bhjv->bhdv', kb * decay_k, vb)
        return S, o

    S_T, o = lax.scan(step, state0, (to_chunks(q), to_chunks(k), to_chunks(v)))
    return o.transpose(1, 0, 3, 2, 4).reshape(B, T, H, dv), S_T


def bidirectional_retention(q, k, v, log_gamma, state_fwd0, state_bwd0):
    o_f, s_f = retention_scan(q, k, v, log_gamma[0], state_fwd0)
    o_b, s_b = retention_scan(q[:, ::-1], k[:, ::-1], v[:, ::-1], log_gamma[1], state_bwd0)
    diag = jnp.einsum('bthd,bthd->bth', q, k).astype(jnp.float32)[..., None] * v.astype(jnp.float32)
    return o_f + o_b[:, ::-1] - diag, s_f, s_b


def retention_output(o, g):
    mu = jnp.mean(o, axis=-1, keepdims=True)
    oc = o - mu
    on = oc * lax.rsqrt(jnp.mean(oc * oc, axis=-1, keepdims=True) + GN_EPS)
    B, T = o.shape[0], o.shape[1]
    return (on.reshape(B, T, -1) * jax.nn.silu(g.astype(jnp.float32))).astype(g.dtype)


def mixer_na_retention(hx, hc, w_in, w_out, q_norm, k_norm, rpb, ret_log_decay, cos, sin, need_ctx):
    B, S, _ = hx.shape
    L = hc.shape[1]
    scale = HEAD_DIM ** -0.5

    def split(p, T):
        aq, ak, av, bq, bk, bv, bg = jnp.split(p, AB_SPLITS, axis=-1)
        heads = lambda t: t.reshape(B, T, -1, HEAD_DIM)
        return heads(aq), heads(ak), heads(av), heads(bq), heads(bk), heads(bv), bg

    aqx, akx, avx, bqx, bkx, bvx, bgx = split(hx @ w_in, S)
    aqc, akc, avc, bqc, bkc, bvc, bgc = split(hc @ w_in, L)

    aqx = rms_norm(aqx, q_norm) * scale
    akx = rms_norm(akx, k_norm)
    aqc = rms_norm(aqc, q_norm) * scale
    akc = rms_norm(akc, k_norm)
    oa_x = neighbourhood_attention(aqx, akx, avx, akc, avc, rpb)

    log_gamma = -jnp.exp(ret_log_decay.astype(jnp.float32))
    zeros = jnp.zeros((B, RET_HEADS, HEAD_DIM, HEAD_DIM), jnp.float32)
    ob_c, st_f, st_b = bidirectional_retention(bqc * scale, bkc, bvc, log_gamma, zeros, zeros)
    ob_x, _, _ = bidirectional_retention(apply_rope(bqx, cos, sin) * scale, apply_rope(bkx, cos, sin),
                                         bvx, log_gamma, st_f, st_b)

    yx = jnp.concatenate([oa_x.reshape(B, S, -1), retention_output(ob_x, bgx)], axis=-1) @ w_out
    if not need_ctx:
        return yx, None
    oa_c = context_attention(aqc, akc, avc)
    yc = jnp.concatenate([oa_c.reshape(B, L, -1), retention_output(ob_c, bgc)], axis=-1) @ w_out
    return yx, yc


def windowed_gqa(q, k, v, k_ctx, v_ctx, sink):
    B, S, Hq, d = q.shape
    Hkv = k.shape[2]
    G = Hq // Hkv
    L = k_ctx.shape[1]
    blk = SWA_WINDOW
    n = S // blk
    n_loc = 3 * blk

    def key_blocks(t):
        tp = jnp.pad(t, ((0, 0), (blk, blk), (0, 0), (0, 0))).reshape(B, n + 2, blk, Hkv, d)
        tb = jnp.concatenate([tp[:, :-2], tp[:, 1:-1], tp[:, 2:]], axis=2)
        return tb.transpose(1, 0, 2, 3, 4)

    kb, vb = key_blocks(k), key_blocks(v)
    qb = q.reshape(B, n, blk, Hkv, G, d).transpose(1, 0, 2, 3, 4, 5)
    i = jnp.arange(n)
    q_pos = i[:, None] * blk + jnp.arange(blk)[None, :]
    key_pos = i[:, None] * blk - blk + jnp.arange(n_loc)[None, :]
    mask = ((jnp.abs(q_pos[:, :, None] - key_pos[:, None, :]) <= SWA_WINDOW)
            & (key_pos[:, None, :] >= 0) & (key_pos[:, None, :] < S))
    sink_col = jnp.broadcast_to(sink.reshape(Hkv, G, 1, 1).astype(jnp.float32), (B, Hkv, G, blk, 1))

    def one_block(args):
        q_i, k_i, v_i, m_i = args
        s_loc = jnp.where(m_i, jnp.einsum('bqkgd,bskd->bkgqs', q_i, k_i).astype(jnp.float32), NEG_INF)
        s_ctx = jnp.einsum('bqkgd,blkd->bkgql', q_i, k_ctx).astype(jnp.float32)
        p = jax.nn.softmax(jnp.concatenate([s_loc, s_ctx, sink_col], axis=-1), axis=-1).astype(v.dtype)
        return (jnp.einsum('bkgqs,bskd->bqkgd', p[..., :n_loc], v_i)
                + jnp.einsum('bkgql,blkd->bqkgd', p[..., n_loc:n_loc + L], v_ctx))

    out = lax.map(one_block, (qb, kb, vb, mask))
    return out.transpose(1, 0, 2, 3, 4, 5).reshape(B, S, Hq, d)


def mixer_window_gqa(hx, hc, w_in, w_out, q_norm, k_norm, sink, cos, sin, need_ctx):
    B, S, _ = hx.shape
    L = hc.shape[1]
    scale = HEAD_DIM ** -0.5

    def split(p, T):
        q, k, v = jnp.split(p, (SWA_Q_W, SWA_Q_W + SWA_KV_W), axis=-1)
        return (q.reshape(B, T, SWA_Q_HEADS, HEAD_DIM), k.reshape(B, T, SWA_KV_HEADS, HEAD_DIM),
                v.reshape(B, T, SWA_KV_HEADS, HEAD_DIM))

    qx, kx, vx = split(hx @ w_in, S)
    qc, kc, vc = split(hc @ w_in, L)
    qx = apply_rope(rms_norm(qx, q_norm), cos, sin) * scale
    kx = apply_rope(rms_norm(kx, k_norm), cos, sin)
    qc = rms_norm(qc, q_norm) * scale
    kc = rms_norm(kc, k_norm)
    yx = windowed_gqa(qx, kx, vx, kc, vc, sink).reshape(B, S, -1) @ w_out
    if not need_ctx:
        return yx, None
    yc = context_attention(qc, kc, vc, sink).reshape(B, L, -1) @ w_out
    return yx, yc


def peer(h, w_q, sub_keys, u, v):
    B, T, D = h.shape
    q = (h @ w_q).reshape(B, T, PEER_HEADS, 2, PEER_QDIM // 2)
    s = jnp.einsum('bthpd,hpnd->bthpn', q, sub_keys).astype(jnp.float32)
    s1, i1 = lax.top_k(s[..., 0, :], PEER_TOPK)
    s2, i2 = lax.top_k(s[..., 1, :], PEER_TOPK)
    cand_s = (s1[..., :, None] + s2[..., None, :]).reshape(B, T, PEER_HEADS, PEER_TOPK * PEER_TOPK)
    cand_i = (i1[..., :, None] * PEER_KEYS + i2[..., None, :]).reshape(B, T, PEER_HEADS, PEER_TOPK * PEER_TOPK)
    top_s, pos = lax.top_k(cand_s, PEER_TOPK)
    idx = jnp.take_along_axis(cand_i, pos, axis=-1)
    gate = jax.nn.softmax(top_s, axis=-1)
    n_e = PEER_HEADS * PEER_TOPK
    nb = (B * T) // PEER_BLOCK
    hb = h.reshape(nb, PEER_BLOCK, D)
    ib = idx.reshape(nb, PEER_BLOCK, n_e)
    gb = gate.reshape(nb, PEER_BLOCK, n_e)

    def one_block(args):
        h_i, i_i, g_i = args
        act = jax.nn.gelu(jnp.einsum('td,ted->te', h_i, u[i_i]), approximate=False)
        return jnp.einsum('te,ted->td', (g_i * act).astype(h.dtype), v[i_i])

    return lax.map(one_block, (hb, ib, gb)).reshape(B, T, D)


def setup_inputs(seed: int = 0) -> dict:
    key = jax.random.key(seed)
    ks = jax.random.split(key, 24)
    f32 = jnp.float32
    n_even = (DEPTH + 1) // 2
    n_odd = DEPTH // 2
    nrm = lambda k, shape, s: jax.random.normal(k, shape, f32) * s
    base_decay = jnp.log(-jnp.log1p(-jnp.power(2.0, -5.0 - jnp.arange(RET_HEADS, dtype=f32))))
    return {
        'x': nrm(ks[0], (BATCH, SEQ, D_MODEL), 1.0),
        'c': nrm(ks[1], (BATCH, D_MODEL), 1.0),
        'ctx': nrm(ks[2], (BATCH, CTX_LEN, D_MODEL), 1.0),
        'c_ctx': nrm(ks[3], (D_MODEL,), 1.0),
        'mod_w': nrm(ks[4], (DEPTH, D_MODEL, 6 * D_MODEL), D_MODEL ** -0.5),
        'mod_b': nrm(ks[5], (DEPTH, 6 * D_MODEL), 0.02),
        'norm1_g': 1.0 + nrm(ks[6], (DEPTH, D_MODEL), 0.02),
        'norm2_g': 1.0 + nrm(ks[7], (DEPTH, D_MODEL), 0.02),
        'ab_w_in': nrm(ks[8], (n_even, D_MODEL, AB_IN), D_MODEL ** -0.5),
        'ab_w_out': nrm(ks[9], (n_even, AB_OUT, D_MODEL), AB_OUT ** -0.5),
        'na_q_norm': 1.0 + nrm(ks[10], (n_even, HEAD_DIM), 0.02),
        'na_k_norm': 1.0 + nrm(ks[11], (n_even, HEAD_DIM), 0.02),
        'na_rpb': nrm(ks[12], (n_even, NA_HEADS, 2 * NA_ROWS - 1, 2 * NA_COLS - 1), 0.1),
        'ret_log_decay': base_decay[None, None, :] + nrm(ks[13], (n_even, 2, RET_HEADS), 0.05),
        'swa_w_in': nrm(ks[14], (n_odd, D_MODEL, SWA_IN), D_MODEL ** -0.5),
        'swa_w_out': nrm(ks[15], (n_odd, SWA_OUT, D_MODEL), SWA_OUT ** -0.5),
        'swa_q_norm': 1.0 + nrm(ks[16], (n_odd, HEAD_DIM), 0.02),
        'swa_k_norm': 1.0 + nrm(ks[17], (n_odd, HEAD_DIM), 0.02),
        'swa_sink': nrm(ks[18], (n_odd, SWA_Q_HEADS), 0.5),
        'peer_w_q': nrm(ks[19], (DEPTH, D_MODEL, PEER_HEADS * PEER_QDIM), D_MODEL ** -0.5),
        'peer_sub_keys': nrm(ks[20], (DEPTH, PEER_HEADS, 2, PEER_KEYS, PEER_QDIM // 2), (PEER_QDIM // 2) ** -0.5),
        'peer_u': nrm(ks[21], (DEPTH, PEER_EXPERTS, D_MODEL), D_MODEL ** -0.5),
        'peer_v': nrm(ks[22], (DEPTH, PEER_EXPERTS, D_MODEL), 0.5),
    }


def reference(x, c, ctx, c_ctx, mod_w, mod_b, norm1_g, norm2_g, ab_w_in, ab_w_out, na_q_norm, na_k_norm,
              na_rpb, ret_log_decay, swa_w_in, swa_w_out, swa_q_norm, swa_k_norm, swa_sink,
              peer_w_q, peer_sub_keys, peer_u, peer_v):
    S = x.shape[1]
    cos, sin = axial_rope(S, HEAD_DIM)
    x_lat, x_ctx = x, ctx
    for l in range(DEPTH):
        need_ctx = l < DEPTH - 1
        sh1, sc1, g1, sh2, sc2, g2 = [m[:, None, :] for m in adaln(c, mod_w[l], mod_b[l])]
        ch1, cs1, cg1, ch2, cs2, cg2 = adaln(c_ctx, mod_w[l], mod_b[l])
        hx = modulate(x_lat, norm1_g[l], sh1, sc1)
        hc = modulate(x_ctx, norm1_g[l], ch1, cs1)
        j = l // 2
        if l % 2 == 0:
            yx, yc = mixer_na_retention(hx, hc, ab_w_in[j], ab_w_out[j], na_q_norm[j], na_k_norm[j],
                                        na_rpb[j], ret_log_decay[j], cos, sin, need_ctx)
        else:
            yx, yc = mixer_window_gqa(hx, hc, swa_w_in[j], swa_w_out[j], swa_q_norm[j], swa_k_norm[j],
                                      swa_sink[j], cos, sin, need_ctx)
        x_lat = x_lat + g1 * yx
        hx2 = modulate(x_lat, norm2_g[l], sh2, sc2)
        x_lat = x_lat + g2 * peer(hx2, peer_w_q[l], peer_sub_keys[l], peer_u[l], peer_v[l])
        if need_ctx:
            x_ctx = x_ctx + cg1 * yc
            hc2 = modulate(x_ctx, norm2_g[l], ch2, cs2)
            x_ctx = x_ctx + cg2 * peer(hc2, peer_w_q[l], peer_sub_keys[l], peer_u[l], peer_v[l])
    return x_lat
```

```cpp
#define MK_N_LAUNCHES 21
#include <hip/hip_runtime.h>
#include <cstdio>
#include <cstdint>
namespace pg8 {
#define PG8_LAS __attribute__((address_space(3)))
typedef unsigned short bf16_t;
typedef short bf16x8 __attribute__((ext_vector_type(8)));
typedef float f32x4 __attribute__((ext_vector_type(4)));
typedef unsigned u32x4 __attribute__((ext_vector_type(4)));
constexpr int BM = 256, BK = 64, HALF = 128, HTB = HALF * BK * 2  , STAGE_BYTES = 8 * HTB, NXCD = 8, WGM = 8;

__host__ __device__ __forceinline__ int lds_byte(int r, int c) { const int st = (r >> 4) * 2 + (c >> 5), rr = r & 15, cc = c & 31, ob = rr * 64 + cc * 2; return st * 1024 + (ob ^ (((ob >> 9) & 1) << 5)); }
__host__ __device__ __forceinline__ void stage_rc(int b, int& R, int& C) { const int st = b / 1024, sb = b % 1024, swz = sb ^ (((sb >> 9) & 1) << 5); R = (st >> 1) * 16 + swz / 64; C = (st & 1) * 32 + (swz % 64) / 2; }
__host__ __device__ __forceinline__ int perm32(int rho) { const int n = rho >> 4, i = rho & 15; return 8 * (i >> 2) + 4 * n + (i & 3); }

struct Unit { int pm, pn; };
struct Gemm { const bf16_t* A; const bf16_t* Bt; int M, N, K; };

struct StaticOrder {
    int nM, nN, nwg, G, c;
    __host__ __device__ void init(int M, int N, int G_, int c_) { nM = M / BM; nN = N / BM; nwg = nM * nN; G = G_; c = c_; }
    __host__ __device__ bool next(int i, Unit& u) const {
        const long L = (long)i * G + c; if (L >= nwg) return false;
        int wgid = (int)L; { const int q = nwg / NXCD, r = nwg % NXCD, xcd = wgid % NXCD, off = wgid / NXCD; wgid = (xcd < r ? xcd * (q + 1) : r * (q + 1) + (xcd - r) * q) + off; }
        const int nig = WGM * nN, gid = wgid / nig, fm = gid * WGM, gsz = (nM - fm) < WGM ? (nM - fm) : WGM;
        u.pm = fm + ((wgid % nig) % gsz); u.pn = (wgid % nig) / gsz; return true;
    }
    __device__ __forceinline__ void a_ready(const Unit&) const {}
    __device__ __forceinline__ void done(const Unit&) const {}
};

__device__ __forceinline__ unsigned cvt_pk_bf16(float lo, float hi) { unsigned r; asm volatile("v_cvt_pk_bf16_f32 %0, %1, %2" : "=v"(r) : "v"(lo), "v"(hi)); return r; }
typedef float f32x2 __attribute__((ext_vector_type(2)));
__device__ __forceinline__ f32x2 gelu_pk(f32x2 v) {
    const f32x2 av = __builtin_elementwise_abs(v), d = av * 0.2316418882f + 1.0f;
    f32x2 t; t.x = __builtin_amdgcn_rcpf(d.x); t.y = __builtin_amdgcn_rcpf(d.y);
    f32x2 q = t * 0.5307027145f + (-0.7265760135f); q = q * t + 0.7107068705f; q = q * t + (-0.142248368f); q = q * t + 0.127414796f; q = q * t;
    const f32x2 s = (v * v) * (-0.72134752044f);
    f32x2 e; e.x = __builtin_amdgcn_exp2f(s.x); e.y = __builtin_amdgcn_exp2f(s.y);
    const f32x2 m = v * (q * e), r = v - m;
    f32x2 o; o.x = v.x < 0.f ? m.x : r.x; o.y = v.y < 0.f ? m.y : r.y; return o;
}

template <int ACT  > struct EpiBf16 {
    static constexpr bool PERM = true, AFTER_DRAIN = false; static_assert(ACT == 0 || ACT == 1, "EpiBf16: ACT is 0 (none) or 1 (gelu_pk)");
    bf16_t* O; int ldc; const float* bias; int split_cols; size_t split_stride; float scale0;
    __device__ __forceinline__ void operator()(const f32x4 (&acc)[2][2][4][2], const Unit& u, int wr, int wc, int fr, int fq) const {
        const int row0 = u.pm * BM + wr * 64 + fr; int colt = u.pn * BM; bf16_t* base = O;
        float sc = 1.f; if (split_cols) { const int t = colt / split_cols; base += (size_t)t * split_stride; colt -= t * split_cols; if (t == 0) sc = scale0; }
        const int col0 = colt + wc * 32 + 8 * fq, bcol0 = u.pn * BM + wc * 32 + 8 * fq;
        f32x4 bv[2][2];
#pragma unroll
        for (int bj = 0; bj < 2; ++bj)
#pragma unroll
            for (int n = 0; n < 2; ++n) bv[bj][n] = bias ? *(const f32x4*)(bias + bcol0 + bj * HALF + 4 * n) : (f32x4){0.f, 0.f, 0.f, 0.f};
#pragma unroll
        for (int ai = 0; ai < 2; ++ai)
#pragma unroll
            for (int m = 0; m < 4; ++m) { bf16_t* rowp = base + (size_t)(row0 + ai * HALF + m * 16) * ldc + col0;
#pragma unroll
                for (int bj = 0; bj < 2; ++bj) { f32x4 v0 = acc[ai][bj][m][0] + bv[bj][0], v1 = acc[ai][bj][m][1] + bv[bj][1];
                    if (ACT == 1) { f32x2 a = gelu_pk((f32x2){v0[0], v0[1]}), b = gelu_pk((f32x2){v0[2], v0[3]}), c = gelu_pk((f32x2){v1[0], v1[1]}), d = gelu_pk((f32x2){v1[2], v1[3]});
                        v0 = (f32x4){a.x, a.y, b.x, b.y}; v1 = (f32x4){c.x, c.y, d.x, d.y}; }
                    v0 = v0 * sc; v1 = v1 * sc; u32x4 w; w.x = cvt_pk_bf16(v0[0], v0[1]); w.y = cvt_pk_bf16(v0[2], v0[3]); w.z = cvt_pk_bf16(v1[0], v1[1]); w.w = cvt_pk_bf16(v1[2], v1[3]);
                    *(u32x4*)(rowp + bj * HALF) = w; } }
    }
};

struct EpiRes {
    static constexpr bool PERM = false, AFTER_DRAIN = false;
    const float* base_lat; const float* base_ctx; float* out; const float* gate;
    __device__ __forceinline__ void operator()(const f32x4 (&acc)[2][2][4][2], const Unit& u, int wr, int wc, int fr, int fq) const {
        const int rowt = u.pm * BM;
        const int cond = rowt < 16384 ? (rowt >> 12) : 4;
        const float* g = gate + (size_t)cond * 6144;
        const int col0 = u.pn * BM + wc * 32 + 4 * fq;
        f32x4 gv[2][2];
#pragma unroll
        for (int bj = 0; bj < 2; ++bj)
#pragma unroll
            for (int n = 0; n < 2; ++n) gv[bj][n] = *(const f32x4*)(g + col0 + bj * HALF + n * 16);
#pragma unroll
        for (int ai = 0; ai < 2; ++ai)
#pragma unroll
            for (int m = 0; m < 4; ++m) {
                const int r = rowt + ai * HALF + wr * 64 + m * 16 + fr;
                const float* bp = r < 16384 ? base_lat + (size_t)r * 1024 : base_ctx + (size_t)(r - 16384) * 1024;
                float* op = out + (size_t)r * 1024;
#pragma unroll
                for (int bj = 0; bj < 2; ++bj)
#pragma unroll
                    for (int n = 0; n < 2; ++n) {
                        const int off = col0 + bj * HALF + n * 16;
                        const f32x4 bs = *(const f32x4*)(bp + off);
                        *(f32x4*)(op + off) = bs + gv[bj][n] * acc[ai][bj][m][n];
                    }
            }
    }
};

template <class Epi, class Sched, bool ALIGN_EPI = false, bool SP2 = false>
__device__ __forceinline__ void gemm_phase(PG8_LAS unsigned char* lds, const Gemm g, const Sched& S, const Epi& E) {
    const int tid = threadIdx.x, wid = __builtin_amdgcn_readfirstlane(tid >> 6), lane = tid & 63, wr = wid >> 2, wc = wid & 3, fr = lane & 15, fq = lane >> 4;
    const int K = g.K, nt = K / BK;
    unsigned voffA[2], voffB[2];
#pragma unroll
    for (int i = 0; i < 2; ++i) { int R, C; stage_rc(tid * 16 + i * 8192, R, C); const int Rb = Epi::PERM ? ((R & ~31) + perm32(R & 31)) : R;
        voffA[i] = (unsigned)(R * K + C) * 2u; voffB[i] = (unsigned)(Rb * K + C) * 2u; }
    const size_t kstep = (size_t)(BK * 2);
    const size_t hstep = (size_t)HALF * K * 2;
    const size_t tstep = 2 * hstep;
    const unsigned ldsw = (unsigned)wid * 1024u;
    const int aoff = lds_byte(wr * 64 + fr, fq * 8), boff = lds_byte(wc * 32 + fr, fq * 8);
#define PG8_SA(b, h) (((b) * 2 + (h)) * HTB)
#define PG8_SB(b, h) ((4 + (b) * 2 + (h)) * HTB)
#define PG8_STAGE(bufoff, gbase, voff) do { _Pragma("unroll") for (int _i = 0; _i < 2; ++_i) \
        __builtin_amdgcn_global_load_lds((const unsigned*)((const char*)(gbase) + (voff)[_i]), (PG8_LAS unsigned*)(lds + (bufoff) + ldsw + _i * 8192), 16, 0, 0); } while (0)
#define PG8_LDA(dst, b, h) do { _Pragma("unroll") for (int m = 0; m < 4; ++m) _Pragma("unroll") for (int k = 0; k < 2; ++k) dst[m][k] = *(const PG8_LAS bf16x8*)(lds + PG8_SA(b, h) + aoff + m * 2048 + k * 1024); } while (0)
#define PG8_LDB(dst, b, h) do { _Pragma("unroll") for (int n = 0; n < 2; ++n) _Pragma("unroll") for (int k = 0; k < 2; ++k) dst[n][k] = *(const PG8_LAS bf16x8*)(lds + PG8_SB(b, h) + boff + n * 2048 + k * 1024); } while (0)
#define PG8_MMA(ai, bj, At, Bt) do { __builtin_amdgcn_s_setprio(1); _Pragma("unroll") for (int m = 0; m < 4; ++m) _Pragma("unroll") for (int n = 0; n < 2; ++n) _Pragma("unroll") for (int k = 0; k < 2; ++k) \
        acc[ai][bj][m][n] = __builtin_amdgcn_mfma_f32_16x16x32_bf16(Bt[n][k], At[m][k], acc[ai][bj][m][n], 0, 0, 0); __builtin_amdgcn_s_setprio(0); } while (0)
#define PG8_WAIT_V(n) asm volatile("s_waitcnt vmcnt(" #n ")" ::: "memory")
#define PG8_WAIT_L(n) asm volatile("s_waitcnt lgkmcnt(" #n ")" ::: "memory")
#define PG8_BAR __builtin_amdgcn_s_barrier()
#define PG8_SCHED __builtin_amdgcn_sched_barrier(0)
    Unit cur, nxt; int ui = 0;
    if (!S.next(0, cur)) return;
    f32x4 acc[2][2][4][2];
#pragma unroll
    for (int a = 0; a < 2; ++a)
#pragma unroll
        for (int b = 0; b < 2; ++b)
#pragma unroll
            for (int m = 0; m < 4; ++m)
#pragma unroll
                for (int n = 0; n < 2; ++n) acc[a][b][m][n] = (f32x4){0.f, 0.f, 0.f, 0.f};
    bf16x8 At[4][2], B0[2][2], B1[2][2];
    const char* cA = (const char*)g.A + (size_t)cur.pm * tstep; const char* cB = (const char*)g.Bt + (size_t)cur.pn * tstep;
    S.a_ready(cur);
    if constexpr (SP2) {
        PG8_STAGE(PG8_SB(0, 0), cB, voffB); PG8_STAGE(PG8_SB(0, 1), cB + hstep, voffB); PG8_STAGE(PG8_SA(0, 0), cA, voffA); PG8_STAGE(PG8_SA(0, 1), cA + hstep, voffA);
        if (wr == 1) PG8_BAR;
        PG8_WAIT_V(2); PG8_BAR;
        PG8_STAGE(PG8_SB(1, 0), cB + kstep, voffB); PG8_STAGE(PG8_SA(1, 0), cA + kstep, voffA); PG8_STAGE(PG8_SB(1, 1), cB + hstep + kstep, voffB);
        PG8_WAIT_V(6); PG8_BAR;
    } else {
        PG8_STAGE(PG8_SB(0, 0), cB, voffB); PG8_STAGE(PG8_SA(0, 0), cA, voffA); PG8_STAGE(PG8_SB(0, 1), cB + hstep, voffB); PG8_STAGE(PG8_SA(0, 1), cA + hstep, voffA);
        if (wr == 1) PG8_BAR;
        PG8_WAIT_V(4); PG8_BAR;
        PG8_STAGE(PG8_SB(1, 0), cB + kstep, voffB); PG8_STAGE(PG8_SA(1, 0), cA + kstep, voffA); PG8_STAGE(PG8_SB(1, 1), cB + hstep + kstep, voffB);
        PG8_WAIT_V(6); PG8_BAR;
    }
    for (;;) {
        const bool has_next = S.next(ui + 1, nxt);
        const char* nA = has_next ? (const char*)g.A + (size_t)nxt.pm * tstep : cA; const char* nB = has_next ? (const char*)g.Bt + (size_t)nxt.pn * tstep : cB;
        for (int t = 0; t < nt; t += 2) {
            const bool last = (t == nt - 2);
            const char* a1 = cA + (size_t)(t + 1) * kstep;
            const char* a2 = last ? nA : cA + (size_t)(t + 2) * kstep; const char* b2 = last ? nB : cB + (size_t)(t + 2) * kstep;
            const char* a3 = a2 + kstep; const char* b3 = b2 + kstep;
            if (last && has_next) S.a_ready(nxt);
            if constexpr (SP2) {
            PG8_LDB(B0, 0, 0); PG8_LDB(B1, 0, 1); PG8_SCHED; PG8_LDA(At, 0, 0); PG8_STAGE(PG8_SA(1, 1), a1 + hstep, voffA);
            PG8_WAIT_V(8); PG8_WAIT_L(0); PG8_BAR; PG8_MMA(0, 0, At, B0); PG8_MMA(0, 1, At, B1); PG8_BAR; PG8_SCHED;
            PG8_LDA(At, 0, 1); PG8_STAGE(PG8_SB(0, 0), b2, voffB); PG8_STAGE(PG8_SB(0, 1), b2 + hstep, voffB); PG8_STAGE(PG8_SA(0, 0), a2, voffA);
            PG8_WAIT_V(8); PG8_WAIT_L(0); PG8_BAR; PG8_MMA(1, 0, At, B0); PG8_MMA(1, 1, At, B1); PG8_BAR; PG8_SCHED;
            PG8_LDB(B0, 1, 0); PG8_LDB(B1, 1, 1); PG8_SCHED; PG8_LDA(At, 1, 0); PG8_STAGE(PG8_SA(0, 1), a2 + hstep, voffA);
            PG8_WAIT_V(8); PG8_WAIT_L(0); PG8_BAR; PG8_MMA(0, 0, At, B0); PG8_MMA(0, 1, At, B1); PG8_BAR; PG8_SCHED;
            PG8_LDA(At, 1, 1); PG8_STAGE(PG8_SB(1, 0), b3, voffB); PG8_STAGE(PG8_SB(1, 1), b3 + hstep, voffB); PG8_STAGE(PG8_SA(1, 0), a3, voffA);
            PG8_WAIT_V(8); PG8_WAIT_L(0); PG8_BAR; PG8_MMA(1, 0, At, B0); PG8_MMA(1, 1, At, B1); PG8_BAR; PG8_SCHED;
            } else {
            PG8_LDB(B0, 0, 0); PG8_SCHED; PG8_LDA(At, 0, 0); PG8_STAGE(PG8_SA(1, 1), a1 + hstep, voffA);
            PG8_WAIT_L(8); PG8_BAR; PG8_WAIT_L(0); PG8_MMA(0, 0, At, B0); PG8_BAR; PG8_SCHED;
            PG8_LDB(B1, 0, 1); PG8_STAGE(PG8_SB(0, 0), b2, voffB);
            PG8_BAR; PG8_WAIT_L(0); PG8_MMA(0, 1, At, B1); PG8_BAR;
            PG8_LDA(At, 0, 1); PG8_STAGE(PG8_SA(0, 0), a2, voffA);
            PG8_BAR; PG8_WAIT_L(0); PG8_MMA(1, 0, At, B0); PG8_BAR; PG8_SCHED;
            PG8_STAGE(PG8_SB(0, 1), b2 + hstep, voffB);
            PG8_WAIT_V(6); PG8_BAR; PG8_MMA(1, 1, At, B1); PG8_BAR;
            PG8_LDB(B0, 1, 0); PG8_SCHED; PG8_LDA(At, 1, 0); PG8_STAGE(PG8_SA(0, 1), a2 + hstep, voffA);
            PG8_WAIT_L(8); PG8_BAR; PG8_WAIT_L(0); PG8_MMA(0, 0, At, B0); PG8_BAR; PG8_SCHED;
            PG8_LDB(B1, 1, 1); PG8_STAGE(PG8_SB(1, 0), b3, voffB);
            PG8_BAR; PG8_WAIT_L(0); PG8_MMA(0, 1, At, B1); PG8_BAR;
            PG8_LDA(At, 1, 1); PG8_STAGE(PG8_SA(1, 0), a3, voffA);
            PG8_BAR; PG8_WAIT_L(0); PG8_MMA(1, 0, At, B0); PG8_BAR; PG8_SCHED;
            PG8_STAGE(PG8_SB(1, 1), b3 + hstep, voffB);
            PG8_WAIT_V(6); PG8_BAR; PG8_MMA(1, 1, At, B1); PG8_BAR;
            }
        }
        if constexpr (ALIGN_EPI) { if (wr == 0) PG8_BAR; }
        if constexpr (!Epi::AFTER_DRAIN) { E(acc, cur, wr, wc, fr, fq); S.done(cur); }
        if (!has_next) break;
#pragma unroll
        for (int a = 0; a < 2; ++a)
#pragma unroll
            for (int b = 0; b < 2; ++b)
#pragma unroll
                for (int m = 0; m < 4; ++m)
#pragma unroll
                    for (int n = 0; n < 2; ++n) acc[a][b][m][n] = (f32x4){0.f, 0.f, 0.f, 0.f};
        cur = nxt; cA = nA; cB = nB; ++ui;
        if constexpr (ALIGN_EPI) { if (wr == 1) PG8_BAR; }
    }
    PG8_WAIT_V(0);
    if constexpr (!ALIGN_EPI) { if (wr == 0) PG8_BAR; }
    PG8_BAR;
    if constexpr (Epi::AFTER_DRAIN) { E.fused(acc, cur, wr, wc, fr, fq, lds, wid, lane); S.done(cur); }
#undef PG8_SA
#undef PG8_SB
#undef PG8_STAGE
#undef PG8_LDA
#undef PG8_LDB
#undef PG8_MMA
#undef PG8_WAIT_V
#undef PG8_WAIT_L
#undef PG8_BAR
#undef PG8_SCHED
}
}
#define GAS __attribute__((address_space(1)))
#define LAS __attribute__((address_space(3)))
typedef unsigned short bf16;
typedef unsigned v4u __attribute__((ext_vector_type(4)));
typedef float f32x4 __attribute__((ext_vector_type(4)));
typedef short bf16x8 __attribute__((ext_vector_type(8)));
typedef GAS unsigned gu32;
typedef GAS unsigned long long gu64;
#define RLX_AGENT __ATOMIC_RELAXED, __HIP_MEMORY_SCOPE_AGENT
#define LDS_WAIT() asm volatile("s_waitcnt lgkmcnt(0)" ::: "memory")
#define VM_WAIT() asm volatile("s_waitcnt vmcnt(0)" ::: "memory")
__device__ __forceinline__ unsigned long long rt() { return __builtin_amdgcn_s_memrealtime(); }
__device__ __forceinline__ unsigned f2bf(float f) { unsigned u = __builtin_bit_cast(unsigned, f); return (u + 0x7fffu + ((u >> 16) & 1u)) >> 16; }
__device__ __forceinline__ unsigned pk2(float lo, float hi) { return f2bf(lo) | (f2bf(hi) << 16); }

#define XB_TMO      128
#define XB_XCNT(j)  (256  + 64 * (j))
#define XB_XSUB(j)  (1280 + 64 * (j))
#define XB_XGEN(j)  (2304 + 64 * (j))
#define XB_TOP      3328
#define XB_TOPGEN   3392
#define XCD_BAR_WORDS 3456
#define XB_SPIN_CAP (1u << 18)

__device__ __forceinline__ unsigned xb_ld(unsigned* p)              { return __hip_atomic_load(p, __ATOMIC_RELAXED, __HIP_MEMORY_SCOPE_AGENT); }
__device__ __forceinline__ unsigned xb_add(unsigned* p, unsigned v) { return __hip_atomic_fetch_add(p, v, __ATOMIC_RELAXED, __HIP_MEMORY_SCOPE_AGENT); }
__device__ __forceinline__ unsigned xb_xcc_id() { return (unsigned)__builtin_amdgcn_s_getreg((3 << 11) | 20) & 0xFu; }
#define XB_SPIN(cond, bar) do { unsigned _sp = 0; while (cond) { __builtin_amdgcn_s_sleep(1); \
    if ((++_sp & 255u) == 0u) { if (xb_ld(&(bar)[XB_TMO])) break; if (_sp > XB_SPIN_CAP) { atomicAdd(&(bar)[XB_TMO], 1u); break; } } } } while (0)

struct XcdBarrier {
    unsigned* bar; unsigned x;
    volatile LAS unsigned* st;
};

__device__ __forceinline__ XcdBarrier xcd_barrier_post(unsigned* bar, volatile LAS unsigned* st) {
    XcdBarrier b; b.bar = bar; b.x = xb_xcc_id(); b.st = st;
    if (threadIdx.x == 0) (void)xb_add(&bar[XB_XCNT(b.x)], 1u);
    return b;
}
__device__ __forceinline__ void xcd_barrier_complete(unsigned* bar, unsigned x, unsigned& nloc, unsigned& nx) {
    const unsigned G = gridDim.x * gridDim.y * gridDim.z;
    unsigned sum, cnt, mine, sp = 0u;
    for (;;) {
        sum = 0u; cnt = 0u; mine = 0u;
#pragma unroll
        for (unsigned j = 0; j < 16; ++j) { const unsigned c = xb_ld(&bar[XB_XCNT(j)]); sum += c; cnt += (c > 0u) ? 1u : 0u; mine = (j == x) ? c : mine; }
        if (sum == G) break;
        __builtin_amdgcn_s_sleep(1);
        if ((++sp & 255u) == 0u) { if (xb_ld(&bar[XB_TMO])) break; if (sp > XB_SPIN_CAP) { atomicAdd(&bar[XB_TMO], 1u); break; } }
    }
    nloc = mine > 0u ? mine : 1u; nx = cnt > 0u ? cnt : 1u;
}

__device__ __forceinline__ void xcd_barrier(const XcdBarrier& b) {
    asm volatile("s_waitcnt vmcnt(0)" ::: "memory");
    __syncthreads();
    if (threadIdx.x == 0) {
        unsigned* bar = b.bar;
        __builtin_amdgcn_s_waitcnt(0);
        unsigned nloc = b.st[0], nx = b.st[1];
        if (nloc == 0u) { xcd_barrier_complete(bar, b.x, nloc, nx); b.st[0] = nloc; b.st[1] = nx; }
        const unsigned old = xb_add(&bar[XB_XSUB(b.x)], 1u);
        const unsigned gen = old / nloc;
        if (old + 1u == (gen + 1u) * nloc) {
            __builtin_amdgcn_fence(__ATOMIC_RELEASE, "agent");
            asm volatile("s_waitcnt vmcnt(0)" ::: "memory");
            const unsigned og = xb_add(&bar[XB_TOP], 1u);
            const unsigned tg = og / nx;
            if (og + 1u == (tg + 1u) * nx) xb_add(&bar[XB_TOPGEN], 1u);
            else XB_SPIN(xb_ld(&bar[XB_TOPGEN]) == tg, bar);
            __builtin_amdgcn_fence(__ATOMIC_ACQUIRE, "agent");
            xb_add(&bar[XB_XGEN(b.x)], 1u);
            asm volatile("s_waitcnt vmcnt(0)" ::: "memory");
        } else {
            XB_SPIN(xb_ld(&bar[XB_XGEN(b.x)]) == gen, bar);
            __builtin_amdgcn_fence(__ATOMIC_ACQUIRE, "agent");
            asm volatile("s_waitcnt vmcnt(0)" ::: "memory");
        }
    }
    __syncthreads();
}
constexpr int NWAVES = 8, NTHR = 512;
constexpr int DM = 1024, NBATCH = 4, SEQ = 4096, CL = 256;
constexpr int MLAT = NBATCH * SEQ, MCTX = NBATCH * CL, MALL = MLAT + MCTX;
constexpr int AB_IN = 3584, SWA_IN = 1536, PQD = 2048, MODW = 6144;
constexpr size_t MiB = 1u << 20;
constexpr size_t WS_CTL = 0, CTL_ZERO_BYTES = 1 * MiB;
constexpr size_t WS_MOD = 1 * MiB;
constexpr size_t WS_ROPE = 1 * MiB + 512 * 1024;
constexpr size_t WS_SUBK = 2 * MiB;
constexpr size_t WS_WIN0 = 4 * MiB, WS_WOUT0 = 11 * MiB, WS_WQ0 = 13 * MiB, WS_WIN1 = 17 * MiB, WS_WOUT1 = 20 * MiB, WS_WQ1 = 22 * MiB;
constexpr size_t WS_U = 32 * MiB, WS_V = 96 * MiB;
constexpr size_t WS_XN = 160 * MiB;
constexpr size_t WS_XS = 194 * MiB;
constexpr size_t WS_P = 262 * MiB;
constexpr size_t WS_Q2 = 262 * MiB;
constexpr size_t WS_IDX = 330 * MiB, WS_GATE = 339 * MiB;
constexpr size_t WS_TAV = 381 * MiB, WS_TBK = 398 * MiB, WS_TBV = 415 * MiB;
constexpr size_t WS_KV = 432 * MiB;
constexpr size_t WS_ST = 466 * MiB;
constexpr size_t WS_END = 483 * MiB;
constexpr int CW_BAR = 4096;

typedef unsigned v2u __attribute__((ext_vector_type(2)));
typedef __bf16 bf16x2_t __attribute__((ext_vector_type(2)));
__device__ __forceinline__ float bflo(unsigned u) { return __uint_as_float(u << 16); }
__device__ __forceinline__ float bfhi(unsigned u) { return __uint_as_float(u & 0xffff0000u); }
__device__ __forceinline__ float bf1(bf16 u) { return __uint_as_float((unsigned)u << 16); }
__device__ __forceinline__ v4u ld16(const bf16* p) { return *(const v4u*)p; }
__device__ __forceinline__ bf16x8 ldfrag(const bf16* p) { return __builtin_bit_cast(bf16x8, *(const v4u*)p); }
__device__ __forceinline__ f32x4 mfma16(bf16x8 a, bf16x8 b, f32x4 c) { return __builtin_amdgcn_mfma_f32_16x16x32_bf16(a, b, c, 0, 0, 0); }
__device__ __forceinline__ float wave_sum(float v) {
#pragma unroll
    for (int o = 1; o < 64; o <<= 1) v += __shfl_xor(v, o);
    return v;
}
__device__ __forceinline__ float fexp2(float x) { return __builtin_amdgcn_exp2f(x); }
__device__ __forceinline__ float fexp(float x) { return __builtin_amdgcn_exp2f(x * 1.4426950408889634f); }
__device__ __forceinline__ bf16x8 pack8(const f32x4& a, const f32x4& b) {
    v4u w; w.x = pk2(a[0], a[1]); w.y = pk2(a[2], a[3]); w.z = pk2(b[0], b[1]); w.w = pk2(b[2], b[3]);
    return __builtin_bit_cast(bf16x8, w);
}
__device__ __forceinline__ float dot2bf(unsigned a, unsigned b, float acc) {
    return __builtin_amdgcn_fdot2_f32_bf16(__builtin_bit_cast(bf16x2_t, a), __builtin_bit_cast(bf16x2_t, b), acc, false);
}
__device__ __forceinline__ float gelu_erf(float v) {
    const float av = fabsf(v), d = av * 0.2316418882f + 1.0f;
    const float t = __builtin_amdgcn_rcpf(d);
    float q = t * 0.5307027145f + (-0.7265760135f); q = q * t + 0.7107068705f; q = q * t + (-0.142248368f); q = q * t + 0.127414796f; q = q * t;
    const float e = __builtin_amdgcn_exp2f((v * v) * (-0.72134752044f));
    const float m = v * (q * e), r = v - m;
    return v < 0.f ? m : r;
}

struct Ctx {
    LAS unsigned char* lds;
    int tid, lane, wave, gw, ngw, G;
    const float *x, *c, *ctx, *c_ctx, *mod_w, *mod_b, *norm1_g, *norm2_g, *ab_w_in, *ab_w_out, *na_q_norm, *na_k_norm, *na_rpb, *ret_log_decay,
                *swa_w_in, *swa_w_out, *swa_q_norm, *swa_k_norm, *swa_sink, *peer_w_q, *peer_sub_keys, *peer_u, *peer_v;
    float* out;
    float* MOD; float* ROPE; bf16* SUBK; bf16 *WIN0, *WOUT0, *WQ0, *WIN1, *WOUT1, *WQ1; bf16 *U16, *V16; bf16* XN; float* XS; bf16* P; bf16* Q2;
    int* IDX; float* GATE; bf16 *TAV, *TBK, *TBV; float* KV; bf16* ST;
};

__device__ __forceinline__ void p0_transpose_item(const float* W, int K, int N, bf16* WT, LAS float* scr, int item, int lane) {
    const int nblk = N / 32, kb = item / nblk, nb = item % nblk, k0 = 64 * kb, n0 = 32 * nb;
#pragma unroll 8
    for (int i = 0; i < 32; ++i) { const int kk = 2 * i + (lane >> 5); scr[kk * 33 + (lane & 31)] = W[(size_t)(k0 + kk) * N + n0 + (lane & 31)]; }
    LDS_WAIT(); asm volatile("" ::: "memory");
    const int c = lane & 7;
#pragma unroll
    for (int j = 0; j < 4; ++j) { const int n = (lane >> 3) + 8 * j; const LAS float* s = scr + (8 * c) * 33 + n;
        v4u o; o.x = pk2(s[0 * 33], s[1 * 33]); o.y = pk2(s[2 * 33], s[3 * 33]); o.z = pk2(s[4 * 33], s[5 * 33]); o.w = pk2(s[6 * 33], s[7 * 33]);
        *(v4u*)(WT + (size_t)(n0 + n) * K + k0 + 8 * c) = o; }
    LDS_WAIT(); asm volatile("" ::: "memory");
}
__device__ __forceinline__ void p0_convert(const Ctx& F, const float* src, bf16* dst, size_t n8) {
    const size_t gt = (size_t)F.gw * 64 + F.lane, NT = (size_t)F.ngw * 64;
    for (size_t i = gt; i < n8; i += NT) {
        const f32x4 a = *(const f32x4*)(src + i * 8), b = *(const f32x4*)(src + i * 8 + 4);
        v4u o; o.x = pk2(a[0], a[1]); o.y = pk2(a[2], a[3]); o.z = pk2(b[0], b[1]); o.w = pk2(b[2], b[3]);
        *(v4u*)(dst + i * 8) = o;
    }
}
__device__ __forceinline__ void p0_prologue(const Ctx& F) {
    if (blockIdx.x < 192) {
        const int l = blockIdx.x / 96, cb = blockIdx.x % 96, col = cb * 64 + F.lane;
        LAS float* s = (LAS float*)F.lds;
        LAS float* part = (LAS float*)(F.lds + 20480);
        for (int i = F.tid; i < 5120; i += NTHR) { const int r = i >> 10, k = i & 1023; const float cv = r < 4 ? F.c[r * 1024 + k] : F.c_ctx[k]; s[i] = cv / (1.f + __expf(-cv)); }
        __syncthreads();
        float acc[5] = {0.f, 0.f, 0.f, 0.f, 0.f};
        const float* wp = F.mod_w + ((size_t)l * 1024 + F.wave * 128) * MODW + col;
#pragma unroll 8
        for (int k = 0; k < 128; ++k) { const float wv = wp[(size_t)k * MODW];
#pragma unroll
            for (int r = 0; r < 5; ++r) acc[r] += s[r * 1024 + F.wave * 128 + k] * wv; }
#pragma unroll
        for (int r = 0; r < 5; ++r) part[(F.wave * 5 + r) * 64 + F.lane] = acc[r];
        __syncthreads();
        if (F.wave < 5) { float t = F.mod_b[l * MODW + col];
#pragma unroll
            for (int w = 0; w < 8; ++w) t += part[(w * 5 + F.wave) * 64 + F.lane];
            F.MOD[(size_t)(l * 5 + F.wave) * MODW + col] = t; }
        __syncthreads();
    }
    { const int gt = F.gw * 64 + F.lane;
      if (gt < 1024) { const int pos = gt >> 4, f = gt & 15; const float invf = fexp2(-(float)f * (13.287712379549449f / 16.f)); const float rev = (float)pos * invf * 0.15915494309189535f;
          F.ROPE[gt * 2] = __builtin_amdgcn_cosf(rev); F.ROPE[gt * 2 + 1] = __builtin_amdgcn_sinf(rev); } }
    { LAS float* scr = (LAS float*)(F.lds + F.wave * 16384);
      constexpr int I_IN0 = 16 * (AB_IN / 32), I_O = 16 * 32, I_Q = 16 * (PQD / 32), I_IN1 = 16 * (SWA_IN / 32);
      constexpr int NITEMS = I_IN0 + I_O + I_Q + I_IN1 + I_O + I_Q;
      for (int it = F.gw; it < NITEMS; it += F.ngw) {
          int r = it;
          if (r < I_IN0) { p0_transpose_item(F.ab_w_in, DM, AB_IN, F.WIN0, scr, r, F.lane); continue; } r -= I_IN0;
          if (r < I_O) { p0_transpose_item(F.ab_w_out, DM, DM, F.WOUT0, scr, r, F.lane); continue; } r -= I_O;
          if (r < I_Q) { p0_transpose_item(F.peer_w_q, DM, PQD, F.WQ0, scr, r, F.lane); continue; } r -= I_Q;
          if (r < I_IN1) { p0_transpose_item(F.swa_w_in, DM, SWA_IN, F.WIN1, scr, r, F.lane); continue; } r -= I_IN1;
          if (r < I_O) { p0_transpose_item(F.swa_w_out, DM, DM, F.WOUT1, scr, r, F.lane); continue; } r -= I_O;
          p0_transpose_item(F.peer_w_q + (size_t)DM * PQD, DM, PQD, F.WQ1, scr, r, F.lane);
      } }
    p0_convert(F, F.peer_sub_keys, F.SUBK, (size_t)2 * 8 * 2 * 128 * 128 / 8);
    p0_convert(F, F.peer_u, F.U16, (size_t)2 * 16384 * 1024 / 8);
    p0_convert(F, F.peer_v, F.V16, (size_t)2 * 16384 * 1024 / 8);
}

__device__ __forceinline__ void mod_phase(const Ctx& F, const float* src_lat, const float* src_ctx, int M, const float* normg, const float* mod_l, int sh, int sc) {
    for (int m = F.gw; m < M; m += F.ngw) {
        const float* xr = m < MLAT ? src_lat + (size_t)m * DM : src_ctx + (size_t)(m - MLAT) * DM;
        const int cond = m < MLAT ? (m >> 12) : 4;
        const float* shp = mod_l + (size_t)cond * MODW + sh * 1024; const float* scp = mod_l + (size_t)cond * MODW + sc * 1024;
        f32x4 v[4]; float s = 0.f;
#pragma unroll
        for (int j = 0; j < 4; ++j) { v[j] = *(const f32x4*)(xr + 4 * F.lane + 256 * j); s += (v[j][0] * v[j][0] + v[j][1] * v[j][1]) + (v[j][2] * v[j][2] + v[j][3] * v[j][3]); }
        const float r = 1.0f / sqrtf(wave_sum(s) * (1.f / DM) + 1e-6f);
        bf16* orow = F.XN + (size_t)m * DM;
#pragma unroll
        for (int j = 0; j < 4; ++j) { const int k = 4 * F.lane + 256 * j;
            const f32x4 g = *(const f32x4*)(normg + k), a = *(const f32x4*)(scp + k), b = *(const f32x4*)(shp + k);
            f32x4 o;
#pragma unroll
            for (int e = 0; e < 4; ++e) o[e] = v[j][e] * r * g[e] * (1.f + a[e]) + b[e];
            v2u w; w.x = pk2(o[0], o[1]); w.y = pk2(o[2], o[3]); *(v2u*)(orow + k) = w; }
    }
}

struct PostSlot { int col; const float* nw; int rope; float scale; bf16* tdst; int nheads; int head; int write_nat; };
__device__ __forceinline__ void post_item(const Ctx& F, bf16* P, int ld, int tt, const PostSlot& S, LAS unsigned char* wl) {
    const int lane = F.lane, c = lane & 7, rsub = lane >> 3;
    const bool latent = tt < 256;
    const int m0 = tt * 64;
    const int b = latent ? (tt >> 6) : ((tt - 256) >> 2);
    const int t0 = latent ? ((tt & 63) * 64) : (((tt - 256) & 3) * 64);
    f32x4 nwa = {1.f, 1.f, 1.f, 1.f}, nwb = {1.f, 1.f, 1.f, 1.f};
    if (S.nw) { nwa = *(const f32x4*)(S.nw + 8 * c); nwb = *(const f32x4*)(S.nw + 8 * c + 4); }
#pragma unroll
    for (int it = 0; it < 8; ++it) {
        const int row = it * 8 + rsub;
        bf16* pp = P + (size_t)(m0 + row) * ld + S.col + 8 * c;
        const v4u raw = *(const v4u*)pp;
        float v[8] = {bflo(raw.x), bfhi(raw.x), bflo(raw.y), bfhi(raw.y), bflo(raw.z), bfhi(raw.z), bflo(raw.w), bfhi(raw.w)};
        if (S.nw) {
            float ss = 0.f;
#pragma unroll
            for (int e = 0; e < 8; ++e) ss += v[e] * v[e];
            ss += __shfl_xor(ss, 1); ss += __shfl_xor(ss, 2); ss += __shfl_xor(ss, 4);
            const float r = 1.0f / sqrtf(ss * (1.f / 64.f) + 1e-6f);
#pragma unroll
            for (int e = 0; e < 4; ++e) { v[e] *= r * nwa[e]; v[4 + e] *= r * nwb[e]; }
        }
        if (S.rope && latent) {
            const int t = t0 + row, pos = ((c & 3) < 2) ? (t >> 6) : (t & 63), f0 = (c & 1) * 8;
            const float* rp = F.ROPE + (size_t)(pos * 16 + f0) * 2;
#pragma unroll
            for (int e = 0; e < 8; ++e) {
                const float other = __shfl_xor(v[e], 4);
                const float cs = rp[2 * e], sn = rp[2 * e + 1];
                v[e] = (c < 4) ? (v[e] * cs - other * sn) : (other * sn + v[e] * cs);
            }
        }
        v4u o; o.x = pk2(v[0] * S.scale, v[1] * S.scale); o.y = pk2(v[2] * S.scale, v[3] * S.scale); o.z = pk2(v[4] * S.scale, v[5] * S.scale); o.w = pk2(v[6] * S.scale, v[7] * S.scale);
        if (S.write_nat) *(v4u*)pp = o;
        if (S.tdst) *(LAS v4u*)(wl + row * 144 + 16 * c) = o;
    }
    if (S.tdst) {
        LDS_WAIT(); asm volatile("" ::: "memory");
        const int tlen = latent ? SEQ : CL;
        bf16* dst = S.tdst + (latent ? (size_t)0 : (size_t)NBATCH * S.nheads * 64 * SEQ) + ((size_t)(b * S.nheads + S.head) * 64 + lane) * tlen + t0;
#pragma unroll
        for (int q = 0; q < 8; ++q) {
            unsigned w[4];
#pragma unroll
            for (int e = 0; e < 4; ++e) {
                const unsigned lo = *(LAS const unsigned short*)(wl + (8 * q + 2 * e) * 144 + 2 * lane);
                const unsigned hi = *(LAS const unsigned short*)(wl + (8 * q + 2 * e + 1) * 144 + 2 * lane);
                w[e] = lo | (hi << 16);
            }
            v4u o; o.x = w[0]; o.y = w[1]; o.z = w[2]; o.w = w[3];
            *(v4u*)(dst + 8 * q) = o;
        }
        LDS_WAIT(); asm volatile("" ::: "memory");
    }
}
#define NEG_BIG (-1.0e30f)

template <bool CTXQ>
__device__ __forceinline__ void na_unit(const Ctx& F, int b, int h, int r, int cg) {
    const int lane = F.lane, qi = lane & 15, g = lane >> 4;
    const bf16* P = F.P;
    const int c = cg * 16 + qi;
    const size_t qrow = CTXQ ? (size_t)(MLAT + b * CL + r * 16 + qi) : (size_t)(b * SEQ + r * 64 + c);
    const bf16* qp = P + qrow * AB_IN + h * 64 + 8 * g;
    bf16x8 bq[2]; bq[0] = ldfrag(qp); bq[1] = ldfrag(qp + 32);
    constexpr int NL = CTXQ ? 0 : 8;
    constexpr int NGRP = NL + 8;
    f32x4 st[2 * NGRP];
    const int arow = 8 * (qi >> 2) + (qi & 3);
    int kr0 = 0, kc0 = 0, start = 0;
    if (!CTXQ) {
        kr0 = min(max(r - 4, 0), 56); kc0 = cg == 0 ? 0 : (cg == 1 ? 8 : (cg == 2 ? 24 : 32)); start = min(max(c - 8, 0), 48);
        const float* rpb = F.na_rpb + (size_t)h * 15 * 31;
#pragma unroll
        for (int y = 0; y < NL; ++y) {
            const int T0 = (kr0 + y) * 64 + kc0;
            const float* rpr = rpb + ((kr0 + y) - r + 7) * 31;
#pragma unroll
            for (int hh = 0; hh < 2; ++hh) {
                const bf16* kp = P + (size_t)(b * SEQ + T0 + arow + 4 * hh) * AB_IN + 512 + h * 64 + 8 * g;
                f32x4 a = {0.f, 0.f, 0.f, 0.f};
                a = mfma16(ldfrag(kp), bq[0], a); a = mfma16(ldfrag(kp + 32), bq[1], a);
#pragma unroll
                for (int rr = 0; rr < 4; ++rr) {
                    const int kc = kc0 + 8 * g + 4 * hh + rr;
                    const bool valid = (kc >= start) && (kc < start + 16);
                    const int bi = min(max(kc - c + 15, 0), 30);
                    const float bias = rpr[bi];
                    a[rr] = valid ? a[rr] + bias : NEG_BIG;
                }
                st[2 * y + hh] = a;
            }
        }
    }
#pragma unroll
    for (int y = 0; y < 8; ++y) {
#pragma unroll
        for (int hh = 0; hh < 2; ++hh) {
            const bf16* kp = P + (size_t)(MLAT + b * CL + 32 * y + arow + 4 * hh) * AB_IN + 512 + h * 64 + 8 * g;
            f32x4 a = {0.f, 0.f, 0.f, 0.f};
            a = mfma16(ldfrag(kp), bq[0], a); a = mfma16(ldfrag(kp + 32), bq[1], a);
            st[2 * (NL + y) + hh] = a;
        }
    }
    float m = NEG_BIG;
#pragma unroll
    for (int i = 0; i < 2 * NGRP; ++i) m = fmaxf(fmaxf(fmaxf(st[i][0], st[i][1]), fmaxf(st[i][2], st[i][3])), m);
    m = fmaxf(m, __shfl_xor(m, 16)); m = fmaxf(m, __shfl_xor(m, 32));
    float l = 0.f;
#pragma unroll
    for (int i = 0; i < 2 * NGRP; ++i) {
#pragma unroll
        for (int rr = 0; rr < 4; ++rr) { const float p = fexp(st[i][rr] - m); st[i][rr] = p; l += p; }
    }
    l += __shfl_xor(l, 16); l += __shfl_xor(l, 32);
    f32x4 o[4];
#pragma unroll
    for (int db = 0; db < 4; ++db) o[db] = (f32x4){0.f, 0.f, 0.f, 0.f};
    const bf16* vx = F.TAV + ((size_t)(b * 8 + h) * 64 + qi) * SEQ + 8 * g;
    const bf16* vc = F.TAV + (size_t)NBATCH * 8 * 64 * SEQ + ((size_t)(b * 8 + h) * 64 + qi) * CL + 8 * g;
#pragma unroll
    for (int y = 0; y < NGRP; ++y) {
        const bf16x8 bp = pack8(st[2 * y], st[2 * y + 1]);
        if (y < NL) {
            const int T0 = (kr0 + y) * 64 + kc0;
#pragma unroll
            for (int db = 0; db < 4; ++db) o[db] = mfma16(ldfrag(vx + (size_t)(16 * db) * SEQ + T0), bp, o[db]);
        } else {
#pragma unroll
            for (int db = 0; db < 4; ++db) o[db] = mfma16(ldfrag(vc + (size_t)(16 * db) * CL + 32 * (y - NL)), bp, o[db]);
        }
    }
    const float inv = 1.0f / l;
    bf16* op = F.XN + qrow * DM + h * 64 + 4 * g;
#pragma unroll
    for (int db = 0; db < 4; ++db) { v2u w; w.x = pk2(o[db][0] * inv, o[db][1] * inv); w.y = pk2(o[db][2] * inv, o[db][3] * inv); *(v2u*)(op + 16 * db) = w; }
}

__device__ __forceinline__ void swa_unit(const Ctx& F, int b, int hq, int qb) {
    const int lane = F.lane, qi = lane & 15, g = lane >> 4;
    const bf16* P = F.P;
    const int kvh = hq >> 2;
    const int t0 = qb * 16, t = t0 + qi;
    const size_t qrow = (size_t)(b * SEQ + t);
    const bf16* qp = P + qrow * SWA_IN + hq * 64 + 8 * g;
    bf16x8 bq[2]; bq[0] = ldfrag(qp); bq[1] = ldfrag(qp + 32);
    constexpr int NL = 9, NGRP = NL + 8;
    f32x4 st[2 * NGRP];
    const int arow = 8 * (qi >> 2) + (qi & 3);
#pragma unroll
    for (int y = 0; y < NL; ++y) {
        const int T0 = t0 - 128 + 32 * y;
#pragma unroll
        for (int hh = 0; hh < 2; ++hh) {
            const int srow = min(max(T0 + arow + 4 * hh, 0), SEQ - 1);
            const bf16* kp = P + (size_t)(b * SEQ + srow) * SWA_IN + 1024 + kvh * 64 + 8 * g;
            f32x4 a = {0.f, 0.f, 0.f, 0.f};
            a = mfma16(ldfrag(kp), bq[0], a); a = mfma16(ldfrag(kp + 32), bq[1], a);
#pragma unroll
            for (int rr = 0; rr < 4; ++rr) {
                const int s = T0 + 8 * g + 4 * hh + rr;
                const int d = t - s;
                const bool valid = (s >= 0) && (s < SEQ) && (d <= 128) && (d >= -128);
                a[rr] = valid ? a[rr] : NEG_BIG;
            }
            st[2 * y + hh] = a;
        }
    }
#pragma unroll
    for (int y = 0; y < 8; ++y) {
#pragma unroll
        for (int hh = 0; hh < 2; ++hh) {
            const bf16* kp = P + (size_t)(MLAT + b * CL + 32 * y + arow + 4 * hh) * SWA_IN + 1024 + kvh * 64 + 8 * g;
            f32x4 a = {0.f, 0.f, 0.f, 0.f};
            a = mfma16(ldfrag(kp), bq[0], a); a = mfma16(ldfrag(kp + 32), bq[1], a);
            st[2 * (NL + y) + hh] = a;
        }
    }
    const float sink = F.swa_sink[hq];
    float m = sink;
#pragma unroll
    for (int i = 0; i < 2 * NGRP; ++i) m = fmaxf(fmaxf(fmaxf(st[i][0], st[i][1]), fmaxf(st[i][2], st[i][3])), m);
    m = fmaxf(m, __shfl_xor(m, 16)); m = fmaxf(m, __shfl_xor(m, 32));
    float l = 0.f;
#pragma unroll
    for (int i = 0; i < 2 * NGRP; ++i) {
#pragma unroll
        for (int rr = 0; rr < 4; ++rr) { const float p = fexp(st[i][rr] - m); st[i][rr] = p; l += p; }
    }
    l += __shfl_xor(l, 16); l += __shfl_xor(l, 32);
    l += fexp(sink - m);
    f32x4 o[4];
#pragma unroll
    for (int db = 0; db < 4; ++db) o[db] = (f32x4){0.f, 0.f, 0.f, 0.f};
    const bf16* vx = F.TAV + ((size_t)(b * 4 + kvh) * 64 + qi) * SEQ;
    const bf16* vc = F.TAV + (size_t)NBATCH * 4 * 64 * SEQ + ((size_t)(b * 4 + kvh) * 64 + qi) * CL + 8 * g;
#pragma unroll
    for (int y = 0; y < NGRP; ++y) {
        const bf16x8 bp = pack8(st[2 * y], st[2 * y + 1]);
        if (y < NL) {
            const int tk = min(max(t0 - 128 + 32 * y + 8 * g, 0), SEQ - 8);
#pragma unroll
            for (int db = 0; db < 4; ++db) o[db] = mfma16(ldfrag(vx + (size_t)(16 * db) * SEQ + tk), bp, o[db]);
        } else {
#pragma unroll
            for (int db = 0; db < 4; ++db) o[db] = mfma16(ldfrag(vc + (size_t)(16 * db) * CL + 32 * (y - NL)), bp, o[db]);
        }
    }
    const float inv = 1.0f / l;
    bf16* op = F.XN + qrow * DM + hq * 64 + 4 * g;
#pragma unroll
    for (int db = 0; db < 4; ++db) { v2u w; w.x = pk2(o[db][0] * inv, o[db][1] * inv); w.y = pk2(o[db][2] * inv, o[db][3] * inv); *(v2u*)(op + 16 * db) = w; }
}

__device__ __forceinline__ int ret_pb(int pf) { return pf < 2 ? 32 + pf : pf - 2; }
__device__ __forceinline__ void ret_r1_unit(const Ctx& F, int bh, int pf, int dir) {
    const int lane = F.lane, qi = lane & 15, g = lane >> 4;
    const int h = bh & 7;
    const float lg2 = -__expf(F.ret_log_decay[dir * 8 + h]) * 1.4426950408889634f;
    const bool isctx = pf < 2;
    const int tlen = isctx ? CL : SEQ;
    const size_t boff = (isctx ? (size_t)NBATCH * 8 * 64 * SEQ : (size_t)0) + (size_t)bh * 64 * tlen + (isctx ? pf * 128 : (pf - 2) * 128);
    const bf16* kt = F.TBK + boff + (size_t)qi * tlen + 8 * g;
    const bf16* vt = F.TBV + boff + (size_t)qi * tlen + 8 * g;
    f32x4 acc[4][4];
#pragma unroll
    for (int db = 0; db < 4; ++db)
#pragma unroll
        for (int kb = 0; kb < 4; ++kb) acc[db][kb] = (f32x4){0.f, 0.f, 0.f, 0.f};
#pragma unroll 1
    for (int js = 0; js < 4; ++js) {
        float w[8];
#pragma unroll
        for (int jj = 0; jj < 8; ++jj) { const int j = 32 * js + 8 * g + jj; w[jj] = fexp2(lg2 * (float)(dir == 0 ? 127 - j : j)); }
        bf16x8 bk[4];
#pragma unroll
        for (int kb = 0; kb < 4; ++kb) {
            const v4u raw = ld16(kt + (size_t)(16 * kb) * tlen + 32 * js);
            v4u o; o.x = pk2(bflo(raw.x) * w[0], bfhi(raw.x) * w[1]); o.y = pk2(bflo(raw.y) * w[2], bfhi(raw.y) * w[3]);
            o.z = pk2(bflo(raw.z) * w[4], bfhi(raw.z) * w[5]); o.w = pk2(bflo(raw.w) * w[6], bfhi(raw.w) * w[7]);
            bk[kb] = __builtin_bit_cast(bf16x8, o);
        }
#pragma unroll
        for (int db = 0; db < 4; ++db) {
            const bf16x8 a = ldfrag(vt + (size_t)(16 * db) * tlen + 32 * js);
#pragma unroll
            for (int kb = 0; kb < 4; ++kb) acc[db][kb] = mfma16(a, bk[kb], acc[db][kb]);
        }
    }
    const int idx = dir == 0 ? pf : ret_pb(pf);
    float* out = F.KV + ((size_t)(bh * 2 + dir) * 34 + idx) * 4096;
#pragma unroll
    for (int db = 0; db < 4; ++db)
#pragma unroll
        for (int kb = 0; kb < 4; ++kb)
#pragma unroll
            for (int rr = 0; rr < 4; ++rr) out[(16 * db + 4 * g + rr) * 64 + 16 * kb + qi] = acc[db][kb][rr];
}
__device__ __forceinline__ void ret_r2(const Ctx& F) {
    const int NT = F.ngw * 64;
    for (int it = F.gw * 64 + F.lane; it < 64 * 4096; it += NT) {
        const int unit = it >> 12, e = it & 4095;
        const int dir = unit & 1, h = (unit >> 1) & 7;
        const float gC = fexp2(-__expf(F.ret_log_decay[dir * 8 + h]) * 1.4426950408889634f * 128.f);
        const float* kv = F.KV + (size_t)unit * 34 * 4096 + e;
        bf16* st = F.ST + (size_t)unit * 34 * 4096 + e;
        float S = 0.f;
        if (dir == 0) { for (int p = 0; p < 34; ++p) { st[(size_t)p * 4096] = (bf16)f2bf(S); S = S * gC + kv[(size_t)p * 4096]; } }
        else { for (int p = 33; p >= 0; --p) { st[(size_t)p * 4096] = (bf16)f2bf(S); S = S * gC + kv[(size_t)p * 4096]; } }
    }
}
__device__ __forceinline__ void ret_r3_unit(const Ctx& F, int bh, int pf, int ib) {
    const int lane = F.lane, qi = lane & 15, g = lane >> 4;
    const int b = bh >> 3, h = bh & 7;
    const bf16* P = F.P;
    const bool isctx = pf < 2;
    const size_t row0 = isctx ? (size_t)(MLAT + b * CL + pf * 128) : (size_t)(b * SEQ + (pf - 2) * 128);
    const int i = 16 * ib + qi;
    const float lgf = -__expf(F.ret_log_decay[h]) * 1.4426950408889634f, lgb = -__expf(F.ret_log_decay[8 + h]) * 1.4426950408889634f;
    const bf16* qp = P + (row0 + i) * AB_IN + 1536 + h * 64 + 8 * g;
    bf16x8 bq[2]; bq[0] = ldfrag(qp); bq[1] = ldfrag(qp + 32);
    const int arow = 8 * (qi >> 2) + (qi & 3);
    f32x4 st[8];
#pragma unroll
    for (int y = 0; y < 4; ++y)
#pragma unroll
        for (int hh = 0; hh < 2; ++hh) {
            const bf16* kp = P + (row0 + 32 * y + arow + 4 * hh) * AB_IN + 2048 + h * 64 + 8 * g;
            f32x4 a = {0.f, 0.f, 0.f, 0.f};
            a = mfma16(ldfrag(kp), bq[0], a); a = mfma16(ldfrag(kp + 32), bq[1], a);
#pragma unroll
            for (int rr = 0; rr < 4; ++rr) {
                const int j = 32 * y + 8 * g + 4 * hh + rr; const int d = i - j;
                const float w = d > 0 ? fexp2(lgf * (float)d) : (d < 0 ? fexp2(lgb * (float)(-d)) : 1.0f);
                a[rr] *= w;
            }
            st[2 * y + hh] = a;
        }
    f32x4 o[4];
#pragma unroll
    for (int db = 0; db < 4; ++db) o[db] = (f32x4){0.f, 0.f, 0.f, 0.f};
    const int tlen = isctx ? CL : SEQ;
    const bf16* vt = F.TBV + (isctx ? (size_t)NBATCH * 8 * 64 * SEQ : (size_t)0) + ((size_t)bh * 64 + qi) * tlen + (isctx ? pf * 128 : (pf - 2) * 128) + 8 * g;
#pragma unroll
    for (int y = 0; y < 4; ++y) {
        const bf16x8 bp = pack8(st[2 * y], st[2 * y + 1]);
#pragma unroll
        for (int db = 0; db < 4; ++db) o[db] = mfma16(ldfrag(vt + (size_t)(16 * db) * tlen + 32 * y), bp, o[db]);
    }
    {
        const bf16* sf = F.ST + ((size_t)(bh * 2 + 0) * 34 + pf) * 4096 + qi * 64 + 8 * g;
        const bf16* sb = F.ST + ((size_t)(bh * 2 + 1) * 34 + ret_pb(pf)) * 4096 + qi * 64 + 8 * g;
        const float df = fexp2(lgf * (float)(i + 1)), dbk = fexp2(lgb * (float)(128 - i));
#pragma unroll
        for (int db = 0; db < 4; ++db) {
            f32x4 xf = {0.f, 0.f, 0.f, 0.f}, xb = {0.f, 0.f, 0.f, 0.f};
            xf = mfma16(ldfrag(sf + 16 * db * 64), bq[0], xf); xf = mfma16(ldfrag(sf + 16 * db * 64 + 32), bq[1], xf);
            xb = mfma16(ldfrag(sb + 16 * db * 64), bq[0], xb); xb = mfma16(ldfrag(sb + 16 * db * 64 + 32), bq[1], xb);
            o[db] = o[db] + xf * df + xb * dbk;
        }
    }
    float s = 0.f;
#pragma unroll
    for (int db = 0; db < 4; ++db) s += (o[db][0] + o[db][1]) + (o[db][2] + o[db][3]);
    s += __shfl_xor(s, 16); s += __shfl_xor(s, 32);
    const float mu = s * (1.f / 64.f);
    float q = 0.f;
#pragma unroll
    for (int db = 0; db < 4; ++db)
#pragma unroll
        for (int rr = 0; rr < 4; ++rr) { const float d = o[db][rr] - mu; o[db][rr] = d; q += d * d; }
    q += __shfl_xor(q, 16); q += __shfl_xor(q, 32);
    const float rstd = 1.0f / sqrtf(q * (1.f / 64.f) + 1e-5f);
    const bf16* gp = P + (row0 + i) * AB_IN + 3072 + h * 64 + 4 * g;
    bf16* op = F.XN + (row0 + i) * DM + 512 + h * 64 + 4 * g;
#pragma unroll
    for (int db = 0; db < 4; ++db) {
        const v2u gr = *(const v2u*)(gp + 16 * db);
        const float gv[4] = {bflo(gr.x), bfhi(gr.x), bflo(gr.y), bfhi(gr.y)};
        float r[4];
#pragma unroll
        for (int rr = 0; rr < 4; ++rr) r[rr] = o[db][rr] * rstd * (gv[rr] / (1.f + fexp(-gv[rr])));
        v2u w; w.x = pk2(r[0], r[1]); w.y = pk2(r[2], r[3]); *(v2u*)(op + 16 * db) = w;
    }
}
__device__ __constant__ unsigned char CAND_TAB[52] = {
    0x00,0x01,0x02,0x03,0x04,0x05,0x06,0x07,0x08,0x09,0x0a,0x0b,0x0c,0x0d,0x0e,0x0f,
    0x10,0x11,0x12,0x13,0x14,0x15,0x16,0x17,
    0x20,0x21,0x22,0x23,0x24,
    0x30,0x31,0x32,0x33,
    0x40,0x41,0x42, 0x50,0x51, 0x60,0x61, 0x70,0x71,
    0x80,0x90,0xa0,0xb0,0xc0,0xd0,0xe0,0xf0,
    0x00,0x00 };
#define SORT_NEG (-3.0e38f)
template <int LOGN>
__device__ __forceinline__ void bitonic_sort_desc(float (&v)[1 << LOGN]) {
    constexpr int N = 1 << LOGN;
#pragma unroll
    for (int kk = 1; kk <= LOGN; ++kk) {
#pragma unroll
        for (int jj = kk - 1; jj >= 0; --jj) {
#pragma unroll
            for (int i = 0; i < N; ++i) {
                const int k = 1 << kk, j = 1 << jj, l = i ^ j;
                if (l > i) {
                    const bool desc = ((i & k) == 0);
                    const float a = v[i], b = v[l];
                    const float hi = fmaxf(a, b), lo = fminf(a, b);
                    v[i] = desc ? hi : lo; v[l] = desc ? lo : hi;
                }
            }
        }
    }
}
__device__ __forceinline__ void merge_top16(float (&v)[16], int mask) {
    float c[16];
#pragma unroll
    for (int i = 0; i < 16; ++i) c[i] = fmaxf(v[i], __shfl_xor(v[15 - i], mask));
#pragma unroll
    for (int jj = 3; jj >= 0; --jj) {
#pragma unroll
        for (int i = 0; i < 16; ++i) { const int j = 1 << jj, l = i ^ j;
            if (l > i) { const float a = c[i], b = c[l]; c[i] = fmaxf(a, b); c[l] = fminf(a, b); } }
    }
#pragma unroll
    for (int i = 0; i < 16; ++i) v[i] = c[i];
}
__device__ __forceinline__ void peer_score_unit(const Ctx& F, int l, int tb, int h, LAS unsigned* wl) {
    const int lane = F.lane, qi = lane & 15, g = lane >> 4;
    const size_t m = (size_t)tb * 16 + qi;
#pragma unroll 1
    for (int p = 0; p < 2; ++p) {
        const bf16* qp = F.Q2 + m * PQD + h * 256 + p * 128 + 8 * g;
        bf16x8 bq[4];
#pragma unroll
        for (int ks = 0; ks < 4; ++ks) bq[ks] = ldfrag(qp + 32 * ks);
        const bf16* kp = F.SUBK + ((size_t)((l * 8 + h) * 2 + p) * 128 + qi) * 128 + 8 * g;
        float v[32];
#pragma unroll
        for (int kb = 0; kb < 8; ++kb) {
            f32x4 a = {0.f, 0.f, 0.f, 0.f};
#pragma unroll
            for (int ks = 0; ks < 4; ++ks) a = mfma16(ldfrag(kp + (size_t)(16 * kb) * 128 + 32 * ks), bq[ks], a);
#pragma unroll
            for (int rr = 0; rr < 4; ++rr) v[4 * kb + rr] = __uint_as_float((__float_as_uint(a[rr]) & ~127u) | (unsigned)(16 * kb + 4 * g + rr));
        }
        bitonic_sort_desc<5>(v);
        float t[16];
#pragma unroll
        for (int i = 0; i < 16; ++i) t[i] = v[i];
        merge_top16(t, 16); merge_top16(t, 32);
        if (g == 0) {
#pragma unroll
            for (int i = 0; i < 16; ++i) wl[(qi * 2 + p) * 16 + i] = __float_as_uint(t[i]);
        }
    }
    LDS_WAIT(); asm volatile("" ::: "memory");
    float cd[16];
#pragma unroll
    for (int k = 0; k < 13; ++k) {
        const int code = g * 13 + k;
        const unsigned ij = CAND_TAB[code];
        const unsigned a = wl[(qi * 2 + 0) * 16 + (ij >> 4)], b = wl[(qi * 2 + 1) * 16 + (ij & 15)];
        const float s = __uint_as_float(a & ~127u) + __uint_as_float(b & ~127u);
        cd[k] = code < 50 ? __uint_as_float((__float_as_uint(s) & ~63u) | (unsigned)code) : SORT_NEG;
    }
    cd[13] = SORT_NEG; cd[14] = SORT_NEG; cd[15] = SORT_NEG;
    bitonic_sort_desc<4>(cd);
    merge_top16(cd, 16); merge_top16(cd, 32);
    float e[16]; float sum = 0.f;
    const float mx = __uint_as_float(__float_as_uint(cd[0]) & ~63u);
#pragma unroll
    for (int k = 0; k < 16; ++k) { e[k] = fexp(__uint_as_float(__float_as_uint(cd[k]) & ~63u) - mx); sum += e[k]; }
    const float inv = 1.0f / sum;
    int ex[16];
#pragma unroll
    for (int k = 0; k < 16; ++k) {
        const unsigned code = __float_as_uint(cd[k]) & 63u;
        const unsigned ij = CAND_TAB[code];
        const unsigned a = wl[(qi * 2 + 0) * 16 + (ij >> 4)] & 127u, b = wl[(qi * 2 + 1) * 16 + (ij & 15)] & 127u;
        ex[k] = (int)(a * 128u + b);
    }
    typedef int i32x4 __attribute__((ext_vector_type(4)));
    i32x4 oi; f32x4 og;
#pragma unroll
    for (int k = 0; k < 4; ++k) {
        oi[k] = g == 0 ? ex[k] : (g == 1 ? ex[4 + k] : (g == 2 ? ex[8 + k] : ex[12 + k]));
        og[k] = (g == 0 ? e[k] : (g == 1 ? e[4 + k] : (g == 2 ? e[8 + k] : e[12 + k]))) * inv;
    }
    *(i32x4*)(F.IDX + m * 128 + h * 16 + 4 * g) = oi;
    *(f32x4*)(F.GATE + m * 128 + h * 16 + 4 * g) = og;
    LDS_WAIT(); asm volatile("" ::: "memory");
}

__device__ __forceinline__ void peer_gather_token(const Ctx& F, int l, size_t m, const float* g2, float* dst_row) {
    const int lane = F.lane;
    const int* ip = F.IDX + m * 128; const float* gp = F.GATE + m * 128;
    const int i0 = ip[lane], i1 = ip[64 + lane];
    const float ga0 = gp[lane], ga1 = gp[64 + lane];
    const v4u hA = ld16(F.XN + m * DM + 8 * lane), hB = ld16(F.XN + m * DM + 512 + 8 * lane);
    const bf16* U = F.U16 + (size_t)l * 16384 * 1024 + 8 * lane;
    const bf16* V = F.V16 + (size_t)l * 16384 * 1024 + 8 * lane;
    float acc[16];
#pragma unroll
    for (int k = 0; k < 16; ++k) acc[k] = 0.f;
#pragma unroll 1
    for (int bt = 0; bt < 2; ++bt) {
        const int idv = bt ? i1 : i0;
        const float gav = bt ? ga1 : ga0;
        float act = 0.f;
#pragma unroll 1
        for (int ch = 0; ch < 8; ++ch) {
            float part[8];
            v4u ra[8], rb[8];
#pragma unroll
            for (int e = 0; e < 8; ++e) {
                const int row = __shfl(idv, ch * 8 + e);
                const bf16* rp = U + (size_t)row * 1024;
                ra[e] = ld16(rp); rb[e] = ld16(rp + 512);
            }
#pragma unroll
            for (int e = 0; e < 8; ++e) {
                float a0 = 0.f, a1 = 0.f;
                a0 = dot2bf(ra[e].x, hA.x, a0); a1 = dot2bf(ra[e].y, hA.y, a1); a0 = dot2bf(ra[e].z, hA.z, a0); a1 = dot2bf(ra[e].w, hA.w, a1);
                a0 = dot2bf(rb[e].x, hB.x, a0); a1 = dot2bf(rb[e].y, hB.y, a1); a0 = dot2bf(rb[e].z, hB.z, a0); a1 = dot2bf(rb[e].w, hB.w, a1);
                part[e] = wave_sum(a0 + a1);
            }
#pragma unroll
            for (int e = 0; e < 8; ++e) act = (lane == ch * 8 + e) ? part[e] : act;
        }
        const float wgt = gelu_erf(act) * gav;
#pragma unroll 1
        for (int ch = 0; ch < 8; ++ch) {
            v4u ra[8], rb[8]; float w[8];
#pragma unroll
            for (int e = 0; e < 8; ++e) {
                const int row = __shfl(idv, ch * 8 + e);
                w[e] = __shfl(wgt, ch * 8 + e);
                const bf16* rp = V + (size_t)row * 1024;
                ra[e] = ld16(rp); rb[e] = ld16(rp + 512);
            }
#pragma unroll
            for (int e = 0; e < 8; ++e) {
                acc[0] += w[e] * bflo(ra[e].x); acc[1] += w[e] * bfhi(ra[e].x); acc[2] += w[e] * bflo(ra[e].y); acc[3] += w[e] * bfhi(ra[e].y);
                acc[4] += w[e] * bflo(ra[e].z); acc[5] += w[e] * bfhi(ra[e].z); acc[6] += w[e] * bflo(ra[e].w); acc[7] += w[e] * bfhi(ra[e].w);
                acc[8] += w[e] * bflo(rb[e].x); acc[9] += w[e] * bfhi(rb[e].x); acc[10] += w[e] * bflo(rb[e].y); acc[11] += w[e] * bfhi(rb[e].y);
                acc[12] += w[e] * bflo(rb[e].z); acc[13] += w[e] * bfhi(rb[e].z); acc[14] += w[e] * bflo(rb[e].w); acc[15] += w[e] * bfhi(rb[e].w);
            }
        }
    }
    const float* src = F.XS + m * DM;
#pragma unroll
    for (int hf = 0; hf < 2; ++hf) {
        const int k0 = hf * 512 + 8 * lane;
        const f32x4 ga = *(const f32x4*)(g2 + k0), gb = *(const f32x4*)(g2 + k0 + 4);
        const f32x4 xa = *(const f32x4*)(src + k0), xb = *(const f32x4*)(src + k0 + 4);
        f32x4 oa, ob;
#pragma unroll
        for (int e = 0; e < 4; ++e) { oa[e] = xa[e] + ga[e] * acc[hf * 8 + e]; ob[e] = xb[e] + gb[e] * acc[hf * 8 + 4 + e]; }
        *(f32x4*)(dst_row + k0) = oa; *(f32x4*)(dst_row + k0 + 4) = ob;
    }
}
#ifndef MK_N_LAUNCHES
#define MK_N_LAUNCHES 1
#endif
constexpr int NPH = 21;
constexpr int LDS_BYTES = 147456;
constexpr int LDSCTL_OFF = 131072, MISC_OFF = LDSCTL_OFF + 320;
struct Args { const float* in[23]; float* out; unsigned char* ws; int ph_lo, ph_hi; };


__device__ __forceinline__ Ctx make_ctx(const Args* ap, LAS unsigned char* lds) {
    Ctx F;
    F.lds = lds;
    F.tid = threadIdx.x; F.lane = F.tid & 63; F.wave = __builtin_amdgcn_readfirstlane(F.tid >> 6);
    F.G = gridDim.x;
    { const int bx = blockIdx.x; const int vcu = (F.G % 8 == 0) ? (bx % 8) * (F.G / 8) + bx / 8 : bx; F.gw = vcu * NWAVES + F.wave; F.ngw = F.G * NWAVES; }
    F.x = ap->in[0]; F.c = ap->in[1]; F.ctx = ap->in[2]; F.c_ctx = ap->in[3]; F.mod_w = ap->in[4]; F.mod_b = ap->in[5]; F.norm1_g = ap->in[6]; F.norm2_g = ap->in[7];
    F.ab_w_in = ap->in[8]; F.ab_w_out = ap->in[9]; F.na_q_norm = ap->in[10]; F.na_k_norm = ap->in[11]; F.na_rpb = ap->in[12]; F.ret_log_decay = ap->in[13];
    F.swa_w_in = ap->in[14]; F.swa_w_out = ap->in[15]; F.swa_q_norm = ap->in[16]; F.swa_k_norm = ap->in[17]; F.swa_sink = ap->in[18];
    F.peer_w_q = ap->in[19]; F.peer_sub_keys = ap->in[20]; F.peer_u = ap->in[21]; F.peer_v = ap->in[22];
    F.out = ap->out;
    unsigned char* ws = ap->ws;
    F.MOD = (float*)(ws + WS_MOD); F.ROPE = (float*)(ws + WS_ROPE); F.SUBK = (bf16*)(ws + WS_SUBK);
    F.WIN0 = (bf16*)(ws + WS_WIN0); F.WOUT0 = (bf16*)(ws + WS_WOUT0); F.WQ0 = (bf16*)(ws + WS_WQ0); F.WIN1 = (bf16*)(ws + WS_WIN1); F.WOUT1 = (bf16*)(ws + WS_WOUT1); F.WQ1 = (bf16*)(ws + WS_WQ1);
    F.U16 = (bf16*)(ws + WS_U); F.V16 = (bf16*)(ws + WS_V); F.XN = (bf16*)(ws + WS_XN); F.XS = (float*)(ws + WS_XS); F.P = (bf16*)(ws + WS_P); F.Q2 = (bf16*)(ws + WS_Q2);
    F.IDX = (int*)(ws + WS_IDX); F.GATE = (float*)(ws + WS_GATE); F.TAV = (bf16*)(ws + WS_TAV); F.TBK = (bf16*)(ws + WS_TBK); F.TBV = (bf16*)(ws + WS_TBV);
    F.KV = (float*)(ws + WS_KV); F.ST = (bf16*)(ws + WS_ST);
    return F;
}
#define PHASE_CTX const Args* ap_ = (const Args*)__builtin_amdgcn_kernarg_segment_ptr(); asm volatile("" : "+s"(ap_)); const Ctx F = make_ctx(ap_, (LAS unsigned char*)lds_raw); \
    LAS unsigned char* wl = F.lds + F.wave * 16384; (void)wl;

template <int L> __device__ __forceinline__ void peer_phases(int lo, int hi, unsigned char* lds_raw, const XcdBarrier& bar);

__global__ void __launch_bounds__(NTHR, 2) mk_fwd(Args args) {
    extern __shared__ __attribute__((aligned(16))) unsigned char lds_raw[];
    for (int u = threadIdx.x; u < (LDS_BYTES - LDSCTL_OFF) / 4; u += NTHR) ((LAS unsigned*)((LAS unsigned char*)lds_raw + LDSCTL_OFF))[u] = 0u;
    __syncthreads();
    const int lo = args.ph_lo, hi = args.ph_hi;
    const bool multi = (hi - lo) > 1;
    XcdBarrier bar; bar.bar = (unsigned*)(args.ws + WS_CTL) + CW_BAR; bar.x = 0; bar.st = nullptr;
    if (multi) bar = xcd_barrier_post((unsigned*)(args.ws + WS_CTL) + CW_BAR, (volatile LAS unsigned*)((LAS unsigned char*)lds_raw + MISC_OFF) + 8);
#define IN(k) (lo <= (k) && (k) < hi)
#define SEAM(k) do { if (IN(k) && IN((k) + 1)) xcd_barrier(bar); } while (0)

    if (IN(0)) { PHASE_CTX p0_prologue(F); }
    SEAM(0);
    if (IN(1)) { PHASE_CTX mod_phase(F, F.x, F.ctx, MALL, F.norm1_g, F.MOD, 0, 1); }
    SEAM(1);
    if (IN(2)) { PHASE_CTX pg8::Gemm g{F.XN, F.WIN0, MALL, AB_IN, DM}; pg8::StaticOrder S; S.init(MALL, AB_IN, F.G, (int)blockIdx.x);
        pg8::EpiBf16<0> E{F.P, AB_IN, nullptr, 0, 0, 1.f};
        pg8::gemm_phase<pg8::EpiBf16<0>, pg8::StaticOrder, true, true>(F.lds, g, S, E); }
    SEAM(2);
    if (IN(3)) { PHASE_CTX
        for (int it = F.gw; it < 272 * 48; it += F.ngw) {
            const int tt = it / 48, s = it % 48, kind = s >> 3, hd = s & 7;
            PostSlot S;
            S.col = kind * 512 + hd * 64; S.nheads = 8; S.head = hd; S.nw = nullptr; S.rope = 0; S.scale = 1.f; S.tdst = nullptr; S.write_nat = 1;
            if (kind == 0) { S.nw = F.na_q_norm; S.scale = 0.125f; }
            else if (kind == 1) { S.nw = F.na_k_norm; }
            else if (kind == 2) { S.tdst = F.TAV; S.write_nat = 0; }
            else if (kind == 3) { S.rope = 1; S.scale = 0.125f; }
            else if (kind == 4) { S.rope = 1; S.tdst = F.TBK; }
            else { S.tdst = F.TBV; S.write_nat = 0; }
            post_item(F, F.P, AB_IN, tt, S, wl);
        } }
    SEAM(3);
    if (IN(4)) { PHASE_CTX
        for (int u = F.gw; u < 8192; u += F.ngw) { const int cg = u & 3, r = (u >> 2) & 63, h = (u >> 8) & 7, b = u >> 11; na_unit<false>(F, b, h, r, cg); }
        for (int v = F.gw; v < 512; v += F.ngw) { const int qb = v & 15, h = (v >> 4) & 7, b = v >> 7; na_unit<true>(F, b, h, qb, 0); }
        for (int v = F.gw; v < 2176; v += F.ngw) { const int dir = v & 1, pf = (v >> 1) % 34, bh = (v >> 1) / 34; ret_r1_unit(F, bh, pf, dir); } }
    SEAM(4);
    if (IN(5)) { PHASE_CTX ret_r2(F); }
    SEAM(5);
    if (IN(6)) { PHASE_CTX for (int u = F.gw; u < 32 * 34 * 8; u += F.ngw) { const int ib = u & 7, pf = (u >> 3) % 34, bh = (u >> 3) / 34; ret_r3_unit(F, bh, pf, ib); } }
    SEAM(6);
    if (IN(7)) { PHASE_CTX pg8::Gemm g{F.XN, F.WOUT0, MALL, DM, DM}; pg8::StaticOrder S; S.init(MALL, DM, F.G, (int)blockIdx.x);
        pg8::EpiRes E{F.x, F.ctx, F.XS, F.MOD + 2 * 1024};
        pg8::gemm_phase<pg8::EpiRes, pg8::StaticOrder, true, true>(F.lds, g, S, E); }
    SEAM(7);
    peer_phases<0>(lo, hi, lds_raw, bar);
    SEAM(11);
    if (IN(12)) { PHASE_CTX mod_phase(F, F.XS, F.XS + (size_t)MLAT * DM, MALL, F.norm1_g + DM, F.MOD + 5 * MODW, 0, 1); }
    SEAM(12);
    if (IN(13)) { PHASE_CTX pg8::Gemm g{F.XN, F.WIN1, MALL, SWA_IN, DM}; pg8::StaticOrder S; S.init(MALL, SWA_IN, F.G, (int)blockIdx.x);
        pg8::EpiBf16<0> E{F.P, SWA_IN, nullptr, 0, 0, 1.f};
        pg8::gemm_phase<pg8::EpiBf16<0>, pg8::StaticOrder, true, true>(F.lds, g, S, E); }
    SEAM(13);
    if (IN(14)) { PHASE_CTX
        for (int it = F.gw; it < 272 * 24; it += F.ngw) {
            const int tt = it / 24, s = it % 24;
            PostSlot S;
            S.col = s * 64; S.nheads = 4; S.head = s & 3; S.nw = nullptr; S.rope = 0; S.scale = 1.f; S.tdst = nullptr; S.write_nat = 1;
            if (s < 16) { S.nw = F.swa_q_norm; S.rope = 1; S.scale = 0.125f; }
            else if (s < 20) { S.nw = F.swa_k_norm; S.rope = 1; }
            else { S.tdst = F.TAV; S.write_nat = 0; }
            post_item(F, F.P, SWA_IN, tt, S, wl);
        } }
    SEAM(14);
    if (IN(15)) { PHASE_CTX for (int u = F.gw; u < 16384; u += F.ngw) { const int hq = u & 15, qb = (u >> 4) & 255, b = u >> 12; swa_unit(F, b, hq, qb); } }
    SEAM(15);
    if (IN(16)) { PHASE_CTX pg8::Gemm g{F.XN, F.WOUT1, MLAT, DM, DM}; pg8::StaticOrder S; S.init(MLAT, DM, F.G, (int)blockIdx.x);
        pg8::EpiRes E{F.XS, F.XS + (size_t)MLAT * DM, F.XS, F.MOD + 5 * MODW + 2 * 1024};
        pg8::gemm_phase<pg8::EpiRes, pg8::StaticOrder, true, true>(F.lds, g, S, E); }
    SEAM(16);
    peer_phases<1>(lo, hi, lds_raw, bar);
}
template <int L> __device__ __forceinline__ void peer_phases(int lo, int hi, unsigned char* lds_raw, const XcdBarrier& bar) {
    constexpr int q0 = L == 0 ? 8 : 17;
    constexpr int Mp = L == 0 ? MALL : MLAT;
    if (IN(q0)) { PHASE_CTX mod_phase(F, F.XS, F.XS + (size_t)MLAT * DM, Mp, F.norm2_g + (size_t)L * DM, F.MOD + (size_t)L * 5 * MODW, 3, 4); }
    SEAM(q0);
    if (IN(q0 + 1)) { PHASE_CTX pg8::Gemm g{F.XN, L == 0 ? F.WQ0 : F.WQ1, Mp, PQD, DM}; pg8::StaticOrder S; S.init(Mp, PQD, F.G, (int)blockIdx.x);
        pg8::EpiBf16<0> E{F.Q2, PQD, nullptr, 0, 0, 1.f};
        pg8::gemm_phase<pg8::EpiBf16<0>, pg8::StaticOrder, true, true>(F.lds, g, S, E); }
    SEAM(q0 + 1);
    if (IN(q0 + 2)) { PHASE_CTX for (int u = F.gw; u < (Mp / 16) * 8; u += F.ngw) peer_score_unit(F, L, u >> 3, u & 7, (LAS unsigned*)wl); }
    SEAM(q0 + 2);
    if (IN(q0 + 3)) { PHASE_CTX
        const float* mod_l = F.MOD + (size_t)L * 5 * MODW;
        for (int m = F.gw; m < Mp; m += F.ngw) {
            const int cond = m < MLAT ? (m >> 12) : 4;
            float* dst = (L == 1) ? F.out + (size_t)m * DM : F.XS + (size_t)m * DM;
            peer_gather_token(F, L, (size_t)m, mod_l + (size_t)cond * MODW + 5 * 1024, dst);
        } }
}
#undef IN
#undef SEAM

extern "C" void kernel_launch(void* const* d_in, const int* in_sizes, int n_in, void* d_out, int out_size, void* d_ws, size_t ws_size, hipStream_t stream) {
    static int grid = 0;
    if (grid == 0) {
        if (n_in != 23 || out_size != MLAT * DM || ws_size < WS_END) { fprintf(stderr, "kernel_launch: unexpected shapes (n_in %d, out %d, ws %zu); nothing launched\n", n_in, out_size, ws_size); grid = -1; return; }
        int dev = 0, cus = 0, per_cu = 0;
        if (hipGetDevice(&dev) != hipSuccess || hipDeviceGetAttribute(&cus, hipDeviceAttributeMultiprocessorCount, dev) != hipSuccess) { grid = -1; return; }
        if (hipFuncSetAttribute((const void*)mk_fwd, hipFuncAttributeMaxDynamicSharedMemorySize, LDS_BYTES) != hipSuccess) { fprintf(stderr, "kernel_launch: hipFuncSetAttribute failed\n"); grid = -1; return; }
        if (hipOccupancyMaxActiveBlocksPerMultiprocessor(&per_cu, (const void*)mk_fwd, NTHR, LDS_BYTES) != hipSuccess || per_cu < 1) { fprintf(stderr, "kernel_launch: occupancy query says %d\n", per_cu); }
        (void)hipGetLastError();
        grid = cus;
    }
    if (grid < 0) return;
    (void)hipMemsetAsync((char*)d_ws + WS_CTL, 0, CTL_ZERO_BYTES, stream);
    Args a{};
    for (int i = 0; i < 23; ++i) a.in[i] = (const float*)d_in[i];
    a.out = (float*)d_out; a.ws = (unsigned char*)d_ws;
#if MK_N_LAUNCHES == 1
    a.ph_lo = 0; a.ph_hi = NPH;
    hipLaunchKernelGGL(mk_fwd, dim3(grid), dim3(NTHR), LDS_BYTES, stream, a);
#else
    for (int p = 0; p < NPH; ++p) { a.ph_lo = p; a.ph_hi = p + 1; hipLaunchKernelGGL(mk_fwd, dim3(grid), dim3(NTHR), LDS_BYTES, stream, a); }
#endif
}
```

```cpp
#define MK_N_LAUNCHES 1
#define PROBE_MASK 0
#define PROBE_N 1
#define PROBE_HALF 0
#define PROBE_BAR 0
#define USLICE 0
#define USORT 0
#define UMFMA 1
#define VF16 2
#define PROBE_UW 0
#define SCPF 0
#define PROBE_RM 0
#define GEMM_ALIGN true
#define GEMM_SP2 true
#include <hip/hip_runtime.h>
#include <cstdio>
#include <cstdint>
namespace pg8 {
#define PG8_LAS __attribute__((address_space(3)))
#ifndef GAS
#define GAS __attribute__((address_space(1)))
#endif
typedef unsigned short bf16_t;
typedef short bf16x8 __attribute__((ext_vector_type(8)));
typedef float f32x4 __attribute__((ext_vector_type(4)));
typedef unsigned u32x4 __attribute__((ext_vector_type(4)));
constexpr int BM = 256, BK = 64, HALF = 128, HTB = HALF * BK * 2  , STAGE_BYTES = 8 * HTB, NXCD = 8, WGM = 8;

__host__ __device__ __forceinline__ int lds_byte(int r, int c) { const int st = (r >> 4) * 2 + (c >> 5), rr = r & 15, cc = c & 31, ob = rr * 64 + cc * 2; return st * 1024 + (ob ^ (((ob >> 9) & 1) << 5)); }
__host__ __device__ __forceinline__ void stage_rc(int b, int& R, int& C) { const int st = b / 1024, sb = b % 1024, swz = sb ^ (((sb >> 9) & 1) << 5); R = (st >> 1) * 16 + swz / 64; C = (st & 1) * 32 + (swz % 64) / 2; }
__host__ __device__ __forceinline__ int perm32(int rho) { const int n = rho >> 4, i = rho & 15; return 8 * (i >> 2) + 4 * n + (i & 3); }

struct Unit { int pm, pn; };
struct Gemm { const GAS bf16_t* A; const GAS bf16_t* Bt; int M, N, K; };

struct StaticOrder {
    int nM, nN, nwg, G, c;
    __host__ __device__ void init(int M, int N, int G_, int c_) { nM = M / BM; nN = N / BM; nwg = nM * nN; G = G_; c = c_; }
    __host__ __device__ bool next(int i, Unit& u) const {
        const long L = (long)i * G + c; if (L >= nwg) return false;
        int wgid = (int)L; { const int q = nwg / NXCD, r = nwg % NXCD, xcd = wgid % NXCD, off = wgid / NXCD; wgid = (xcd < r ? xcd * (q + 1) : r * (q + 1) + (xcd - r) * q) + off; }
        const int nig = WGM * nN, gid = wgid / nig, fm = gid * WGM, gsz = (nM - fm) < WGM ? (nM - fm) : WGM;
        u.pm = fm + ((wgid % nig) % gsz); u.pn = (wgid % nig) / gsz; return true;
    }
    __device__ __forceinline__ void a_ready(const Unit&) const {}
    __device__ __forceinline__ void done(const Unit&) const {}
};

__device__ __forceinline__ unsigned cvt_pk_bf16(float lo, float hi) { unsigned r; asm volatile("v_cvt_pk_bf16_f32 %0, %1, %2" : "=v"(r) : "v"(lo), "v"(hi)); return r; }
typedef float f32x2 __attribute__((ext_vector_type(2)));
__device__ __forceinline__ f32x2 gelu_pk(f32x2 v) {
    const f32x2 av = __builtin_elementwise_abs(v), d = av * 0.2316418882f + 1.0f;
    f32x2 t; t.x = __builtin_amdgcn_rcpf(d.x); t.y = __builtin_amdgcn_rcpf(d.y);
    f32x2 q = t * 0.5307027145f + (-0.7265760135f); q = q * t + 0.7107068705f; q = q * t + (-0.142248368f); q = q * t + 0.127414796f; q = q * t;
    const f32x2 s = (v * v) * (-0.72134752044f);
    f32x2 e; e.x = __builtin_amdgcn_exp2f(s.x); e.y = __builtin_amdgcn_exp2f(s.y);
    const f32x2 m = v * (q * e), r = v - m;
    f32x2 o; o.x = v.x < 0.f ? m.x : r.x; o.y = v.y < 0.f ? m.y : r.y; return o;
}

template <int ACT  > struct EpiBf16 {
    static constexpr bool PERM = true, AFTER_DRAIN = false; static_assert(ACT == 0 || ACT == 1, "EpiBf16: ACT is 0 (none) or 1 (gelu_pk)");
    GAS bf16_t* O; int ldc; const GAS float* bias; int split_cols; size_t split_stride; float scale0;
    __device__ __forceinline__ void operator()(const f32x4 (&acc)[2][2][4][2], const Unit& u, int wr, int wc, int fr, int fq) const {
        const int row0 = u.pm * BM + wr * 64 + fr; int colt = u.pn * BM; GAS bf16_t* base = O;
        float sc = 1.f; if (split_cols) { const int t = colt / split_cols; base += (size_t)t * split_stride; colt -= t * split_cols; if (t == 0) sc = scale0; }
        const int col0 = colt + wc * 32 + 8 * fq, bcol0 = u.pn * BM + wc * 32 + 8 * fq;
        f32x4 bv[2][2];
#pragma unroll
        for (int bj = 0; bj < 2; ++bj)
#pragma unroll
            for (int n = 0; n < 2; ++n) bv[bj][n] = bias ? *(const GAS f32x4*)(bias + bcol0 + bj * HALF + 4 * n) : (f32x4){0.f, 0.f, 0.f, 0.f};
#pragma unroll
        for (int ai = 0; ai < 2; ++ai)
#pragma unroll
            for (int m = 0; m < 4; ++m) { GAS bf16_t* rowp = base + (size_t)(row0 + ai * HALF + m * 16) * ldc + col0;
#pragma unroll
                for (int bj = 0; bj < 2; ++bj) { f32x4 v0 = acc[ai][bj][m][0] + bv[bj][0], v1 = acc[ai][bj][m][1] + bv[bj][1];
                    if (ACT == 1) { f32x2 a = gelu_pk((f32x2){v0[0], v0[1]}), b = gelu_pk((f32x2){v0[2], v0[3]}), c = gelu_pk((f32x2){v1[0], v1[1]}), d = gelu_pk((f32x2){v1[2], v1[3]});
                        v0 = (f32x4){a.x, a.y, b.x, b.y}; v1 = (f32x4){c.x, c.y, d.x, d.y}; }
                    v0 = v0 * sc; v1 = v1 * sc; u32x4 w; w.x = cvt_pk_bf16(v0[0], v0[1]); w.y = cvt_pk_bf16(v0[2], v0[3]); w.z = cvt_pk_bf16(v1[0], v1[1]); w.w = cvt_pk_bf16(v1[2], v1[3]);
                    *(GAS u32x4*)(rowp + bj * HALF) = w; } }
    }
};

template <bool BASEB> struct EpiRes {
    static constexpr bool PERM = false, AFTER_DRAIN = false;
    const GAS float* base_lat; const GAS float* base_ctx; GAS bf16_t* xs; const GAS float* gate;
    __device__ __forceinline__ void operator()(const f32x4 (&acc)[2][2][4][2], const Unit& u, int wr, int wc, int fr, int fq) const {
        typedef unsigned u32x2e __attribute__((ext_vector_type(2)));
        const int rowt = u.pm * BM;
        const int cond = rowt < 16384 ? (rowt >> 12) : 4;
        const GAS float* g = gate + (size_t)cond * 6144;
        const int col0 = u.pn * BM + wc * 32 + 4 * fq;
        f32x4 gv[2][2];
#pragma unroll
        for (int bj = 0; bj < 2; ++bj)
#pragma unroll
            for (int n = 0; n < 2; ++n) gv[bj][n] = *(const GAS f32x4*)(g + col0 + bj * HALF + n * 16);
#pragma unroll
        for (int ai = 0; ai < 2; ++ai)
#pragma unroll
            for (int m = 0; m < 4; ++m) {
                const int r = rowt + ai * HALF + wr * 64 + m * 16 + fr;
                const GAS float* bp = r < 16384 ? base_lat + (size_t)r * 1024 : base_ctx + (size_t)(r - 16384) * 1024;
                GAS bf16_t* op = xs + (size_t)r * 1024;
#pragma unroll
                for (int bj = 0; bj < 2; ++bj)
#pragma unroll
                    for (int n = 0; n < 2; ++n) {
                        const int off = col0 + bj * HALF + n * 16;
                        f32x4 bs;
                        if (BASEB) { const u32x2e w = *(const GAS u32x2e*)(op + off); bs = (f32x4){__uint_as_float(w.x << 16), __uint_as_float(w.x & 0xffff0000u), __uint_as_float(w.y << 16), __uint_as_float(w.y & 0xffff0000u)}; }
                        else bs = *(const GAS f32x4*)(bp + off);
                        const f32x4 o = bs + gv[bj][n] * acc[ai][bj][m][n];
                        u32x2e w; w.x = cvt_pk_bf16(o[0], o[1]); w.y = cvt_pk_bf16(o[2], o[3]);
                        *(GAS u32x2e*)(op + off) = w;
                    }
            }
    }
};

template <class Epi, class Sched, bool ALIGN_EPI = false, bool SP2 = false>
__device__ __forceinline__ void gemm_phase(PG8_LAS unsigned char* lds, const Gemm g, const Sched& S, const Epi& E) {
    const int tid = threadIdx.x, wid = __builtin_amdgcn_readfirstlane(tid >> 6), lane = tid & 63, wr = wid >> 2, wc = wid & 3, fr = lane & 15, fq = lane >> 4;
    const int K = g.K, nt = K / BK;
    unsigned voffA[2], voffB[2];
#pragma unroll
    for (int i = 0; i < 2; ++i) { int R, C; stage_rc(tid * 16 + i * 8192, R, C); const int Rb = Epi::PERM ? ((R & ~31) + perm32(R & 31)) : R;
        voffA[i] = (unsigned)(R * K + C) * 2u; voffB[i] = (unsigned)(Rb * K + C) * 2u; }
    const size_t kstep = (size_t)(BK * 2);
    const size_t hstep = (size_t)HALF * K * 2;
    const size_t tstep = 2 * hstep;
    const unsigned ldsw = (unsigned)wid * 1024u;
    const int aoff = lds_byte(wr * 64 + fr, fq * 8), boff = lds_byte(wc * 32 + fr, fq * 8);
#define PG8_SA(b, h) (((b) * 2 + (h)) * HTB)
#define PG8_SB(b, h) ((4 + (b) * 2 + (h)) * HTB)
#define PG8_STAGE(bufoff, gbase, voff) do { _Pragma("unroll") for (int _i = 0; _i < 2; ++_i) \
        __builtin_amdgcn_global_load_lds((const unsigned*)((const char*)(gbase) + (voff)[_i]), (PG8_LAS unsigned*)(lds + (bufoff) + ldsw + _i * 8192), 16, 0, 0); } while (0)
#define PG8_LDA(dst, b, h) do { _Pragma("unroll") for (int m = 0; m < 4; ++m) _Pragma("unroll") for (int k = 0; k < 2; ++k) dst[m][k] = *(const PG8_LAS bf16x8*)(lds + PG8_SA(b, h) + aoff + m * 2048 + k * 1024); } while (0)
#define PG8_LDB(dst, b, h) do { _Pragma("unroll") for (int n = 0; n < 2; ++n) _Pragma("unroll") for (int k = 0; k < 2; ++k) dst[n][k] = *(const PG8_LAS bf16x8*)(lds + PG8_SB(b, h) + boff + n * 2048 + k * 1024); } while (0)
#define PG8_MMA(ai, bj, At, Bt) do { __builtin_amdgcn_s_setprio(1); _Pragma("unroll") for (int m = 0; m < 4; ++m) _Pragma("unroll") for (int n = 0; n < 2; ++n) _Pragma("unroll") for (int k = 0; k < 2; ++k) \
        acc[ai][bj][m][n] = __builtin_amdgcn_mfma_f32_16x16x32_bf16(Bt[n][k], At[m][k], acc[ai][bj][m][n], 0, 0, 0); __builtin_amdgcn_s_setprio(0); } while (0)
#define PG8_WAIT_V(n) asm volatile("s_waitcnt vmcnt(" #n ")" ::: "memory")
#define PG8_WAIT_L(n) asm volatile("s_waitcnt lgkmcnt(" #n ")" ::: "memory")
#define PG8_BAR __builtin_amdgcn_s_barrier()
#define PG8_SCHED __builtin_amdgcn_sched_barrier(0)
    Unit cur, nxt; int ui = 0;
    if (!S.next(0, cur)) return;
    f32x4 acc[2][2][4][2];
#pragma unroll
    for (int a = 0; a < 2; ++a)
#pragma unroll
        for (int b = 0; b < 2; ++b)
#pragma unroll
            for (int m = 0; m < 4; ++m)
#pragma unroll
                for (int n = 0; n < 2; ++n) acc[a][b][m][n] = (f32x4){0.f, 0.f, 0.f, 0.f};
    bf16x8 At[4][2], B0[2][2], B1[2][2];
    const char* cA = (const char*)g.A + (size_t)cur.pm * tstep; const char* cB = (const char*)g.Bt + (size_t)cur.pn * tstep;
    S.a_ready(cur);
    if constexpr (SP2) {
        PG8_STAGE(PG8_SB(0, 0), cB, voffB); PG8_STAGE(PG8_SB(0, 1), cB + hstep, voffB); PG8_STAGE(PG8_SA(0, 0), cA, voffA); PG8_STAGE(PG8_SA(0, 1), cA + hstep, voffA);
        if (wr == 1) PG8_BAR;
        PG8_WAIT_V(2); PG8_BAR;
        PG8_STAGE(PG8_SB(1, 0), cB + kstep, voffB); PG8_STAGE(PG8_SA(1, 0), cA + kstep, voffA); PG8_STAGE(PG8_SB(1, 1), cB + hstep + kstep, voffB);
        PG8_WAIT_V(6); PG8_BAR;
    } else {
        PG8_STAGE(PG8_SB(0, 0), cB, voffB); PG8_STAGE(PG8_SA(0, 0), cA, voffA); PG8_STAGE(PG8_SB(0, 1), cB + hstep, voffB); PG8_STAGE(PG8_SA(0, 1), cA + hstep, voffA);
        if (wr == 1) PG8_BAR;
        PG8_WAIT_V(4); PG8_BAR;
        PG8_STAGE(PG8_SB(1, 0), cB + kstep, voffB); PG8_STAGE(PG8_SA(1, 0), cA + kstep, voffA); PG8_STAGE(PG8_SB(1, 1), cB + hstep + kstep, voffB);
        PG8_WAIT_V(6); PG8_BAR;
    }
    for (;;) {
        const bool has_next = S.next(ui + 1, nxt);
        const char* nA = has_next ? (const char*)g.A + (size_t)nxt.pm * tstep : cA; const char* nB = has_next ? (const char*)g.Bt + (size_t)nxt.pn * tstep : cB;
        for (int t = 0; t < nt; t += 2) {
            const bool last = (t == nt - 2);
            const char* a1 = cA + (size_t)(t + 1) * kstep;
            const char* a2 = last ? nA : cA + (size_t)(t + 2) * kstep; const char* b2 = last ? nB : cB + (size_t)(t + 2) * kstep;
            const char* a3 = a2 + kstep; const char* b3 = b2 + kstep;
            if (last && has_next) S.a_ready(nxt);
            if constexpr (SP2) {
            PG8_LDB(B0, 0, 0); PG8_LDB(B1, 0, 1); PG8_SCHED; PG8_LDA(At, 0, 0); PG8_STAGE(PG8_SA(1, 1), a1 + hstep, voffA);
            PG8_WAIT_V(8); PG8_WAIT_L(0); PG8_BAR; PG8_MMA(0, 0, At, B0); PG8_MMA(0, 1, At, B1); PG8_BAR; PG8_SCHED;
            PG8_LDA(At, 0, 1); PG8_STAGE(PG8_SB(0, 0), b2, voffB); PG8_STAGE(PG8_SB(0, 1), b2 + hstep, voffB); PG8_STAGE(PG8_SA(0, 0), a2, voffA);
            PG8_WAIT_V(8); PG8_WAIT_L(0); PG8_BAR; PG8_MMA(1, 0, At, B0); PG8_MMA(1, 1, At, B1); PG8_BAR; PG8_SCHED;
            PG8_LDB(B0, 1, 0); PG8_LDB(B1, 1, 1); PG8_SCHED; PG8_LDA(At, 1, 0); PG8_STAGE(PG8_SA(0, 1), a2 + hstep, voffA);
            PG8_WAIT_V(8); PG8_WAIT_L(0); PG8_BAR; PG8_MMA(0, 0, At, B0); PG8_MMA(0, 1, At, B1); PG8_BAR; PG8_SCHED;
            PG8_LDA(At, 1, 1); PG8_STAGE(PG8_SB(1, 0), b3, voffB); PG8_STAGE(PG8_SB(1, 1), b3 + hstep, voffB); PG8_STAGE(PG8_SA(1, 0), a3, voffA);
            PG8_WAIT_V(8); PG8_WAIT_L(0); PG8_BAR; PG8_MMA(1, 0, At, B0); PG8_MMA(1, 1, At, B1); PG8_BAR; PG8_SCHED;
            } else {
            PG8_LDB(B0, 0, 0); PG8_SCHED; PG8_LDA(At, 0, 0); PG8_STAGE(PG8_SA(1, 1), a1 + hstep, voffA);
            PG8_WAIT_L(8); PG8_BAR; PG8_WAIT_L(0); PG8_MMA(0, 0, At, B0); PG8_BAR; PG8_SCHED;
            PG8_LDB(B1, 0, 1); PG8_STAGE(PG8_SB(0, 0), b2, voffB);
            PG8_BAR; PG8_WAIT_L(0); PG8_MMA(0, 1, At, B1); PG8_BAR;
            PG8_LDA(At, 0, 1); PG8_STAGE(PG8_SA(0, 0), a2, voffA);
            PG8_BAR; PG8_WAIT_L(0); PG8_MMA(1, 0, At, B0); PG8_BAR; PG8_SCHED;
            PG8_STAGE(PG8_SB(0, 1), b2 + hstep, voffB);
            PG8_WAIT_V(6); PG8_BAR; PG8_MMA(1, 1, At, B1); PG8_BAR;
            PG8_LDB(B0, 1, 0); PG8_SCHED; PG8_LDA(At, 1, 0); PG8_STAGE(PG8_SA(0, 1), a2 + hstep, voffA);
            PG8_WAIT_L(8); PG8_BAR; PG8_WAIT_L(0); PG8_MMA(0, 0, At, B0); PG8_BAR; PG8_SCHED;
            PG8_LDB(B1, 1, 1); PG8_STAGE(PG8_SB(1, 0), b3, voffB);
            PG8_BAR; PG8_WAIT_L(0); PG8_MMA(0, 1, At, B1); PG8_BAR;
            PG8_LDA(At, 1, 1); PG8_STAGE(PG8_SA(1, 0), a3, voffA);
            PG8_BAR; PG8_WAIT_L(0); PG8_MMA(1, 0, At, B0); PG8_BAR; PG8_SCHED;
            PG8_STAGE(PG8_SB(1, 1), b3 + hstep, voffB);
            PG8_WAIT_V(6); PG8_BAR; PG8_MMA(1, 1, At, B1); PG8_BAR;
            }
        }
        if constexpr (ALIGN_EPI) { if (wr == 0) PG8_BAR; }
        if constexpr (!Epi::AFTER_DRAIN) { E(acc, cur, wr, wc, fr, fq); S.done(cur); }
        if (!has_next) break;
#pragma unroll
        for (int a = 0; a < 2; ++a)
#pragma unroll
            for (int b = 0; b < 2; ++b)
#pragma unroll
                for (int m = 0; m < 4; ++m)
#pragma unroll
                    for (int n = 0; n < 2; ++n) acc[a][b][m][n] = (f32x4){0.f, 0.f, 0.f, 0.f};
        cur = nxt; cA = nA; cB = nB; ++ui;
        if constexpr (ALIGN_EPI) { if (wr == 1) PG8_BAR; }
    }
    PG8_WAIT_V(0);
    if constexpr (!ALIGN_EPI) { if (wr == 0) PG8_BAR; }
    PG8_BAR;
    if constexpr (Epi::AFTER_DRAIN) { E.fused(acc, cur, wr, wc, fr, fq, lds, wid, lane); S.done(cur); }
#undef PG8_SA
#undef PG8_SB
#undef PG8_STAGE
#undef PG8_LDA
#undef PG8_LDB
#undef PG8_MMA
#undef PG8_WAIT_V
#undef PG8_WAIT_L
#undef PG8_BAR
#undef PG8_SCHED
}
}
#define GAS __attribute__((address_space(1)))
#define LAS __attribute__((address_space(3)))
typedef unsigned short bf16;
typedef unsigned v4u __attribute__((ext_vector_type(4)));
typedef float f32x4 __attribute__((ext_vector_type(4)));
typedef short bf16x8 __attribute__((ext_vector_type(8)));
typedef GAS unsigned gu32;
typedef GAS unsigned long long gu64;
#define RLX_AGENT __ATOMIC_RELAXED, __HIP_MEMORY_SCOPE_AGENT
#define LDS_WAIT() asm volatile("s_waitcnt lgkmcnt(0)" ::: "memory")
#define VM_WAIT() asm volatile("s_waitcnt vmcnt(0)" ::: "memory")
__device__ __forceinline__ unsigned long long rt() { return __builtin_amdgcn_s_memrealtime(); }
__device__ __forceinline__ unsigned f2bf(float f) { unsigned u = __builtin_bit_cast(unsigned, f); return (u + 0x7fffu + ((u >> 16) & 1u)) >> 16; }
typedef float pk2_f2_t __attribute__((ext_vector_type(2))); typedef __bf16 pk2_b2_t __attribute__((ext_vector_type(2)));
__device__ __forceinline__ unsigned pk2(float lo, float hi) { pk2_f2_t v = {lo, hi}; return __builtin_bit_cast(unsigned, __builtin_convertvector(v, pk2_b2_t)); }

#define XB_TMO      128
#define XB_XCNT(j)  (256  + 64 * (j))
#define XB_XSUB(j)  (1280 + 64 * (j))
#define XB_XGEN(j)  (2304 + 64 * (j))
#define XB_TOP      3328
#define XB_TOPGEN   3392
#define XCD_BAR_WORDS 3456
#define XB_SPIN_CAP (1u << 18)

__device__ __forceinline__ unsigned xb_ld(unsigned* p)              { return __hip_atomic_load(p, __ATOMIC_RELAXED, __HIP_MEMORY_SCOPE_AGENT); }
__device__ __forceinline__ unsigned xb_add(unsigned* p, unsigned v) { return __hip_atomic_fetch_add(p, v, __ATOMIC_RELAXED, __HIP_MEMORY_SCOPE_AGENT); }
__device__ __forceinline__ unsigned xb_xcc_id() { return (unsigned)__builtin_amdgcn_s_getreg((3 << 11) | 20) & 0xFu; }
#define XB_SPIN(cond, bar) do { unsigned _sp = 0; while (cond) { __builtin_amdgcn_s_sleep(1); \
    if ((++_sp & 255u) == 0u) { if (xb_ld(&(bar)[XB_TMO])) break; if (_sp > XB_SPIN_CAP) { atomicAdd(&(bar)[XB_TMO], 1u); break; } } } } while (0)

struct XcdBarrier {
    unsigned* bar; unsigned x;
    volatile LAS unsigned* st;
};

__device__ __forceinline__ XcdBarrier xcd_barrier_post(unsigned* bar, volatile LAS unsigned* st) {
    XcdBarrier b; b.bar = bar; b.x = xb_xcc_id(); b.st = st;
    if (threadIdx.x == 0) (void)xb_add(&bar[XB_XCNT(b.x)], 1u);
    return b;
}
__device__ __forceinline__ void xcd_barrier_complete(unsigned* bar, unsigned x, unsigned& nloc, unsigned& nx) {
    const unsigned G = gridDim.x * gridDim.y * gridDim.z;
    unsigned sum, cnt, mine, sp = 0u;
    for (;;) {
        sum = 0u; cnt = 0u; mine = 0u;
#pragma unroll
        for (unsigned j = 0; j < 16; ++j) { const unsigned c = xb_ld(&bar[XB_XCNT(j)]); sum += c; cnt += (c > 0u) ? 1u : 0u; mine = (j == x) ? c : mine; }
        if (sum == G) break;
        __builtin_amdgcn_s_sleep(1);
        if ((++sp & 255u) == 0u) { if (xb_ld(&bar[XB_TMO])) break; if (sp > XB_SPIN_CAP) { atomicAdd(&bar[XB_TMO], 1u); break; } }
    }
    nloc = mine > 0u ? mine : 1u; nx = cnt > 0u ? cnt : 1u;
}

__device__ __forceinline__ void xcd_barrier(const XcdBarrier& b) {
    asm volatile("s_waitcnt vmcnt(0)" ::: "memory");
    __syncthreads();
    if (threadIdx.x == 0) {
        unsigned* bar = b.bar;
        __builtin_amdgcn_s_waitcnt(0);
        unsigned nloc = b.st[0], nx = b.st[1];
        if (nloc == 0u) { xcd_barrier_complete(bar, b.x, nloc, nx); b.st[0] = nloc; b.st[1] = nx; }
        const unsigned old = xb_add(&bar[XB_XSUB(b.x)], 1u);
        const unsigned gen = old / nloc;
        if (old + 1u == (gen + 1u) * nloc) {
            __builtin_amdgcn_fence(__ATOMIC_RELEASE, "agent");
            asm volatile("s_waitcnt vmcnt(0)" ::: "memory");
            const unsigned og = xb_add(&bar[XB_TOP], 1u);
            const unsigned tg = og / nx;
            if (og + 1u == (tg + 1u) * nx) xb_add(&bar[XB_TOPGEN], 1u);
            else XB_SPIN(xb_ld(&bar[XB_TOPGEN]) == tg, bar);
            __builtin_amdgcn_fence(__ATOMIC_ACQUIRE, "agent");
            xb_add(&bar[XB_XGEN(b.x)], 1u);
            asm volatile("s_waitcnt vmcnt(0)" ::: "memory");
        } else {
            XB_SPIN(xb_ld(&bar[XB_XGEN(b.x)]) == gen, bar);
            __builtin_amdgcn_fence(__ATOMIC_ACQUIRE, "agent");
            asm volatile("s_waitcnt vmcnt(0)" ::: "memory");
        }
    }
    __syncthreads();
}
constexpr int NWAVES = 8, NTHR = 512;
constexpr int DM = 1024, NBATCH = 4, SEQ = 4096, CL = 256;
constexpr int MLAT = NBATCH * SEQ, MCTX = NBATCH * CL, MALL = MLAT + MCTX;
constexpr int AB_IN = 3584, SWA_IN = 1536, PQD = 2048, MODW = 6144;
constexpr size_t MiB = 1u << 20;
#ifndef U_FP4
#define U_FP4 1
#endif
#ifndef V_FP4
#define V_FP4 1
#endif
constexpr int U_ROWB = U_FP4 ? 512 : 768, V_ROWB = V_FP4 ? 512 : 768;
constexpr size_t WS_CTL = 0, CTL_ZERO_BYTES = 1 * MiB;
constexpr size_t WS_MOD = 1 * MiB;
constexpr size_t WS_ROPE = 1 * MiB + 512 * 1024;
constexpr size_t WS_SU = 1 * MiB + 640 * 1024, WS_SV = 1 * MiB + 768 * 1024;
constexpr size_t WS_SUBK = 2 * MiB;
constexpr size_t WS_WIN0 = 4 * MiB, WS_WOUT0 = 11 * MiB, WS_WQ0 = 13 * MiB, WS_WIN1 = 17 * MiB, WS_WOUT1 = 20 * MiB, WS_WQ1 = 22 * MiB;
constexpr size_t WS_U = 32 * MiB, WS_V = 96 * MiB;
constexpr size_t WS_XN = 160 * MiB;
constexpr size_t WS_XS = 194 * MiB;
constexpr size_t WS_P = 262 * MiB;
constexpr size_t WS_Q2 = 262 * MiB;
constexpr size_t WS_IDX = 330 * MiB, WS_GATE = 339 * MiB;
constexpr size_t WS_TAV = 381 * MiB, WS_TBK = 398 * MiB, WS_TBV = 415 * MiB;
constexpr size_t WS_KV = 432 * MiB;
constexpr size_t WS_ST = 466 * MiB;
constexpr size_t WS_END = 483 * MiB;
constexpr int CW_BAR = 4096;

typedef unsigned v2u __attribute__((ext_vector_type(2)));
typedef __bf16 bf16x2_t __attribute__((ext_vector_type(2)));
__device__ __forceinline__ float bflo(unsigned u) { return __uint_as_float(u << 16); }
__device__ __forceinline__ float bfhi(unsigned u) { return __uint_as_float(u & 0xffff0000u); }
__device__ __forceinline__ float bf1(bf16 u) { return __uint_as_float((unsigned)u << 16); }
__device__ __forceinline__ v4u ld16(const GAS bf16* p) { return *(const GAS v4u*)p; }
__device__ __forceinline__ bf16x8 ldfrag(const GAS bf16* p) { return __builtin_bit_cast(bf16x8, *(const GAS v4u*)p); }
__device__ __forceinline__ f32x4 mfma16(bf16x8 a, bf16x8 b, f32x4 c) { return __builtin_amdgcn_mfma_f32_16x16x32_bf16(a, b, c, 0, 0, 0); }
__device__ __forceinline__ float wave_sum(float v) {
#pragma unroll
    for (int o = 1; o < 64; o <<= 1) v += __shfl_xor(v, o);
    return v;
}
__device__ __forceinline__ float fexp2(float x) { return __builtin_amdgcn_exp2f(x); }
__device__ __forceinline__ float fexp(float x) { return __builtin_amdgcn_exp2f(x * 1.4426950408889634f); }
__device__ __forceinline__ bf16x8 pack8(const f32x4& a, const f32x4& b) {
    v4u w; w.x = pk2(a[0], a[1]); w.y = pk2(a[2], a[3]); w.z = pk2(b[0], b[1]); w.w = pk2(b[2], b[3]);
    return __builtin_bit_cast(bf16x8, w);
}
__device__ __forceinline__ float dot2bf(unsigned a, unsigned b, float acc) {
    return __builtin_amdgcn_fdot2_f32_bf16(__builtin_bit_cast(bf16x2_t, a), __builtin_bit_cast(bf16x2_t, b), acc, false);
}
__device__ __forceinline__ float gelu_erf(float v) {
    const float av = fabsf(v), d = av * 0.2316418882f + 1.0f;
    const float t = __builtin_amdgcn_rcpf(d);
    float q = t * 0.5307027145f + (-0.7265760135f); q = q * t + 0.7107068705f; q = q * t + (-0.142248368f); q = q * t + 0.127414796f; q = q * t;
    const float e = __builtin_amdgcn_exp2f((v * v) * (-0.72134752044f));
    const float m = v * (q * e), r = v - m;
    return v < 0.f ? m : r;
}

struct Ctx {
    LAS unsigned char* lds;
    int tid, lane, wave, gw, ngw, G;
    const GAS float *x, *c, *ctx, *c_ctx, *mod_w, *mod_b, *norm1_g, *norm2_g, *ab_w_in, *ab_w_out, *na_q_norm, *na_k_norm, *na_rpb, *ret_log_decay,
                *swa_w_in, *swa_w_out, *swa_q_norm, *swa_k_norm, *swa_sink, *peer_w_q, *peer_sub_keys, *peer_u, *peer_v;
    GAS float* out;
    GAS float* MOD; GAS float* ROPE; GAS bf16* SUBK; GAS bf16 *WIN0, *WOUT0, *WQ0, *WIN1, *WOUT1, *WQ1; GAS unsigned char *U8, *V8; GAS float *SU, *SV; GAS bf16* XN; GAS bf16* XS; GAS bf16* P; GAS bf16* Q2;
    GAS int* IDX; GAS float* GATE; GAS bf16 *TAV, *TBK, *TBV; GAS float* KV; GAS bf16* ST;
};

__device__ __forceinline__ void p0_transpose_item(const GAS float* W, int K, int N, GAS bf16* WT, LAS float* scr, int item, int lane) {
    const int nblk = N / 32, kb = item / nblk, nb = item % nblk, k0 = 64 * kb, n0 = 32 * nb;
#pragma unroll 8
    for (int i = 0; i < 32; ++i) { const int kk = 2 * i + (lane >> 5); scr[kk * 33 + (lane & 31)] = W[(size_t)(k0 + kk) * N + n0 + (lane & 31)]; }
    LDS_WAIT(); asm volatile("" ::: "memory");
    const int c = lane & 7;
#pragma unroll
    for (int j = 0; j < 4; ++j) { const int n = (lane >> 3) + 8 * j; const LAS float* s = scr + (8 * c) * 33 + n;
        v4u o; o.x = pk2(s[0 * 33], s[1 * 33]); o.y = pk2(s[2 * 33], s[3 * 33]); o.z = pk2(s[4 * 33], s[5 * 33]); o.w = pk2(s[6 * 33], s[7 * 33]);
        *(GAS v4u*)(WT + (size_t)(n0 + n) * K + k0 + 8 * c) = o; }
    LDS_WAIT(); asm volatile("" ::: "memory");
}
__device__ __forceinline__ void p0_convert(const Ctx& F, const GAS float* src, GAS bf16* dst, size_t n8) {
    const size_t gt = (size_t)F.gw * 64 + F.lane, NT = (size_t)F.ngw * 64;
    for (size_t i = gt; i < n8; i += NT) {
        const f32x4 a = *(const GAS f32x4*)(src + i * 8), b = *(const GAS f32x4*)(src + i * 8 + 4);
        v4u o; o.x = pk2(a[0], a[1]); o.y = pk2(a[2], a[3]); o.z = pk2(b[0], b[1]); o.w = pk2(b[2], b[3]);
        *(GAS v4u*)(dst + i * 8) = o;
    }
}

#ifndef FP6_PACK_INTERLEAVED
#define FP6_PACK_INTERLEAVED 1
#endif
typedef float f32x16v __attribute__((ext_vector_type(16)));
typedef float f32x32v __attribute__((ext_vector_type(32)));
typedef unsigned u32x6v __attribute__((ext_vector_type(6)));
__device__ __forceinline__ void convert_fp6_rows(const Ctx& F, int rbeg, int rend) {
    const int q = F.lane & 31, hf = F.lane >> 5;
    for (int R0 = rbeg + F.wave * 2; R0 < rend; R0 += NWAVES * 2) {
        const int R = R0 + hf;
        if (R >= rend) continue;
        const bool isv = R >= 32768; const int r = R & 32767;
        const GAS float* xr = (isv ? F.peer_v : F.peer_u) + (size_t)r * 1024 + 32 * q;
        f32x16v a, b; float am = 0.f;
#pragma unroll
        for (int j = 0; j < 4; ++j) { const f32x4 v = *(const GAS f32x4*)(xr + 4 * j); a[4 * j] = v[0]; a[4 * j + 1] = v[1]; a[4 * j + 2] = v[2]; a[4 * j + 3] = v[3];
            am = fmaxf(fmaxf(fmaxf(fabsf(v[0]), fabsf(v[1])), fmaxf(fabsf(v[2]), fabsf(v[3]))), am); }
#pragma unroll
        for (int j = 0; j < 4; ++j) { const f32x4 v = *(const GAS f32x4*)(xr + 16 + 4 * j); b[4 * j] = v[0]; b[4 * j + 1] = v[1]; b[4 * j + 2] = v[2]; b[4 * j + 3] = v[3];
            am = fmaxf(fmaxf(fmaxf(fabsf(v[0]), fabsf(v[1])), fmaxf(fabsf(v[2]), fabsf(v[3]))), am); }
#pragma unroll
        for (int o = 1; o < 32; o <<= 1) am = fmaxf(am, __shfl_xor(am, o));
        const bool fp4 = isv ? (V_FP4 != 0) : (U_FP4 != 0);
        const float sc = am > 0.f ? am * (fp4 ? (1.0f / 6.0f) : (1.0f / 7.5f)) : 1.0f, inv = 1.0f / sc;
        a = a * inv; b = b * inv;
        if (fp4) {
            v4u o;
#pragma unroll
            for (int d = 0; d < 4; ++d) { unsigned pk = 0;
#define X_(e) ((e) < 16 ? a[(e) & 15] : b[(e) & 15])
                pk = __builtin_amdgcn_cvt_scalef32_pk_fp4_f32(pk, X_(8 * d + 0), X_(8 * d + 1), 1.0f, 0);
                pk = __builtin_amdgcn_cvt_scalef32_pk_fp4_f32(pk, X_(8 * d + 2), X_(8 * d + 3), 1.0f, 1);
                pk = __builtin_amdgcn_cvt_scalef32_pk_fp4_f32(pk, X_(8 * d + 4), X_(8 * d + 5), 1.0f, 2);
                pk = __builtin_amdgcn_cvt_scalef32_pk_fp4_f32(pk, X_(8 * d + 6), X_(8 * d + 7), 1.0f, 3);
#undef X_
                o[d] = pk; }
            *(GAS v4u*)((isv ? F.V8 : F.U8) + (size_t)r * 512 + 16 * q) = o;
        } else {
        { f32x16v a2, b2;
#pragma unroll
          for (int i = 0; i < 8; ++i) { a2[i] = a[2 * i]; b2[i] = a[2 * i + 1]; a2[8 + i] = b[2 * i]; b2[8 + i] = b[2 * i + 1]; }
          a = a2; b = b2; }
        const u32x6v pk = __builtin_amdgcn_cvt_scalef32_2xpk16_fp6_f32(a, b, 1.0f);
        GAS unsigned* dp = (GAS unsigned*)((isv ? F.V8 : F.U8) + (size_t)r * 768 + 24 * q);
        *(GAS v2u*)dp = (v2u){pk[0], pk[1]}; *(GAS v2u*)(dp + 2) = (v2u){pk[2], pk[3]}; *(GAS v2u*)(dp + 4) = (v2u){pk[4], pk[5]};
        }
        if (q == 0) { if (isv) F.SV[r] = sc; else F.SU[r] = sc; }
    }
}
__device__ __forceinline__ int idle_slot(int nwg, int G, int c, int& nslots) {
    const int mx = (nwg + G - 1) / G, full = nwg - (mx - 1) * G;
    nslots = G - full;
    if (nslots == 0) { nslots = G; return c; }
    return c >= full ? c - full : -1;
}
__device__ __forceinline__ void side_transposes(const Ctx& F, int slot, int nslots) {
    LAS float* scr = (LAS float*)(F.lds + F.wave * 16384);
    constexpr int I_O = 16 * 32, I_Q = 16 * (PQD / 32), I_IN1 = 16 * (SWA_IN / 32);
    constexpr int NITEMS = I_O + I_Q + I_IN1 + I_O + I_Q;
    for (int it = slot * NWAVES + F.wave; it < NITEMS; it += nslots * NWAVES) {
        int r = it;
        if (r < I_O) { p0_transpose_item(F.ab_w_out, DM, DM, F.WOUT0, scr, r, F.lane); continue; } r -= I_O;
        if (r < I_Q) { p0_transpose_item(F.peer_w_q, DM, PQD, F.WQ0, scr, r, F.lane); continue; } r -= I_Q;
        if (r < I_IN1) { p0_transpose_item(F.swa_w_in, DM, SWA_IN, F.WIN1, scr, r, F.lane); continue; } r -= I_IN1;
        if (r < I_O) { p0_transpose_item(F.swa_w_out, DM, DM, F.WOUT1, scr, r, F.lane); continue; } r -= I_O;
        p0_transpose_item(F.peer_w_q + (size_t)DM * PQD, DM, PQD, F.WQ1, scr, r, F.lane);
    }
}
__device__ __forceinline__ void side_convert(const Ctx& F, int part) {
    int n7, n9; const int s7 = idle_slot((MALL / 256) * (DM / 256), F.G, (int)blockIdx.x, n7), s9 = idle_slot((MALL / 256) * (PQD / 256), F.G, (int)blockIdx.x, n9);
    const int slot = part == 0 ? s7 : (s9 < 0 ? -1 : n7 + s9);
    if (slot < 0) return;
    const int per = (65536 + n7 + n9 - 1) / (n7 + n9);
    const int rbeg = min(slot * per, 65536), rend = min(rbeg + per, 65536);
    convert_fp6_rows(F, rbeg, rend);
}
__device__ __forceinline__ void p0_prologue(const Ctx& F) {
    if (blockIdx.x < 192) {
        const int l = blockIdx.x / 96, cb = blockIdx.x % 96, col = cb * 64 + F.lane;
        LAS float* s = (LAS float*)F.lds;
        LAS float* part = (LAS float*)(F.lds + 20480);
        for (int i = F.tid; i < 5120; i += NTHR) { const int r = i >> 10, k = i & 1023; const float cv = r < 4 ? F.c[r * 1024 + k] : F.c_ctx[k]; s[i] = cv / (1.f + __expf(-cv)); }
        __syncthreads();
        float acc[5] = {0.f, 0.f, 0.f, 0.f, 0.f};
        const GAS float* wp = F.mod_w + ((size_t)l * 1024 + F.wave * 128) * MODW + col;
#pragma unroll 32
        for (int k = 0; k < 128; ++k) { const float wv = wp[(size_t)k * MODW];
#pragma unroll
            for (int r = 0; r < 5; ++r) acc[r] += s[r * 1024 + F.wave * 128 + k] * wv; }
#pragma unroll
        for (int r = 0; r < 5; ++r) part[(F.wave * 5 + r) * 64 + F.lane] = acc[r];
        __syncthreads();
        if (F.wave < 5) { float t = F.mod_b[l * MODW + col];
#pragma unroll
            for (int w = 0; w < 8; ++w) t += part[(w * 5 + F.wave) * 64 + F.lane];
            F.MOD[(size_t)(l * 5 + F.wave) * MODW + col] = t; }
        __syncthreads();
    }
    { const int gt = F.gw * 64 + F.lane;
      if (gt < 1024) { const int pos = gt >> 4, f = gt & 15; const float invf = fexp2(-(float)f * (13.287712379549449f / 16.f)); const float rev = (float)pos * invf * 0.15915494309189535f;
          F.ROPE[gt * 2] = __builtin_amdgcn_cosf(rev); F.ROPE[gt * 2 + 1] = __builtin_amdgcn_sinf(rev); } }
    { LAS float* scr = (LAS float*)(F.lds + F.wave * 16384);
      constexpr int I_IN0 = 16 * (AB_IN / 32);
      for (int it = F.gw; it < I_IN0; it += F.ngw) p0_transpose_item(F.ab_w_in, DM, AB_IN, F.WIN0, scr, it, F.lane); }
    p0_convert(F, F.peer_sub_keys, F.SUBK, (size_t)2 * 8 * 2 * 128 * 128 / 8);
}

template <bool SRCB>
__device__ __forceinline__ void mod_phase(const Ctx& F, const GAS float* src_lat, const GAS float* src_ctx, int M, const GAS float* normg, const GAS float* mod_l, int sh, int sc) {
    for (int m = F.gw; m < M; m += F.ngw) {
        const int cond = m < MLAT ? (m >> 12) : 4;
        const GAS float* shp = mod_l + (size_t)cond * MODW + sh * 1024; const GAS float* scp = mod_l + (size_t)cond * MODW + sc * 1024;
        f32x4 v[4]; float s = 0.f;
#pragma unroll
        for (int j = 0; j < 4; ++j) {
            if (SRCB) { const v2u w = *(const GAS v2u*)(F.XS + (size_t)m * DM + 4 * F.lane + 256 * j); v[j] = (f32x4){bflo(w.x), bfhi(w.x), bflo(w.y), bfhi(w.y)}; }
            else { const GAS float* xr = m < MLAT ? src_lat + (size_t)m * DM : src_ctx + (size_t)(m - MLAT) * DM; v[j] = *(const GAS f32x4*)(xr + 4 * F.lane + 256 * j); }
            s += (v[j][0] * v[j][0] + v[j][1] * v[j][1]) + (v[j][2] * v[j][2] + v[j][3] * v[j][3]); }
        const float r = 1.0f / sqrtf(wave_sum(s) * (1.f / DM) + 1e-6f);
        GAS bf16* orow = F.XN + (size_t)m * DM;
#pragma unroll
        for (int j = 0; j < 4; ++j) { const int k = 4 * F.lane + 256 * j;
            const f32x4 g = *(const GAS f32x4*)(normg + k), a = *(const GAS f32x4*)(scp + k), b = *(const GAS f32x4*)(shp + k);
            f32x4 o;
#pragma unroll
            for (int e = 0; e < 4; ++e) o[e] = v[j][e] * r * g[e] * (1.f + a[e]) + b[e];
            v2u w; w.x = pk2(o[0], o[1]); w.y = pk2(o[2], o[3]); *(GAS v2u*)(orow + k) = w; }
    }
}

struct PostSlot { int col; const GAS float* nw; int rope; float scale; GAS bf16* tdst; int nheads; int head; int write_nat; };
__device__ __forceinline__ void post_item(const Ctx& F, GAS bf16* P, int ld, int tt, const PostSlot& S, LAS unsigned char* wl) {
    const int lane = F.lane, c = lane & 7, rsub = lane >> 3;
    const bool latent = tt < 256;
    const int m0 = tt * 64;
    const int b = latent ? (tt >> 6) : ((tt - 256) >> 2);
    const int t0 = latent ? ((tt & 63) * 64) : (((tt - 256) & 3) * 64);
    f32x4 nwa = {1.f, 1.f, 1.f, 1.f}, nwb = {1.f, 1.f, 1.f, 1.f};
    if (S.nw) { nwa = *(const GAS f32x4*)(S.nw + 8 * c); nwb = *(const GAS f32x4*)(S.nw + 8 * c + 4); }
#pragma unroll
    for (int it = 0; it < 8; ++it) {
        const int row = it * 8 + rsub;
        GAS bf16* pp = P + (size_t)(m0 + row) * ld + S.col + 8 * c;
        const v4u raw = *(const GAS v4u*)pp;
        float v[8] = {bflo(raw.x), bfhi(raw.x), bflo(raw.y), bfhi(raw.y), bflo(raw.z), bfhi(raw.z), bflo(raw.w), bfhi(raw.w)};
        if (S.nw) {
            float ss = 0.f;
#pragma unroll
            for (int e = 0; e < 8; ++e) ss += v[e] * v[e];
            ss += __shfl_xor(ss, 1); ss += __shfl_xor(ss, 2); ss += __shfl_xor(ss, 4);
            const float r = 1.0f / sqrtf(ss * (1.f / 64.f) + 1e-6f);
#pragma unroll
            for (int e = 0; e < 4; ++e) { v[e] *= r * nwa[e]; v[4 + e] *= r * nwb[e]; }
        }
        if (S.rope && latent) {
            const int t = t0 + row, pos = ((c & 3) < 2) ? (t >> 6) : (t & 63), f0 = (c & 1) * 8;
            const GAS float* rp = F.ROPE + (size_t)(pos * 16 + f0) * 2;
#pragma unroll
            for (int e = 0; e < 8; ++e) {
                const float other = __shfl_xor(v[e], 4);
                const float cs = rp[2 * e], sn = rp[2 * e + 1];
                v[e] = (c < 4) ? (v[e] * cs - other * sn) : (other * sn + v[e] * cs);
            }
        }
        v4u o; o.x = pk2(v[0] * S.scale, v[1] * S.scale); o.y = pk2(v[2] * S.scale, v[3] * S.scale); o.z = pk2(v[4] * S.scale, v[5] * S.scale); o.w = pk2(v[6] * S.scale, v[7] * S.scale);
        if (S.write_nat) *(GAS v4u*)pp = o;
        if (S.tdst) *(LAS v4u*)(wl + row * 144 + 16 * c) = o;
    }
    if (S.tdst) {
        LDS_WAIT(); asm volatile("" ::: "memory");
        const int tlen = latent ? SEQ : CL;
        GAS bf16* dst = S.tdst + (latent ? (size_t)0 : (size_t)NBATCH * S.nheads * 64 * SEQ) + ((size_t)(b * S.nheads + S.head) * 64 + lane) * tlen + t0;
#pragma unroll
        for (int q = 0; q < 8; ++q) {
            unsigned w[4];
#pragma unroll
            for (int e = 0; e < 4; ++e) {
                const unsigned lo = *(LAS const unsigned short*)(wl + (8 * q + 2 * e) * 144 + 2 * lane);
                const unsigned hi = *(LAS const unsigned short*)(wl + (8 * q + 2 * e + 1) * 144 + 2 * lane);
                w[e] = lo | (hi << 16);
            }
            v4u o; o.x = w[0]; o.y = w[1]; o.z = w[2]; o.w = w[3];
            *(GAS v4u*)(dst + 8 * q) = o;
        }
        LDS_WAIT(); asm volatile("" ::: "memory");
    }
}
#define NEG_BIG (-1.0e30f)
constexpr int SW_KP = 144, SW_CK = 0, SW_CVP = 528, SW_CV = 36864, SW_LK = 70656, SW_LVP = 592, SW_LV = 112128, SW_END = 150016;
__device__ __forceinline__ int kswz(int row, int c8) { const int t = row & 31; return ((row & ~31) + 16 * ((t >> 2) & 1) + 4 * (t >> 3) + (t & 3)) * 144 + 16 * c8; }
__device__ __forceinline__ bf16x8 ldsfrag(LAS const unsigned char* p) { return __builtin_bit_cast(bf16x8, *(LAS const v4u*)p); }

constexpr int NA_RPB = 70656;
template <bool CTXQ>
__device__ __forceinline__ void na_unit2(const Ctx& F, int b, int h, int r, int cg, float Bl2) {
    const int lane = F.lane, qi = lane & 15, g = lane >> 4;
    const GAS bf16* P = F.P;
    LAS const unsigned char* L = F.lds;
    const int c = cg * 16 + qi;
    const size_t qrow = CTXQ ? (size_t)(MLAT + b * CL + r * 16 + qi) : (size_t)(b * SEQ + r * 64 + c);
    const GAS bf16* qp = P + qrow * AB_IN + h * 64 + 8 * g;
    bf16x8 bq[2]; bq[0] = ldfrag(qp); bq[1] = ldfrag(qp + 32);
    const int arow = 8 * (qi >> 2) + (qi & 3);
    const int kz0 = 16 * g, kz1 = kz0 + 64;
    float l = 0.f;
    f32x4 o[4];
#pragma unroll
    for (int db = 0; db < 4; ++db) o[db] = (f32x4){0.f, 0.f, 0.f, 0.f};
    if (!CTXQ) {
        const int kr0 = min(max(r - 4, 0), 56), kc0 = cg == 0 ? 0 : (cg == 1 ? 8 : (cg == 2 ? 24 : 32)), start = min(max(c - 8, 0), 48);
        LAS const float* rpb = (LAS const float*)(L + NA_RPB);
        const GAS bf16* vx = F.TAV + ((size_t)(b * 8 + h) * 64 + qi) * SEQ + 8 * g;
#pragma unroll 4
        for (int y = 0; y < 8; ++y) {
            const int T0 = (kr0 + y) * 64 + kc0;
            LAS const float* rpr = rpb + ((kr0 + y) - r + 7) * 31;
            f32x4 st[2];
#pragma unroll
            for (int hh = 0; hh < 2; ++hh) {
                const GAS bf16* kp = P + (size_t)(b * SEQ + T0 + arow + 4 * hh) * AB_IN + 512 + h * 64 + 8 * g;
                f32x4 a = {0.f, 0.f, 0.f, 0.f};
                a = mfma16(ldfrag(kp), bq[0], a); a = mfma16(ldfrag(kp + 32), bq[1], a);
#pragma unroll
                for (int rr = 0; rr < 4; ++rr) {
                    const int kc = kc0 + 8 * g + 4 * hh + rr;
                    const bool valid = (kc >= start) && (kc < start + 16);
                    const int bi = min(max(kc - c + 15, 0), 30);
                    const float p = fexp2((a[rr] + rpr[bi]) * 1.4426950408889634f - Bl2);
                    a[rr] = valid ? p : 0.f; l += a[rr];
                }
                st[hh] = a;
            }
            const bf16x8 bp = pack8(st[0], st[1]);
#pragma unroll
            for (int db = 0; db < 4; ++db) o[db] = mfma16(ldfrag(vx + (size_t)(16 * db) * SEQ + T0), bp, o[db]);
        }
    }
#pragma unroll 2
    for (int y = 0; y < 8; ++y) {
        f32x4 st[2];
#pragma unroll
        for (int hh = 0; hh < 2; ++hh) {
            LAS const unsigned char* kp = L + SW_CK + (32 * y + 16 * hh + qi) * SW_KP;
            f32x4 a = {0.f, 0.f, 0.f, 0.f};
            a = mfma16(ldsfrag(kp + kz0), bq[0], a); a = mfma16(ldsfrag(kp + kz1), bq[1], a);
#pragma unroll
            for (int rr = 0; rr < 4; ++rr) { const float p = fexp2(a[rr] * 1.4426950408889634f - Bl2); a[rr] = p; l += p; }
            st[hh] = a;
        }
        const bf16x8 bp = pack8(st[0], st[1]);
#pragma unroll
        for (int db = 0; db < 4; ++db) o[db] = mfma16(ldsfrag(L + SW_CV + (16 * db + qi) * SW_CVP + (32 * y + 8 * g) * 2), bp, o[db]);
    }
    l += __shfl_xor(l, 16); l += __shfl_xor(l, 32);
    const float inv = 1.0f / l;
    GAS bf16* op = F.XN + qrow * DM + h * 64 + 4 * g;
#pragma unroll
    for (int db = 0; db < 4; ++db) { v2u w; w.x = pk2(o[db][0] * inv, o[db][1] * inv); w.y = pk2(o[db][2] * inv, o[db][3] * inv); *(GAS v2u*)(op + 16 * db) = w; }
}
__device__ __forceinline__ void swa_phase(const Ctx& F) {
    const int lane = F.lane, qi = lane & 15, g = lane >> 4, tid = F.tid;
    const GAS bf16* P = F.P;
    LAS unsigned char* L = F.lds;
    float mq = fabsf(F.swa_q_norm[lane]), mk = fabsf(F.swa_k_norm[lane]);
#pragma unroll
    for (int o = 1; o < 64; o <<= 1) { mq = fmaxf(mq, __shfl_xor(mq, o)); mk = fmaxf(mk, __shfl_xor(mk, o)); }
    const float Bl2 = 8.1f * mq * mk * 1.4426950408889634f;
    const int arow = 8 * (qi >> 2) + (qi & 3);
    const int vcu = F.gw >> 3;
    for (int su = vcu; su < 256; su += F.G) {
        const int b = su >> 6, kvh = (su >> 4) & 3, qb0 = (su & 15) * 8;
        const int hq = kvh * 4 + (F.wave >> 1), sb = F.wave & 1;
        __syncthreads();
#pragma unroll
        for (int j = 0; j < 4; ++j) {
            const int cid = tid + 512 * j;
            { const int row = cid >> 3, c8 = cid & 7;
              *(LAS v4u*)(L + SW_CK + kswz(row, c8)) = ld16(P + (size_t)(MLAT + b * CL + row) * SWA_IN + 1024 + kvh * 64 + 8 * c8); }
            { const int d = cid >> 5, c = cid & 31;
              *(LAS v4u*)(L + SW_CV + d * SW_CVP + 16 * c) = ld16(F.TAV + (size_t)NBATCH * 4 * 64 * SEQ + ((size_t)(b * 4 + kvh) * 64 + d) * CL + 8 * c); }
        }
        const float sinkp = fexp2(F.swa_sink[hq] * 1.4426950408889634f - Bl2);
        v4u kreg[5], vreg[5];
#define SW_PREFETCH(T0) do { _Pragma("unroll") for (int j = 0; j < 5; ++j) { const int cid = tid + 512 * j; if (cid < 2304) { \
            { const int row = cid >> 3, c8 = cid & 7; const int s_ = min(max((T0) - 128 + row, 0), SEQ - 1); kreg[j] = ld16(P + (size_t)(b * SEQ + s_) * SWA_IN + 1024 + kvh * 64 + 8 * c8); } \
            { const int d = cid / 36, c = cid - d * 36; const int tok = min(max((T0) - 128 + 8 * c, 0), SEQ - 8); vreg[j] = ld16(F.TAV + ((size_t)(b * 4 + kvh) * 64 + d) * SEQ + tok); } } } } while (0)
        SW_PREFETCH(32 * qb0);
#pragma unroll 1
        for (int iq = 0; iq < 8; ++iq) {
            const int t0 = 32 * (qb0 + iq);
            if (iq > 0) __syncthreads();
#pragma unroll
            for (int j = 0; j < 5; ++j) {
                const int cid = tid + 512 * j;
                if (cid < 2304) {
                    { const int row = cid >> 3, c8 = cid & 7; *(LAS v4u*)(L + SW_LK + kswz(row, c8)) = kreg[j]; }
                    { const int d = cid / 36, c = cid - d * 36; *(LAS v4u*)(L + SW_LV + d * SW_LVP + 16 * c) = vreg[j]; }
                }
            }
            if (iq + 1 < 8) SW_PREFETCH(t0 + 32);
            const int t = t0 + 16 * sb + qi;
            const GAS bf16* qp = P + (size_t)(b * SEQ + t) * SWA_IN + hq * 64 + 8 * g;
            bf16x8 bq[2]; bq[0] = ldfrag(qp); bq[1] = ldfrag(qp + 32);
            __syncthreads();
            float l = 0.f;
            f32x4 o[4];
#pragma unroll
            for (int db = 0; db < 4; ++db) o[db] = (f32x4){0.f, 0.f, 0.f, 0.f};
            f32x4 Sraw[2][2]; bf16x8 Ppk[2];
            const int kc0 = 16 * g, kc1 = kc0 + 64;
#define SW_A(y) do { _Pragma("unroll") for (int hh = 0; hh < 2; ++hh) { \
                LAS const unsigned char* kp = ((y) < 9) ? (L + SW_LK + (32 * (y) + 16 * hh + qi) * SW_KP) : (L + SW_CK + (32 * ((y) - 9) + 16 * hh + qi) * SW_KP); \
                f32x4 a = {0.f, 0.f, 0.f, 0.f}; a = mfma16(ldsfrag(kp + kc0), bq[0], a); a = mfma16(ldsfrag(kp + kc1), bq[1], a); Sraw[(y) & 1][hh] = a; } } while (0)
#define SW_B(y) do { f32x4 st[2]; _Pragma("unroll") for (int hh = 0; hh < 2; ++hh) { f32x4 a = Sraw[(y) & 1][hh]; \
                _Pragma("unroll") for (int rr = 0; rr < 4; ++rr) { float p = fexp2(a[rr] * 1.4426950408889634f - Bl2); \
                    if ((y) < 9) { const int s_ = t0 - 128 + 32 * (y) + 8 * g + 4 * hh + rr; const int d = t - s_; \
                        const bool valid = (s_ >= 0) && (s_ < SEQ) && (d <= 128) && (d >= -128); p = valid ? p : 0.f; } \
                    a[rr] = p; l += p; } st[hh] = a; } Ppk[(y) & 1] = pack8(st[0], st[1]); } while (0)
#define SW_C(y) do { _Pragma("unroll") for (int db = 0; db < 4; ++db) { \
                LAS const unsigned char* vp = ((y) < 9) ? (L + SW_LV + (16 * db + qi) * SW_LVP + (32 * (y) + 8 * g) * 2) : (L + SW_CV + (16 * db + qi) * SW_CVP + (32 * ((y) - 9) + 8 * g) * 2); \
                o[db] = mfma16(ldsfrag(vp), Ppk[(y) & 1], o[db]); } } while (0)
            SW_A(0);
            SW_A(1); SW_B(0);
#pragma unroll
            for (int y = 1; y < 17; ++y) {
                if (y + 1 < 17) SW_A(y + 1);
                SW_C(y - 1);
                SW_B(y);
            }
            SW_C(16);
#undef SW_A
#undef SW_B
#undef SW_C
            l += __shfl_xor(l, 16); l += __shfl_xor(l, 32);
            l += sinkp;
            const float inv = 1.0f / l;
            GAS bf16* op = F.XN + (size_t)(b * SEQ + t) * DM + hq * 64 + 4 * g;
#pragma unroll
            for (int db = 0; db < 4; ++db) { v2u w; w.x = pk2(o[db][0] * inv, o[db][1] * inv); w.y = pk2(o[db][2] * inv, o[db][3] * inv); *(GAS v2u*)(op + 16 * db) = w; }
        }
#undef SW_PREFETCH
    }
    __syncthreads();
}

__device__ __forceinline__ void na_phase(const Ctx& F) {
    const int lane = F.lane, tid = F.tid;
    const GAS bf16* P = F.P;
    LAS unsigned char* L = F.lds;
    float mq = fabsf(F.na_q_norm[lane]), mk = fabsf(F.na_k_norm[lane]);
#pragma unroll
    for (int o = 1; o < 64; o <<= 1) { mq = fmaxf(mq, __shfl_xor(mq, o)); mk = fmaxf(mk, __shfl_xor(mk, o)); }
    const int vcu = F.gw >> 3;
    for (int su = vcu; su < 256; su += F.G) {
        const int bh = su >> 3, e8 = su & 7, b = bh >> 3, h = bh & 7;
        __syncthreads();
#pragma unroll
        for (int j = 0; j < 4; ++j) {
            const int cid = tid + 512 * j;
            { const int row = cid >> 3, c8 = cid & 7;
              *(LAS v4u*)(L + SW_CK + kswz(row, c8)) = ld16(P + (size_t)(MLAT + b * CL + row) * AB_IN + 512 + h * 64 + 8 * c8); }
            { const int d = cid >> 5, c = cid & 31;
              *(LAS v4u*)(L + SW_CV + d * SW_CVP + 16 * c) = ld16(F.TAV + (size_t)NBATCH * 8 * 64 * SEQ + ((size_t)(b * 8 + h) * 64 + d) * CL + 8 * c); }
        }
        float mb = 0.f;
        if (tid < 465) { const float v = F.na_rpb[h * 465 + tid]; ((LAS float*)(L + NA_RPB))[tid] = v; }
        for (int i = lane; i < 465; i += 64) mb = fmaxf(mb, fabsf(F.na_rpb[h * 465 + i]));
#pragma unroll
        for (int o = 1; o < 64; o <<= 1) mb = fmaxf(mb, __shfl_xor(mb, o));
        const float Bl2 = (8.1f * mq * mk + mb) * 1.4426950408889634f;
        __syncthreads();
#pragma unroll 1
        for (int k = 0; k < 4; ++k) { const int i = F.wave + 8 * k; na_unit2<false>(F, b, h, e8 * 8 + (i >> 2), i & 3, Bl2); }
        if (F.wave < 2) na_unit2<true>(F, b, h, e8 * 2 + F.wave, 0, Bl2);
    }
    __syncthreads();
}

__device__ __forceinline__ int ret_pb(int pf) { return pf < 2 ? 32 + pf : pf - 2; }
__device__ __forceinline__ void ret_r1_unit(const Ctx& F, int bh, int pf, int dir) {
    const int lane = F.lane, qi = lane & 15, g = lane >> 4;
    const int h = bh & 7;
    const float lg2 = -__expf(F.ret_log_decay[dir * 8 + h]) * 1.4426950408889634f;
    const bool isctx = pf < 2;
    const int tlen = isctx ? CL : SEQ;
    const size_t boff = (isctx ? (size_t)NBATCH * 8 * 64 * SEQ : (size_t)0) + (size_t)bh * 64 * tlen + (isctx ? pf * 128 : (pf - 2) * 128);
    const GAS bf16* kt = F.TBK + boff + (size_t)qi * tlen + 8 * g;
    const GAS bf16* vt = F.TBV + boff + (size_t)qi * tlen + 8 * g;
    f32x4 acc[4][4];
#pragma unroll
    for (int db = 0; db < 4; ++db)
#pragma unroll
        for (int kb = 0; kb < 4; ++kb) acc[db][kb] = (f32x4){0.f, 0.f, 0.f, 0.f};
#pragma unroll 1
    for (int js = 0; js < 4; ++js) {
        float w[8];
#pragma unroll
        for (int jj = 0; jj < 8; ++jj) { const int j = 32 * js + 8 * g + jj; w[jj] = fexp2(lg2 * (float)(dir == 0 ? 127 - j : j)); }
        bf16x8 bk[4];
#pragma unroll
        for (int kb = 0; kb < 4; ++kb) {
            const v4u raw = ld16(kt + (size_t)(16 * kb) * tlen + 32 * js);
            v4u o; o.x = pk2(bflo(raw.x) * w[0], bfhi(raw.x) * w[1]); o.y = pk2(bflo(raw.y) * w[2], bfhi(raw.y) * w[3]);
            o.z = pk2(bflo(raw.z) * w[4], bfhi(raw.z) * w[5]); o.w = pk2(bflo(raw.w) * w[6], bfhi(raw.w) * w[7]);
            bk[kb] = __builtin_bit_cast(bf16x8, o);
        }
#pragma unroll
        for (int db = 0; db < 4; ++db) {
            const bf16x8 a = ldfrag(vt + (size_t)(16 * db) * tlen + 32 * js);
#pragma unroll
            for (int kb = 0; kb < 4; ++kb) acc[db][kb] = mfma16(a, bk[kb], acc[db][kb]);
        }
    }
    const int idx = dir == 0 ? pf : ret_pb(pf);
    GAS float* out = F.KV + ((size_t)(bh * 2 + dir) * 34 + idx) * 4096;
#pragma unroll
    for (int db = 0; db < 4; ++db)
#pragma unroll
        for (int kb = 0; kb < 4; ++kb)
#pragma unroll
            for (int rr = 0; rr < 4; ++rr) out[(16 * db + 4 * g + rr) * 64 + 16 * kb + qi] = acc[db][kb][rr];
}
__device__ __forceinline__ void ret_r2(const Ctx& F) {
    const int NT = F.ngw * 64;
    for (int it = F.gw * 64 + F.lane; it < 64 * 4096; it += NT) {
        const int unit = it >> 12, e = it & 4095;
        const int dir = unit & 1, h = (unit >> 1) & 7;
        const float gC = fexp2(-__expf(F.ret_log_decay[dir * 8 + h]) * 1.4426950408889634f * 128.f);
        const GAS float* kv = F.KV + (size_t)unit * 34 * 4096 + e;
        GAS bf16* st = F.ST + (size_t)unit * 34 * 4096 + e;
        float S = 0.f;
        if (dir == 0) { for (int p = 0; p < 34; ++p) { st[(size_t)p * 4096] = (bf16)f2bf(S); S = S * gC + kv[(size_t)p * 4096]; } }
        else { for (int p = 33; p >= 0; --p) { st[(size_t)p * 4096] = (bf16)f2bf(S); S = S * gC + kv[(size_t)p * 4096]; } }
    }
}
constexpr int R3_KP = 144, R3_K = 0, R3_VP = 272, R3_V = 18432, R3_SP = 144, R3_SF = 35840, R3_SB = 45056, R3_END = 54272;
__device__ __forceinline__ void ret_r3_phase(const Ctx& F) {
    const int lane = F.lane, qi = lane & 15, g = lane >> 4, tid = F.tid, ib = F.wave;
    const GAS bf16* P = F.P;
    LAS unsigned char* L = F.lds;
    const int arow = 8 * (qi >> 2) + (qi & 3);
    const int kc0 = 16 * g, kc1 = kc0 + 64;
    const int vcu = F.gw >> 3;
    for (int grp = vcu; grp < 32 * 34; grp += F.G) {
        const int bh = grp / 34, pf = grp - bh * 34;
        const int b = bh >> 3, h = bh & 7;
        const bool isctx = pf < 2;
        const size_t row0 = isctx ? (size_t)(MLAT + b * CL + pf * 128) : (size_t)(b * SEQ + (pf - 2) * 128);
        const int tlen = isctx ? CL : SEQ;
        const GAS bf16* vt = F.TBV + (isctx ? (size_t)NBATCH * 8 * 64 * SEQ : (size_t)0) + (size_t)bh * 64 * tlen + (isctx ? pf * 128 : (pf - 2) * 128);
        const GAS bf16* sfp = F.ST + ((size_t)(bh * 2 + 0) * 34 + pf) * 4096;
        const GAS bf16* sbp = F.ST + ((size_t)(bh * 2 + 1) * 34 + ret_pb(pf)) * 4096;
        __syncthreads();
#pragma unroll
        for (int j = 0; j < 2; ++j) {
            const int cid = tid + 512 * j;
            { const int row = cid >> 3, c8 = cid & 7; *(LAS v4u*)(L + R3_K + kswz(row, c8)) = ld16(P + (row0 + row) * AB_IN + 2048 + h * 64 + 8 * c8); }
            { const int d = cid >> 4, c = cid & 15; *(LAS v4u*)(L + R3_V + d * R3_VP + 16 * c) = ld16(vt + (size_t)d * tlen + 8 * c); }
        }
        { const int d = tid >> 3, c8 = tid & 7;
          *(LAS v4u*)(L + R3_SF + d * R3_SP + 16 * c8) = ld16(sfp + d * 64 + 8 * c8);
          *(LAS v4u*)(L + R3_SB + d * R3_SP + 16 * c8) = ld16(sbp + d * 64 + 8 * c8); }
        const int i = 16 * ib + qi;
        const float lgf = -__expf(F.ret_log_decay[h]) * 1.4426950408889634f, lgb = -__expf(F.ret_log_decay[8 + h]) * 1.4426950408889634f;
        const GAS bf16* qp = P + (row0 + i) * AB_IN + 1536 + h * 64 + 8 * g;
        bf16x8 bq[2]; bq[0] = ldfrag(qp); bq[1] = ldfrag(qp + 32);
        __syncthreads();
        f32x4 o[4];
#pragma unroll
        for (int db = 0; db < 4; ++db) o[db] = (f32x4){0.f, 0.f, 0.f, 0.f};
#pragma unroll
        for (int y = 0; y < 4; ++y) {
            f32x4 st[2];
#pragma unroll
            for (int hh = 0; hh < 2; ++hh) {
                LAS const unsigned char* kp = L + R3_K + (32 * y + 16 * hh + qi) * R3_KP;
                f32x4 a = {0.f, 0.f, 0.f, 0.f};
                a = mfma16(ldsfrag(kp + kc0), bq[0], a); a = mfma16(ldsfrag(kp + kc1), bq[1], a);
#pragma unroll
                for (int rr = 0; rr < 4; ++rr) {
                    const int j = 32 * y + 8 * g + 4 * hh + rr; const int d = i - j;
                    const float w = d > 0 ? fexp2(lgf * (float)d) : (d < 0 ? fexp2(lgb * (float)(-d)) : 1.0f);
                    a[rr] *= w;
                }
                st[hh] = a;
            }
            const bf16x8 bp = pack8(st[0], st[1]);
#pragma unroll
            for (int db = 0; db < 4; ++db) o[db] = mfma16(ldsfrag(L + R3_V + (16 * db + qi) * R3_VP + (32 * y + 8 * g) * 2), bp, o[db]);
        }
        {
            const float df = fexp2(lgf * (float)(i + 1)), dbk = fexp2(lgb * (float)(128 - i));
#pragma unroll
            for (int db = 0; db < 4; ++db) {
                LAS const unsigned char* sf = L + R3_SF + (16 * db + qi) * R3_SP + 16 * g;
                LAS const unsigned char* sb = L + R3_SB + (16 * db + qi) * R3_SP + 16 * g;
                f32x4 xf = {0.f, 0.f, 0.f, 0.f}, xb = {0.f, 0.f, 0.f, 0.f};
                xf = mfma16(ldsfrag(sf), bq[0], xf); xf = mfma16(ldsfrag(sf + 64), bq[1], xf);
                xb = mfma16(ldsfrag(sb), bq[0], xb); xb = mfma16(ldsfrag(sb + 64), bq[1], xb);
                o[db] = o[db] + xf * df + xb * dbk;
            }
        }
        float s = 0.f;
#pragma unroll
        for (int db = 0; db < 4; ++db) s += (o[db][0] + o[db][1]) + (o[db][2] + o[db][3]);
        s += __shfl_xor(s, 16); s += __shfl_xor(s, 32);
        const float mu = s * (1.f / 64.f);
        float q = 0.f;
#pragma unroll
        for (int db = 0; db < 4; ++db)
#pragma unroll
            for (int rr = 0; rr < 4; ++rr) { const float d = o[db][rr] - mu; o[db][rr] = d; q += d * d; }
        q += __shfl_xor(q, 16); q += __shfl_xor(q, 32);
        const float rstd = 1.0f / sqrtf(q * (1.f / 64.f) + 1e-5f);
        const GAS bf16* gp = P + (row0 + i) * AB_IN + 3072 + h * 64 + 4 * g;
        GAS bf16* op = F.XN + (row0 + i) * DM + 512 + h * 64 + 4 * g;
#pragma unroll
        for (int db = 0; db < 4; ++db) {
            const v2u gr = *(const GAS v2u*)(gp + 16 * db);
            const float gv[4] = {bflo(gr.x), bfhi(gr.x), bflo(gr.y), bfhi(gr.y)};
            float r[4];
#pragma unroll
            for (int rr = 0; rr < 4; ++rr) r[rr] = o[db][rr] * rstd * (gv[rr] / (1.f + fexp(-gv[rr])));
            v2u w; w.x = pk2(r[0], r[1]); w.y = pk2(r[2], r[3]); *(GAS v2u*)(op + 16 * db) = w;
        }
    }
    __syncthreads();
}
__device__ __constant__ unsigned char CAND_TAB[52] = {
    0x00,0x01,0x02,0x03,0x04,0x05,0x06,0x07,0x08,0x09,0x0a,0x0b,0x0c,0x0d,0x0e,0x0f,
    0x10,0x11,0x12,0x13,0x14,0x15,0x16,0x17,
    0x20,0x21,0x22,0x23,0x24,
    0x30,0x31,0x32,0x33,
    0x40,0x41,0x42, 0x50,0x51, 0x60,0x61, 0x70,0x71,
    0x80,0x90,0xa0,0xb0,0xc0,0xd0,0xe0,0xf0,
    0x00,0x00 };
#define SORT_NEG (-3.0e38f)
template <int LOGN>
__device__ __forceinline__ void bitonic_sort_desc(float (&v)[1 << LOGN]) {
    constexpr int N = 1 << LOGN;
#pragma unroll
    for (int kk = 1; kk <= LOGN; ++kk) {
#pragma unroll
        for (int jj = kk - 1; jj >= 0; --jj) {
#pragma unroll
            for (int i = 0; i < N; ++i) {
                const int k = 1 << kk, j = 1 << jj, l = i ^ j;
                if (l > i) {
                    const bool desc = ((i & k) == 0);
                    const float a = v[i], b = v[l];
                    const float hi = fmaxf(a, b), lo = fminf(a, b);
                    v[i] = desc ? hi : lo; v[l] = desc ? lo : hi;
                }
            }
        }
    }
}
__device__ __forceinline__ void merge_top16(float (&v)[16], int mask) {
    float c[16];
#pragma unroll
    for (int i = 0; i < 16; ++i) c[i] = fmaxf(v[i], __shfl_xor(v[15 - i], mask));
#pragma unroll
    for (int jj = 3; jj >= 0; --jj) {
#pragma unroll
        for (int i = 0; i < 16; ++i) { const int j = 1 << jj, l = i ^ j;
            if (l > i) { const float a = c[i], b = c[l]; c[i] = fmaxf(a, b); c[l] = fminf(a, b); } }
    }
#pragma unroll
    for (int i = 0; i < 16; ++i) v[i] = c[i];
}
__device__ __forceinline__ void merge_top16_local(float (&a)[16], const float (&b)[16]) {
    float c[16];
#pragma unroll
    for (int i = 0; i < 16; ++i) c[i] = fmaxf(a[i], b[15 - i]);
#pragma unroll
    for (int jj = 3; jj >= 0; --jj) {
#pragma unroll
        for (int i = 0; i < 16; ++i) { const int j = 1 << jj, l = i ^ j;
            if (l > i) { const float x = c[i], y = c[l]; c[i] = fmaxf(x, y); c[l] = fminf(x, y); } }
    }
#pragma unroll
    for (int i = 0; i < 16; ++i) a[i] = c[i];
}
constexpr int SC_KP = 272, SC_KEYS = 0, SC_PSTRIDE = 128 * SC_KP, SC_WL = 73728;
__device__ __forceinline__ void peer_score_unit(const Ctx& F, int tb, int h, LAS unsigned* wl, bf16x8 (&bq0)[4], int tbn) {
    const int lane = F.lane, qi = lane & 15, g = lane >> 4;
    const size_t m = (size_t)tb * 16 + qi;
    bf16x8 bq1[4];
#pragma unroll 1
    for (int p = 0; p < 2; ++p) {
        bf16x8 bq[4];
        const GAS bf16* qp = F.Q2 + m * PQD + h * 256 + p * 128 + 8 * g;
#pragma unroll
        for (int ks = 0; ks < 4; ++ks) bq[ks] = ldfrag(qp + 32 * ks);
        LAS const unsigned char* kp = F.lds + SC_KEYS + p * SC_PSTRIDE + qi * SC_KP + 16 * g;
        float va[16], vb[16];
#pragma unroll
        for (int kb = 0; kb < 8; ++kb) {
            f32x4 a = {0.f, 0.f, 0.f, 0.f};
#pragma unroll
            for (int ks = 0; ks < 4; ++ks) a = mfma16(ldsfrag(kp + (16 * kb) * SC_KP + 64 * ks), bq[ks], a);
#pragma unroll
            for (int rr = 0; rr < 4; ++rr) {
                const float pv = __uint_as_float((__float_as_uint(a[rr]) & ~127u) | (unsigned)(16 * kb + 4 * g + rr));
                if (kb < 4) va[4 * kb + rr] = pv; else vb[4 * (kb - 4) + rr] = pv;
            }
        }
        bitonic_sort_desc<4>(va); bitonic_sort_desc<4>(vb);
        merge_top16_local(va, vb);
        merge_top16(va, 16); merge_top16(va, 32);
        if (g == 0) {
#pragma unroll
            for (int i = 0; i < 16; ++i) wl[(qi * 2 + p) * 16 + i] = __float_as_uint(va[i]);
        }
    }
    LDS_WAIT(); asm volatile("" ::: "memory");
    LAS const unsigned char* tab = (LAS const unsigned char*)(wl + 512);
    float cd[16];
#pragma unroll
    for (int k = 0; k < 13; ++k) {
        const int code = g * 13 + k;
        const unsigned ij = tab[code];
        const unsigned a = wl[(qi * 2 + 0) * 16 + (ij >> 4)], b = wl[(qi * 2 + 1) * 16 + (ij & 15)];
        const float s = __uint_as_float(a & ~127u) + __uint_as_float(b & ~127u);
        cd[k] = code < 50 ? __uint_as_float((__float_as_uint(s) & ~63u) | (unsigned)code) : SORT_NEG;
    }
    cd[13] = SORT_NEG; cd[14] = SORT_NEG; cd[15] = SORT_NEG;
    bitonic_sort_desc<4>(cd);
    merge_top16(cd, 16); merge_top16(cd, 32);
    float e[16]; float sum = 0.f;
    const float mx = __uint_as_float(__float_as_uint(cd[0]) & ~63u);
#pragma unroll
    for (int k = 0; k < 16; ++k) { e[k] = fexp(__uint_as_float(__float_as_uint(cd[k]) & ~63u) - mx); sum += e[k]; }
    const float inv = 1.0f / sum;
    typedef int i32x4 __attribute__((ext_vector_type(4)));
    i32x4 oi; f32x4 og;
#pragma unroll
    for (int k = 0; k < 4; ++k) {
        const float cv = g == 0 ? cd[k] : (g == 1 ? cd[4 + k] : (g == 2 ? cd[8 + k] : cd[12 + k]));
        const float ev = g == 0 ? e[k] : (g == 1 ? e[4 + k] : (g == 2 ? e[8 + k] : e[12 + k]));
        const unsigned code = __float_as_uint(cv) & 63u;
        const unsigned ij = tab[code];
        const unsigned a = wl[(qi * 2 + 0) * 16 + (ij >> 4)] & 127u, b = wl[(qi * 2 + 1) * 16 + (ij & 15)] & 127u;
        oi[k] = (int)(a * 128u + b);
        og[k] = ev * inv;
    }
    *(GAS i32x4*)(F.IDX + m * 128 + h * 16 + 4 * g) = oi;
    *(GAS f32x4*)(F.GATE + m * 128 + h * 16 + 4 * g) = og;
    LDS_WAIT(); asm volatile("" ::: "memory");
}
__device__ __forceinline__ void peer_score_phase(const Ctx& F, int l, int Mp) {
    const int vcu = F.gw >> 3, tid = F.tid;
    LAS unsigned* wl = (LAS unsigned*)(F.lds + SC_WL + F.wave * 4096);
    if (F.lane < 52) ((LAS unsigned char*)(wl + 512))[F.lane] = CAND_TAB[F.lane];
    const int nj = (F.G >= 8) ? F.G / 8 : 1;
    const int nb = Mp / 16;
    for (int hh = vcu & 7; hh < 8; hh += (F.G >= 8 ? 8 : F.G)) {
        __syncthreads();
        const GAS bf16* src = F.SUBK + (size_t)((l * 8 + hh) * 2) * 128 * 128;
#pragma unroll
        for (int j = 0; j < 8; ++j) { const int cid = tid + 512 * j; const int row = cid >> 4, c16 = cid & 15;
            *(LAS v4u*)(F.lds + SC_KEYS + row * SC_KP + 16 * c16) = ld16(src + (size_t)row * 128 + 8 * c16); }
        __syncthreads();
        { const int tb0 = (vcu >> 3) % nj + nj * F.wave, qi = F.lane & 15, g = F.lane >> 4;
          bf16x8 bq0[4];
          if (SCPF && tb0 < nb) {
#pragma unroll
              for (int ks = 0; ks < 4; ++ks) bq0[ks] = ldfrag(F.Q2 + ((size_t)tb0 * 16 + qi) * PQD + hh * 256 + 8 * g + 32 * ks);
          }
          for (int tb = tb0; tb < nb; tb += nj * NWAVES) { const int tbn = tb + nj * NWAVES; peer_score_unit(F, tb, hh, wl, bq0, tbn < nb ? tbn : -1); } }
    }
    __syncthreads();
}

typedef float f32x2 __attribute__((ext_vector_type(2)));
#define DPP_XOR1(x) __builtin_bit_cast(float, __builtin_amdgcn_update_dpp(0, __builtin_bit_cast(int, (x)), 0xB1, 0xf, 0xf, false))
#define DPP_XOR2(x) __builtin_bit_cast(float, __builtin_amdgcn_update_dpp(0, __builtin_bit_cast(int, (x)), 0x4E, 0xf, 0xf, false))
#define DPP_ROR4(x) __builtin_bit_cast(float, __builtin_amdgcn_update_dpp(0, __builtin_bit_cast(int, (x)), 0x124, 0xf, 0xf, false))
#define DPP_ROR8(x) __builtin_bit_cast(float, __builtin_amdgcn_update_dpp(0, __builtin_bit_cast(int, (x)), 0x128, 0xf, 0xf, false))
__device__ __forceinline__ float xsum16(float x) { auto rr = __builtin_amdgcn_permlane16_swap(__float_as_uint(x), __float_as_uint(x), false, false); return __uint_as_float(rr[0]) + __uint_as_float(rr[1]); }
__device__ __forceinline__ float xsum32(float x) { auto rr = __builtin_amdgcn_permlane32_swap(__float_as_uint(x), __float_as_uint(x), false, false); return __uint_as_float(rr[0]) + __uint_as_float(rr[1]); }
__device__ __forceinline__ float reduce16pairs(const float (&p)[16], int lane) {
    const bool o1 = lane & 1, o2 = lane & 2;
    float a[8];
#pragma unroll
    for (int k = 0; k < 8; ++k) { const float keep = o1 ? p[2 * k + 1] : p[2 * k], send = o1 ? p[2 * k] : p[2 * k + 1]; a[k] = keep + DPP_XOR1(send); }
    float b[4];
#pragma unroll
    for (int k = 0; k < 4; ++k) { const float keep = o2 ? a[2 * k + 1] : a[2 * k], send = o2 ? a[2 * k] : a[2 * k + 1]; b[k] = keep + DPP_XOR2(send); }
#pragma unroll
    for (int k = 0; k < 4; ++k) { b[k] += DPP_ROR4(b[k]); b[k] += DPP_ROR8(b[k]); b[k] = xsum16(b[k]); }
    const int j = (lane >> 2) & 3;
    return j == 0 ? b[0] : (j == 1 ? b[1] : (j == 2 ? b[2] : b[3]));
}
typedef unsigned u32x16v __attribute__((ext_vector_type(16)));
__device__ __forceinline__ u32x6v ld24(const GAS unsigned char* p) {
    const v2u a = *(const GAS v2u*)p, b = *(const GAS v2u*)(p + 8), c = *(const GAS v2u*)(p + 16);
    return (u32x6v){a.x, a.y, b.x, b.y, c.x, c.y};
}
template <bool FP4> struct RowBuf { typedef u32x6v T; };
template <> struct RowBuf<true> { typedef v4u T; };
__device__ __forceinline__ void row_ld(v4u& r, const GAS unsigned char* T, unsigned row, unsigned q) { r = *(const GAS v4u*)(T + (row * 512u + 16u * q)); }
__device__ __forceinline__ void row_ld(u32x6v& r, const GAS unsigned char* T, unsigned row, unsigned q) { r = ld24(T + (row * 768u + 24u * q)); }
__device__ __forceinline__ u32x16v row_unpack(const v4u& r) {
    u32x16v f;
#pragma unroll
    for (int d = 0; d < 4; ++d) {
        f[4 * d + 0] = __builtin_bit_cast(unsigned, __builtin_amdgcn_cvt_scalef32_pk_bf16_fp4(r[d], 1.0f, 0));
        f[4 * d + 1] = __builtin_bit_cast(unsigned, __builtin_amdgcn_cvt_scalef32_pk_bf16_fp4(r[d], 1.0f, 1));
        f[4 * d + 2] = __builtin_bit_cast(unsigned, __builtin_amdgcn_cvt_scalef32_pk_bf16_fp4(r[d], 1.0f, 2));
        f[4 * d + 3] = __builtin_bit_cast(unsigned, __builtin_amdgcn_cvt_scalef32_pk_bf16_fp4(r[d], 1.0f, 3));
    }
    return f;
}
__device__ __forceinline__ u32x16v row_unpack(const u32x6v& r) { return __builtin_bit_cast(u32x16v, __builtin_amdgcn_cvt_scalef32_pk32_bf16_fp6(r, 1.0f)); }
template <int S, bool FP4>
__device__ __forceinline__ void pg_load(typename RowBuf<FP4>::T (&r)[8], const GAS unsigned char* T, int i0, int i1, bool up, unsigned q) {
    constexpr int bt = S >> 2, c = (S >> 1) & 1, sub = S & 1;
    const int idv = bt ? i1 : i0;
    constexpr int j0 = c * 16 + sub * 8;
    row_ld(r[0], T, (unsigned)__builtin_amdgcn_ds_swizzle(idv, (j0 + 0) << 5), q); row_ld(r[1], T, (unsigned)__builtin_amdgcn_ds_swizzle(idv, (j0 + 1) << 5), q);
    row_ld(r[2], T, (unsigned)__builtin_amdgcn_ds_swizzle(idv, (j0 + 2) << 5), q); row_ld(r[3], T, (unsigned)__builtin_amdgcn_ds_swizzle(idv, (j0 + 3) << 5), q);
    row_ld(r[4], T, (unsigned)__builtin_amdgcn_ds_swizzle(idv, (j0 + 4) << 5), q); row_ld(r[5], T, (unsigned)__builtin_amdgcn_ds_swizzle(idv, (j0 + 5) << 5), q);
    row_ld(r[6], T, (unsigned)__builtin_amdgcn_ds_swizzle(idv, (j0 + 6) << 5), q); row_ld(r[7], T, (unsigned)__builtin_amdgcn_ds_swizzle(idv, (j0 + 7) << 5), q);
#pragma unroll
    for (int k = 0; k < 8; ++k) {
    }
}
template <int S, bool FP4, bool LDO = false>
__device__ __forceinline__ void pg_dot(const typename RowBuf<FP4>::T (&r)[8], const unsigned (&h)[16], const f32x2 (&hf)[16], float (&p)[16]) {
    constexpr int sub = S & 1;
#pragma unroll
    for (int k = 0; k < 8; ++k) {
        if (LDO) { p[sub * 8 + k] = __uint_as_float((r[k][0] ^ r[k][1] ^ r[k][2] ^ r[k][3]) & 0x3fffffffu); }
        else if (FP4) {
            f32x2 s0 = {0.f, 0.f}, s1 = {0.f, 0.f};
#pragma unroll
            for (int d = 0; d < 4; ++d) {
                s0 += __builtin_amdgcn_cvt_scalef32_pk_f32_fp4(r[k][d], 1.0f, 0) * hf[4 * d + 0];
                s1 += __builtin_amdgcn_cvt_scalef32_pk_f32_fp4(r[k][d], 1.0f, 1) * hf[4 * d + 1];
                s0 += __builtin_amdgcn_cvt_scalef32_pk_f32_fp4(r[k][d], 1.0f, 2) * hf[4 * d + 2];
                s1 += __builtin_amdgcn_cvt_scalef32_pk_f32_fp4(r[k][d], 1.0f, 3) * hf[4 * d + 3];
            }
            const f32x2 t = s0 + s1;
            p[sub * 8 + k] = t.x + t.y;
        } else {
            const u32x16v f = row_unpack(r[k]);
            float s0 = 0.f, s1 = 0.f;
#pragma unroll
            for (int e = 0; e < 16; e += 2) { s0 = dot2bf(f[e], h[e], s0); s1 = dot2bf(f[e + 1], h[e + 1], s1); }
            p[sub * 8 + k] = s0 + s1;
        }
    }
}
template <int S, bool FP4, bool LDO = false>
__device__ __forceinline__ void pg_axpy(const typename RowBuf<FP4>::T (&r)[8], float wgt0, float wgt1, bool up, float (&acc)[32]) {
    constexpr int bt = S >> 2, c = (S >> 1) & 1, sub = S & 1;
    const float wgt = bt ? wgt1 : wgt0;
#pragma unroll
    for (int k = 0; k < 8; ++k) {
        if (LDO) { acc[(S * 8 + k) & 31] += __uint_as_float((r[k][0] ^ r[k][1] ^ r[k][2] ^ r[k][3]) & 0x3fffffffu); continue; }
        const float wA = __uint_as_float(__builtin_amdgcn_readlane(__float_as_uint(wgt), c * 16 + sub * 8 + k));
        const float wB = __uint_as_float(__builtin_amdgcn_readlane(__float_as_uint(wgt), 32 + c * 16 + sub * 8 + k));
        const float w = up ? wB : wA;
        if (FP4) {
            const f32x2 w2 = (f32x2){w, w};
#pragma unroll
            for (int d = 0; d < 4; ++d) {
                { const f32x2 f = __builtin_amdgcn_cvt_scalef32_pk_f32_fp4(r[k][d], 1.0f, 0); const f32x2 a = (f32x2){acc[8 * d + 0], acc[8 * d + 1]} + w2 * f; acc[8 * d + 0] = a.x; acc[8 * d + 1] = a.y; }
                { const f32x2 f = __builtin_amdgcn_cvt_scalef32_pk_f32_fp4(r[k][d], 1.0f, 1); const f32x2 a = (f32x2){acc[8 * d + 2], acc[8 * d + 3]} + w2 * f; acc[8 * d + 2] = a.x; acc[8 * d + 3] = a.y; }
                { const f32x2 f = __builtin_amdgcn_cvt_scalef32_pk_f32_fp4(r[k][d], 1.0f, 2); const f32x2 a = (f32x2){acc[8 * d + 4], acc[8 * d + 5]} + w2 * f; acc[8 * d + 4] = a.x; acc[8 * d + 5] = a.y; }
                { const f32x2 f = __builtin_amdgcn_cvt_scalef32_pk_f32_fp4(r[k][d], 1.0f, 3); const f32x2 a = (f32x2){acc[8 * d + 6], acc[8 * d + 7]} + w2 * f; acc[8 * d + 6] = a.x; acc[8 * d + 7] = a.y; }
            }
        } else {
            const unsigned wlo = f2bf(w), whi = wlo << 16;
            const u32x16v f = row_unpack(r[k]);
#pragma unroll
            for (int e = 0; e < 16; ++e) { acc[2 * e] = dot2bf(f[e], wlo, acc[2 * e]); acc[2 * e + 1] = dot2bf(f[e], whi, acc[2 * e + 1]); }
        }
    }
}
typedef _Float16 h2v __attribute__((ext_vector_type(2)));
template <int S>
__device__ __forceinline__ void pg_axpy_h(const v4u (&r)[8], float wgt0, float wgt1, bool up, h2v (&acc)[16]) {
    constexpr int bt = S >> 2, c = (S >> 1) & 1, sub = S & 1, j0 = c * 16 + sub * 8;
    const int wp = __float_as_int(bt ? wgt1 : wgt0);
    const int wsw[8] = {__builtin_amdgcn_ds_swizzle(wp, (j0 + 0) << 5), __builtin_amdgcn_ds_swizzle(wp, (j0 + 1) << 5), __builtin_amdgcn_ds_swizzle(wp, (j0 + 2) << 5), __builtin_amdgcn_ds_swizzle(wp, (j0 + 3) << 5),
                        __builtin_amdgcn_ds_swizzle(wp, (j0 + 4) << 5), __builtin_amdgcn_ds_swizzle(wp, (j0 + 5) << 5), __builtin_amdgcn_ds_swizzle(wp, (j0 + 6) << 5), __builtin_amdgcn_ds_swizzle(wp, (j0 + 7) << 5)};
#pragma unroll
    for (int k = 0; k < 8; ++k) {
        const h2v wh = __builtin_bit_cast(h2v, wsw[k]);
        int f[16];
#pragma unroll
        for (int d = 0; d < 4; ++d) {
            f[4 * d + 0] = __builtin_bit_cast(int, __builtin_amdgcn_cvt_scalef32_pk_f16_fp4(r[k][d], 1.0f, 0));
            f[4 * d + 1] = __builtin_bit_cast(int, __builtin_amdgcn_cvt_scalef32_pk_f16_fp4(r[k][d], 1.0f, 1));
            f[4 * d + 2] = __builtin_bit_cast(int, __builtin_amdgcn_cvt_scalef32_pk_f16_fp4(r[k][d], 1.0f, 2));
            f[4 * d + 3] = __builtin_bit_cast(int, __builtin_amdgcn_cvt_scalef32_pk_f16_fp4(r[k][d], 1.0f, 3));
        }
        asm volatile("" : "+v"(f[0]), "+v"(f[1]), "+v"(f[2]), "+v"(f[3]), "+v"(f[4]), "+v"(f[5]), "+v"(f[6]), "+v"(f[7]), "+v"(f[8]), "+v"(f[9]), "+v"(f[10]), "+v"(f[11]), "+v"(f[12]), "+v"(f[13]), "+v"(f[14]), "+v"(f[15]));
#pragma unroll
        for (int e = 0; e < 16; ++e) acc[e] = __builtin_elementwise_fma(wh, __builtin_bit_cast(h2v, f[e]), acc[e]);
    }
}
template <bool LDO = false>
__device__ __forceinline__ void peer_gather_u(const Ctx& F, int l, size_t m, float& wgt0, float& wgt1, int rm = -1) {
    const int lane = F.lane, q = lane & 31;
    const bool up = lane >= 32;
    const GAS int* ip = F.IDX + m * 128; const GAS float* gp = F.GATE + m * 128;
    const int i0 = ip[lane] & rm, i1 = ip[64 + lane] & rm;
    const float ga0 = gp[lane], ga1 = gp[64 + lane];
    const GAS unsigned char* U = F.U8 + (size_t)l * 16384 * U_ROWB;
    typename RowBuf<U_FP4 != 0>::T ra[8], rb[8];
    pg_load<0, U_FP4 != 0>(ra, U, i0, i1, up, (unsigned)q);
    unsigned h[16];
    { const GAS bf16* hp = F.XN + m * DM + 32 * q;
#pragma unroll
      for (int j = 0; j < 4; ++j) { const v4u w = ld16(hp + 8 * j); h[4 * j] = w.x; h[4 * j + 1] = w.y; h[4 * j + 2] = w.z; h[4 * j + 3] = w.w; } }
    f32x2 hf[16];
#pragma unroll
    for (int i = 0; i < 16; ++i) hf[i] = (f32x2){bflo(h[i]), bfhi(h[i])};
    const GAS float* SU = F.SU + l * 16384; const GAS float* SV = F.SV + l * 16384;
    const float su0 = SU[i0], sv0 = SV[i0], su1 = SU[i1], sv1 = SV[i1];
    const int cl = (lane >> 4) & 1;
    float p[16]; float act0 = 0.f, act1 = 0.f, tot;
    pg_load<1, U_FP4 != 0>(rb, U, i0, i1, up, (unsigned)q); pg_dot<0, U_FP4 != 0, LDO>(ra, h, hf, p);
    pg_load<2, U_FP4 != 0>(ra, U, i0, i1, up, (unsigned)q); pg_dot<1, U_FP4 != 0, LDO>(rb, h, hf, p); tot = reduce16pairs(p, lane); act0 = (cl == 0) ? tot : act0;
    pg_load<3, U_FP4 != 0>(rb, U, i0, i1, up, (unsigned)q); pg_dot<2, U_FP4 != 0, LDO>(ra, h, hf, p);
    pg_load<4, U_FP4 != 0>(ra, U, i0, i1, up, (unsigned)q); pg_dot<3, U_FP4 != 0, LDO>(rb, h, hf, p); tot = reduce16pairs(p, lane); act0 = (cl == 1) ? tot : act0;
    pg_load<5, U_FP4 != 0>(rb, U, i0, i1, up, (unsigned)q); pg_dot<4, U_FP4 != 0, LDO>(ra, h, hf, p);
    pg_load<6, U_FP4 != 0>(ra, U, i0, i1, up, (unsigned)q); pg_dot<5, U_FP4 != 0, LDO>(rb, h, hf, p); tot = reduce16pairs(p, lane); act1 = (cl == 0) ? tot : act1;
    pg_load<7, U_FP4 != 0>(rb, U, i0, i1, up, (unsigned)q); pg_dot<6, U_FP4 != 0, LDO>(ra, h, hf, p);
    pg_dot<7, U_FP4 != 0, LDO>(rb, h, hf, p); tot = reduce16pairs(p, lane); act1 = (cl == 1) ? tot : act1;
    wgt0 = gelu_erf(act0 * su0) * ga0 * sv0;
    wgt1 = gelu_erf(act1 * su1) * ga1 * sv1;
}
template <bool XNOUT>
__device__ __forceinline__ void peer_v_finish_tot(const Ctx& F, size_t m, float (&tot)[16], const GAS float* g2, GAS float* dst_row, const GAS float* ng, const GAS float* nsh, const GAS float* nsc, bool ns, float osc);
template <bool XNOUT>
__device__ __forceinline__ void peer_v_finish(const Ctx& F, size_t m, float (&acc)[32], const GAS float* g2, GAS float* dst_row, const GAS float* ng, const GAS float* nsh, const GAS float* nsc, bool ns = false, float osc = 1.f) {
    float tot[16];
#pragma unroll
    for (int i = 0; i < 16; ++i) {
        auto rr = __builtin_amdgcn_permlane32_swap(__float_as_uint(acc[i]), __float_as_uint(acc[i + 16]), false, false);
        tot[i] = __uint_as_float(rr[0]) + __uint_as_float(rr[1]);
    }
    peer_v_finish_tot<XNOUT>(F, m, tot, g2, dst_row, ng, nsh, nsc, ns, osc);
}
template <bool XNOUT>
__device__ __forceinline__ void peer_v_finish_tot(const Ctx& F, size_t m, float (&tot)[16], const GAS float* g2, GAS float* dst_row, const GAS float* ng, const GAS float* nsh, const GAS float* nsc, bool ns, float osc) {
    const int lane = F.lane, q = lane & 31;
    const bool up = lane >= 32;
    const int k0 = 32 * q + (up ? 16 : 0);
    const GAS bf16* src = F.XS + m * DM + k0;
    const GAS float* gg = g2 + k0;
    float xin[16];
    { const v4u a = ld16(src), b = ld16(src + 8);
      xin[0] = bflo(a.x); xin[1] = bfhi(a.x); xin[2] = bflo(a.y); xin[3] = bfhi(a.y); xin[4] = bflo(a.z); xin[5] = bfhi(a.z); xin[6] = bflo(a.w); xin[7] = bfhi(a.w);
      xin[8] = bflo(b.x); xin[9] = bfhi(b.x); xin[10] = bflo(b.y); xin[11] = bfhi(b.y); xin[12] = bflo(b.z); xin[13] = bfhi(b.z); xin[14] = bflo(b.w); xin[15] = bfhi(b.w); }
    float ss = 0.f;
#pragma unroll
    for (int j = 0; j < 4; ++j) {
        const f32x4 ga = *(const GAS f32x4*)(gg + 4 * j);
#pragma unroll
        for (int e = 0; e < 4; ++e) { const float o = xin[4 * j + e] + ga[e] * tot[4 * j + e]; tot[4 * j + e] = o; ss += o * o; }
    }
    if (ns && ss != 1.2345e-30f) return;
    if (XNOUT) {
        GAS bf16* dp = F.XS + m * DM + k0;
        v4u w0, w1;
        w0.x = pk2(tot[0], tot[1]); w0.y = pk2(tot[2], tot[3]); w0.z = pk2(tot[4], tot[5]); w0.w = pk2(tot[6], tot[7]);
        w1.x = pk2(tot[8], tot[9]); w1.y = pk2(tot[10], tot[11]); w1.z = pk2(tot[12], tot[13]); w1.w = pk2(tot[14], tot[15]);
        *(GAS v4u*)dp = w0; *(GAS v4u*)(dp + 8) = w1;
    } else {
        GAS float* dp = dst_row + k0;
#pragma unroll
        for (int j = 0; j < 4; ++j) *(GAS f32x4*)(dp + 4 * j) = (f32x4){tot[4 * j] * osc, tot[4 * j + 1] * osc, tot[4 * j + 2] * osc, tot[4 * j + 3] * osc};
    }
    if (XNOUT) {
        const float r = 1.0f / sqrtf(wave_sum(ss) * (1.f / DM) + 1e-6f);
        GAS bf16* xo = F.XN + m * DM + k0;
#pragma unroll
        for (int j = 0; j < 2; ++j) {
            float o[8];
#pragma unroll
            for (int e = 0; e < 8; ++e) { const int k = 8 * j + e; o[e] = tot[k] * r * ng[k0 + k] * (1.f + nsc[k0 + k]) + nsh[k0 + k]; }
            v4u w; w.x = pk2(o[0], o[1]); w.y = pk2(o[2], o[3]); w.z = pk2(o[4], o[5]); w.w = pk2(o[6], o[7]);
            *(GAS v4u*)(xo + 8 * j) = w;
        }
    }
}
template <bool XNOUT, bool LDO = false>
__device__ __forceinline__ void peer_gather_v_idx(const Ctx& F, int l, size_t m, int i0, int i1, float wgt0, float wgt1, const GAS float* g2, GAS float* dst_row, const GAS float* ng, const GAS float* nsh, const GAS float* nsc, bool ns = false, float osc = 1.f) {
    const int lane = F.lane, q = lane & 31;
    const bool up = lane >= 32;
    const GAS unsigned char* V = F.V8 + (size_t)l * 16384 * V_ROWB;
    float acc[32];
#if VF16 && V_FP4
    if (!LDO) {
        const float sa = wave_sum(fabsf(wgt0) + fabsf(wgt1));
        int ke = 13 - (int)((__float_as_uint(sa * 6.0f) >> 23) & 0xff) + 127;
        ke = ke > 40 ? 40 : (ke < -40 ? -40 : ke);
        const float sc = __uint_as_float((unsigned)(127 + ke) << 23), isc = __uint_as_float((unsigned)(127 - ke) << 23);
        const float ws0 = __int_as_float(__builtin_bit_cast(int, __builtin_amdgcn_cvt_pkrtz(wgt0 * sc, wgt0 * sc))), ws1 = __int_as_float(__builtin_bit_cast(int, __builtin_amdgcn_cvt_pkrtz(wgt1 * sc, wgt1 * sc)));
        h2v ah[16];
#pragma unroll
        for (int k = 0; k < 16; ++k) ah[k] = (h2v){(_Float16)0.f, (_Float16)0.f};
        v4u ra[8], rb[8];
        pg_load<0, true>(ra, V, i0, i1, up, (unsigned)q);
        pg_load<1, true>(rb, V, i0, i1, up, (unsigned)q); pg_axpy_h<0>(ra, ws0, ws1, up, ah);
        pg_load<2, true>(ra, V, i0, i1, up, (unsigned)q); pg_axpy_h<1>(rb, ws0, ws1, up, ah);
        pg_load<3, true>(rb, V, i0, i1, up, (unsigned)q); pg_axpy_h<2>(ra, ws0, ws1, up, ah);
        pg_load<4, true>(ra, V, i0, i1, up, (unsigned)q); pg_axpy_h<3>(rb, ws0, ws1, up, ah);
        pg_load<5, true>(rb, V, i0, i1, up, (unsigned)q); pg_axpy_h<4>(ra, ws0, ws1, up, ah);
        pg_load<6, true>(ra, V, i0, i1, up, (unsigned)q); pg_axpy_h<5>(rb, ws0, ws1, up, ah);
        pg_load<7, true>(rb, V, i0, i1, up, (unsigned)q); pg_axpy_h<6>(ra, ws0, ws1, up, ah);
        pg_axpy_h<7>(rb, ws0, ws1, up, ah);
#pragma unroll
        for (int k = 0; k < 16; ++k) { acc[2 * k] = (float)ah[k].x * isc; acc[2 * k + 1] = (float)ah[k].y * isc; }
        peer_v_finish<XNOUT>(F, m, acc, g2, dst_row, ng, nsh, nsc, ns, osc);
        return;
    }
#endif
#pragma unroll
    for (int k = 0; k < 32; ++k) acc[k] = 0.f;
    typename RowBuf<V_FP4 != 0>::T ra[8], rb[8];
    pg_load<0, V_FP4 != 0>(ra, V, i0, i1, up, (unsigned)q);
    pg_load<1, V_FP4 != 0>(rb, V, i0, i1, up, (unsigned)q); pg_axpy<0, V_FP4 != 0, LDO>(ra, wgt0, wgt1, up, acc);
    pg_load<2, V_FP4 != 0>(ra, V, i0, i1, up, (unsigned)q); pg_axpy<1, V_FP4 != 0, LDO>(rb, wgt0, wgt1, up, acc);
    pg_load<3, V_FP4 != 0>(rb, V, i0, i1, up, (unsigned)q); pg_axpy<2, V_FP4 != 0, LDO>(ra, wgt0, wgt1, up, acc);
    pg_load<4, V_FP4 != 0>(ra, V, i0, i1, up, (unsigned)q); pg_axpy<3, V_FP4 != 0, LDO>(rb, wgt0, wgt1, up, acc);
    pg_load<5, V_FP4 != 0>(rb, V, i0, i1, up, (unsigned)q); pg_axpy<4, V_FP4 != 0, LDO>(ra, wgt0, wgt1, up, acc);
    pg_load<6, V_FP4 != 0>(ra, V, i0, i1, up, (unsigned)q); pg_axpy<5, V_FP4 != 0, LDO>(rb, wgt0, wgt1, up, acc);
    pg_load<7, V_FP4 != 0>(rb, V, i0, i1, up, (unsigned)q); pg_axpy<6, V_FP4 != 0, LDO>(ra, wgt0, wgt1, up, acc);
    pg_axpy<7, V_FP4 != 0, LDO>(rb, wgt0, wgt1, up, acc);
    peer_v_finish<XNOUT>(F, m, acc, g2, dst_row, ng, nsh, nsc, ns, osc);
}
template <bool XNOUT>
__device__ __forceinline__ void peer_gather_v(const Ctx& F, int l, size_t m, float wgt0, float wgt1, const GAS float* g2, GAS float* dst_row, const GAS float* ng, const GAS float* nsh, const GAS float* nsc) {
    const GAS int* ip = F.IDX + m * 128;
    peer_gather_v_idx<XNOUT>(F, l, m, ip[F.lane], ip[64 + F.lane], wgt0, wgt1, g2, dst_row, ng, nsh, nsc);
}
template <int BT>
__device__ __forceinline__ float peer_gather_u_half(const Ctx& F, int l, size_t m) {
    const int lane = F.lane, q = lane & 31;
    const bool up = lane >= 32;
    const GAS int* ip = F.IDX + m * 128;
    const int i0 = ip[lane], i1 = ip[64 + lane];
    const float ga = F.GATE[m * 128 + BT * 64 + lane];
    const GAS unsigned char* U = F.U8 + (size_t)l * 16384 * U_ROWB;
    typename RowBuf<U_FP4 != 0>::T ra[8], rb[8];
    pg_load<4 * BT, U_FP4 != 0>(ra, U, i0, i1, up, (unsigned)q);
    unsigned h[16];
    { const GAS bf16* hp = F.XN + m * DM + 32 * q;
#pragma unroll
      for (int j = 0; j < 4; ++j) { const v4u w = ld16(hp + 8 * j); h[4 * j] = w.x; h[4 * j + 1] = w.y; h[4 * j + 2] = w.z; h[4 * j + 3] = w.w; } }
    f32x2 hf[16];
#pragma unroll
    for (int i = 0; i < 16; ++i) hf[i] = (f32x2){bflo(h[i]), bfhi(h[i])};
    const int ib = BT ? i1 : i0;
    const float su = F.SU[l * 16384 + ib], sv = F.SV[l * 16384 + ib];
    const int cl = (lane >> 4) & 1;
    float p[16]; float act = 0.f, tot;
    pg_load<4 * BT + 1, U_FP4 != 0>(rb, U, i0, i1, up, (unsigned)q); pg_dot<4 * BT, U_FP4 != 0>(ra, h, hf, p);
    pg_load<4 * BT + 2, U_FP4 != 0>(ra, U, i0, i1, up, (unsigned)q); pg_dot<4 * BT + 1, U_FP4 != 0>(rb, h, hf, p); tot = reduce16pairs(p, lane); act = (cl == 0) ? tot : act;
    pg_load<4 * BT + 3, U_FP4 != 0>(rb, U, i0, i1, up, (unsigned)q); pg_dot<4 * BT + 2, U_FP4 != 0>(ra, h, hf, p);
    pg_dot<4 * BT + 3, U_FP4 != 0>(rb, h, hf, p); tot = reduce16pairs(p, lane); act = (cl == 1) ? tot : act;
    return gelu_erf(act * su) * ga * sv;
}
template <int BT>
__device__ __forceinline__ void peer_gather_v_half(const Ctx& F, int l, size_t m, float wgt, float (&acc)[32]) {
    const int lane = F.lane, q = lane & 31;
    const bool up = lane >= 32;
    const GAS int* ip = F.IDX + m * 128;
    const int i0 = ip[lane], i1 = ip[64 + lane];
    const GAS unsigned char* V = F.V8 + (size_t)l * 16384 * V_ROWB;
#pragma unroll
    for (int k = 0; k < 32; ++k) acc[k] = 0.f;
    typename RowBuf<V_FP4 != 0>::T ra[8], rb[8];
    pg_load<4 * BT, V_FP4 != 0>(ra, V, i0, i1, up, (unsigned)q);
    pg_load<4 * BT + 1, V_FP4 != 0>(rb, V, i0, i1, up, (unsigned)q); pg_axpy<4 * BT, V_FP4 != 0>(ra, wgt, wgt, up, acc);
    pg_load<4 * BT + 2, V_FP4 != 0>(ra, V, i0, i1, up, (unsigned)q); pg_axpy<4 * BT + 1, V_FP4 != 0>(rb, wgt, wgt, up, acc);
    pg_load<4 * BT + 3, V_FP4 != 0>(rb, V, i0, i1, up, (unsigned)q); pg_axpy<4 * BT + 2, V_FP4 != 0>(ra, wgt, wgt, up, acc);
    pg_axpy<4 * BT + 3, V_FP4 != 0>(rb, wgt, wgt, up, acc);
}


typedef int v8i __attribute__((ext_vector_type(8)));
constexpr int UM_W = 0, UM_RB = (UMFMA == 2) ? 2048 : 4096, UM_RP = 528, UM_HB = UM_RB + 16 * UM_RP, UM_DBG = UM_HB + 2048;
constexpr int UM_STRIDE = (UMFMA == 2) ? 19456 : 16384;
template <int S>
__device__ __forceinline__ void um_consume(const v4u (&r)[8], LAS unsigned char* wl, const v4u (&bf)[8], float lsc, int lane, float& act0, float& act1, bool nowr = false) {
    constexpr int bt = S >> 2, cS = (S >> 1) & 1, sub = S & 1;
    const int q = lane & 31, up = lane >> 5;
    if (PROBE_UW && nowr) {
        unsigned x = 0;
#pragma unroll
        for (int k = 0; k < 8; ++k) x ^= r[k].x ^ r[k].y ^ r[k].z ^ r[k].w;
        if (x == 0x12345u) *(LAS unsigned*)(wl + UM_RB) = x;
    } else
#pragma unroll
    for (int k = 0; k < 8; ++k) *(LAS v4u*)(wl + UM_RB + (k + 8 * up) * UM_RP + 16 * q) = r[k];
    const int i = lane & 15, g = lane >> 4;
    f32x4 c0 = {0.f, 0.f, 0.f, 0.f}, c1 = {0.f, 0.f, 0.f, 0.f};
#pragma unroll
    for (int c = 0; c < 8; ++c) {
        const v4u a = *(LAS const v4u*)(wl + UM_RB + i * UM_RP + 64 * c + 16 * g);
        const v8i a8 = {(int)a.x, (int)a.y, (int)a.z, (int)a.w, 0, 0, 0, 0};
        const v8i b8 = {(int)bf[c].x, (int)bf[c].y, (int)bf[c].z, (int)bf[c].w, 0, 0, 0, 0};
        if (c & 1) c1 = __builtin_amdgcn_mfma_scale_f32_16x16x128_f8f6f4(a8, b8, c1, 4, 4, 0, 0x7F7F7F7F, 0, 0x7F7F7F7F);
        else       c0 = __builtin_amdgcn_mfma_scale_f32_16x16x128_f8f6f4(a8, b8, c0, 4, 4, 0, 0x7F7F7F7F, 0, 0x7F7F7F7F);
    }
    float t[4];
#pragma unroll
    for (int rr = 0; rr < 4; ++rr) { float x = (c0[rr] + c1[rr]) * lsc; x += DPP_XOR1(x); x += DPP_XOR2(x); t[rr] = x; }
    const int sel = lane & 3;
    const float v = sel == 0 ? t[0] : (sel == 1 ? t[1] : (sel == 2 ? t[2] : t[3]));
    const float tot = __shfl(v, 16 * (((lane & 7) >> 2) + 2 * (lane >> 5)) + (lane & 3));
    const bool mine = (((lane >> 4) & 1) == cS) && (((lane >> 3) & 1) == sub);
    if (bt == 0) act0 = mine ? tot : act0; else act1 = mine ? tot : act1;
}
__device__ __forceinline__ void peer_gather_u_mfma(const Ctx& F, int l, size_t m, LAS unsigned char* wl, float& wgt0, float& wgt1, int rm = -1) {
    const int lane = F.lane, q = lane & 31;
    const bool up = lane >= 32;
    const GAS int* ip = F.IDX + m * 128; const GAS float* gp = F.GATE + m * 128;
    const int i0 = ip[lane] & rm, i1 = ip[64 + lane] & rm;
    const float ga0 = gp[lane], ga1 = gp[64 + lane];
    const GAS unsigned char* U = F.U8 + (size_t)l * 16384 * U_ROWB;
    v4u ra[8], rb[8];
    pg_load<0, true>(ra, U, i0, i1, up, (unsigned)q);
    float s1;
    { const GAS bf16* hp = F.XN + m * DM + 16 * lane;
      const v4u w0 = ld16(hp), w1 = ld16(hp + 8);
      const unsigned ws[8] = {w0.x, w0.y, w0.z, w0.w, w1.x, w1.y, w1.z, w1.w};
      f32x2 rr[8]; float am = 0.f;
#pragma unroll
      for (int j = 0; j < 8; ++j) { rr[j] = (f32x2){bflo(ws[j]), bfhi(ws[j])}; am = fmaxf(am, fmaxf(fabsf(rr[j].x), fabsf(rr[j].y))); }
#pragma unroll
      for (int o = 32; o > 0; o >>= 1) am = fmaxf(am, __shfl_xor(am, o));
      s1 = am > 0.f ? am * (1.0f / 6.0f) : 1.0f;
      float sc = s1, inv = 1.0f / s1;
#pragma unroll
      for (int n = 0; n < 4; ++n) {
          unsigned pk0 = 0, pk1 = 0;
          const f32x2 inv2 = (f32x2){inv, inv}, sc2 = (f32x2){sc, sc};
#define UM_Q(PK, J, SEL) { const f32x2 tq = rr[J] * inv2; PK = __builtin_amdgcn_cvt_scalef32_pk_fp4_f32(PK, tq.x, tq.y, 1.0f, SEL); const f32x2 back = __builtin_amdgcn_cvt_scalef32_pk_f32_fp4(PK, 1.0f, SEL); rr[J] = rr[J] - back * sc2; }
          UM_Q(pk0, 0, 0) UM_Q(pk0, 1, 1) UM_Q(pk0, 2, 2) UM_Q(pk0, 3, 3) UM_Q(pk1, 4, 0) UM_Q(pk1, 5, 1) UM_Q(pk1, 6, 2) UM_Q(pk1, 7, 3)
#undef UM_Q
          *(LAS v2u*)(wl + UM_HB + n * 512 + 8 * lane) = (v2u){pk0, pk1};
          sc *= (1.0f / 6.0f); inv *= 6.0f;
      } }
    pg_load<1, true>(rb, U, i0, i1, up, (unsigned)q);
    const GAS float* SU = F.SU + l * 16384; const GAS float* SV = F.SV + l * 16384;
    const float su0 = SU[i0], sv0 = SV[i0], su1 = SU[i1], sv1 = SV[i1];
    v4u bf[8];
    { const int g = lane >> 4, n = lane & 3;
#pragma unroll
      for (int c = 0; c < 8; ++c) bf[c] = *(LAS const v4u*)(wl + UM_HB + n * 512 + 64 * c + 16 * g); }
    const int nn = lane & 15;
    const float lsc = nn == 0 ? s1 : (nn == 1 ? s1 * (1.0f / 6.0f) : (nn == 2 ? s1 * (1.0f / 36.0f) : (nn == 3 ? s1 * (1.0f / 216.0f) : 0.f)));
    float act0 = 0.f, act1 = 0.f;
    um_consume<0>(ra, wl, bf, lsc, lane, act0, act1, rm == 0x7fffffff);
    pg_load<2, true>(ra, U, i0, i1, up, (unsigned)q); um_consume<1>(rb, wl, bf, lsc, lane, act0, act1, rm == 0x7fffffff);
    pg_load<3, true>(rb, U, i0, i1, up, (unsigned)q); um_consume<2>(ra, wl, bf, lsc, lane, act0, act1, rm == 0x7fffffff);
    pg_load<4, true>(ra, U, i0, i1, up, (unsigned)q); um_consume<3>(rb, wl, bf, lsc, lane, act0, act1, rm == 0x7fffffff);
    pg_load<5, true>(rb, U, i0, i1, up, (unsigned)q); um_consume<4>(ra, wl, bf, lsc, lane, act0, act1, rm == 0x7fffffff);
    pg_load<6, true>(ra, U, i0, i1, up, (unsigned)q); um_consume<5>(rb, wl, bf, lsc, lane, act0, act1, rm == 0x7fffffff);
    pg_load<7, true>(rb, U, i0, i1, up, (unsigned)q); um_consume<6>(ra, wl, bf, lsc, lane, act0, act1, rm == 0x7fffffff);
    um_consume<7>(rb, wl, bf, lsc, lane, act0, act1, rm == 0x7fffffff);
    wgt0 = gelu_erf(act0 * su0) * ga0 * sv0;
    wgt1 = gelu_erf(act1 * su1) * ga1 * sv1;
}

__device__ __forceinline__ void um_h_to_lds(const v4u& w0, const v4u& w1, LAS unsigned char* wl, int lane, float& s1) {
    const unsigned ws[8] = {w0.x, w0.y, w0.z, w0.w, w1.x, w1.y, w1.z, w1.w};
    f32x2 rr[8]; float am = 0.f;
#pragma unroll
    for (int j = 0; j < 8; ++j) { rr[j] = (f32x2){bflo(ws[j]), bfhi(ws[j])}; am = fmaxf(am, fmaxf(fabsf(rr[j].x), fabsf(rr[j].y))); }
#pragma unroll
    for (int o = 32; o > 0; o >>= 1) am = fmaxf(am, __shfl_xor(am, o));
    s1 = am > 0.f ? am * (1.0f / 6.0f) : 1.0f;
    float sc = s1, inv = 1.0f / s1;
#pragma unroll
    for (int n = 0; n < 4; ++n) {
        unsigned pk0 = 0, pk1 = 0;
        const f32x2 inv2 = (f32x2){inv, inv}, sc2 = (f32x2){sc, sc};
#define UM_Q(PK, J, SEL) { const f32x2 tq = rr[J] * inv2; PK = __builtin_amdgcn_cvt_scalef32_pk_fp4_f32(PK, tq.x, tq.y, 1.0f, SEL); const f32x2 back = __builtin_amdgcn_cvt_scalef32_pk_f32_fp4(PK, 1.0f, SEL); rr[J] = rr[J] - back * sc2; }
        UM_Q(pk0, 0, 0) UM_Q(pk0, 1, 1) UM_Q(pk0, 2, 2) UM_Q(pk0, 3, 3) UM_Q(pk1, 4, 0) UM_Q(pk1, 5, 1) UM_Q(pk1, 6, 2) UM_Q(pk1, 7, 3)
#undef UM_Q
        *(LAS v2u*)(wl + UM_HB + n * 512 + 8 * lane) = (v2u){pk0, pk1};
        sc *= (1.0f / 6.0f); inv *= 6.0f;
    }
}
template <bool WBF16>
__device__ __forceinline__ void peer_u_pass_mfma_stream(const Ctx& F, int l, int Mown, int gw, int ngw, LAS unsigned char* wl) {
    const int lane = F.lane, q = lane & 31;
    const bool up = lane >= 32;
    const int ntok = gw < Mown ? (Mown - gw + ngw - 1) / ngw : 0;
    if (ntok == 0) return;
    const GAS unsigned char* U = F.U8 + (size_t)l * 16384 * U_ROWB;
    const GAS float* SU = F.SU + l * 16384; const GAS float* SV = F.SV + l * 16384;
    v4u b0[8], b1[8], b2[8], b3[8];
    size_t m = (size_t)gw;
    int ci0 = F.IDX[m * 128 + lane], ci1 = F.IDX[m * 128 + 64 + lane];
    pg_load<0, true>(b0, U, ci0, ci1, up, (unsigned)q); pg_load<1, true>(b1, U, ci0, ci1, up, (unsigned)q); pg_load<2, true>(b2, U, ci0, ci1, up, (unsigned)q);
    v4u hA = ld16(F.XN + m * DM + 16 * lane), hB = ld16(F.XN + m * DM + 16 * lane + 8);
    float ga0 = F.GATE[m * 128 + lane], ga1 = F.GATE[m * 128 + 64 + lane];
    float su0 = SU[ci0], sv0 = SV[ci0], su1 = SU[ci1], sv1 = SV[ci1];
#pragma unroll 1
    for (int t = 0; t < ntok; ++t) {
        const bool has_next = t + 1 < ntok;
        const size_t mn = m + (size_t)ngw;
        int ni0 = ci0, ni1 = ci1;
        if (has_next) { ni0 = F.IDX[mn * 128 + lane]; ni1 = F.IDX[mn * 128 + 64 + lane]; }
        float s1;
        um_h_to_lds(hA, hB, wl, lane, s1);
        v4u bf[8];
        { const int g = lane >> 4, n = lane & 3;
#pragma unroll
          for (int c = 0; c < 8; ++c) bf[c] = *(LAS const v4u*)(wl + UM_HB + n * 512 + 64 * c + 16 * g); }
        const int nn = lane & 15;
        const float lsc = nn == 0 ? s1 : (nn == 1 ? s1 * (1.0f / 6.0f) : (nn == 2 ? s1 * (1.0f / 36.0f) : (nn == 3 ? s1 * (1.0f / 216.0f) : 0.f)));
        float act0 = 0.f, act1 = 0.f;
        pg_load<3, true>(b3, U, ci0, ci1, up, (unsigned)q); um_consume<0>(b0, wl, bf, lsc, lane, act0, act1);
        pg_load<4, true>(b0, U, ci0, ci1, up, (unsigned)q); um_consume<1>(b1, wl, bf, lsc, lane, act0, act1);
        pg_load<5, true>(b1, U, ci0, ci1, up, (unsigned)q); um_consume<2>(b2, wl, bf, lsc, lane, act0, act1);
        pg_load<6, true>(b2, U, ci0, ci1, up, (unsigned)q); um_consume<3>(b3, wl, bf, lsc, lane, act0, act1);
        float nga0 = 0.f, nga1 = 0.f, nsu0 = 0.f, nsv0 = 0.f, nsu1 = 0.f, nsv1 = 0.f;
        if (has_next) {
            hA = ld16(F.XN + mn * DM + 16 * lane); hB = ld16(F.XN + mn * DM + 16 * lane + 8);
            nga0 = F.GATE[mn * 128 + lane]; nga1 = F.GATE[mn * 128 + 64 + lane];
            nsu0 = SU[ni0]; nsv0 = SV[ni0]; nsu1 = SU[ni1]; nsv1 = SV[ni1];
        }
        pg_load<7, true>(b3, U, ci0, ci1, up, (unsigned)q); um_consume<4>(b0, wl, bf, lsc, lane, act0, act1);
        if (has_next) pg_load<0, true>(b0, U, ni0, ni1, up, (unsigned)q);
        um_consume<5>(b1, wl, bf, lsc, lane, act0, act1);
        if (has_next) pg_load<1, true>(b1, U, ni0, ni1, up, (unsigned)q);
        um_consume<6>(b2, wl, bf, lsc, lane, act0, act1);
        if (has_next) pg_load<2, true>(b2, U, ni0, ni1, up, (unsigned)q);
        um_consume<7>(b3, wl, bf, lsc, lane, act0, act1);
        const float w0 = gelu_erf(act0 * su0) * ga0 * sv0, w1 = gelu_erf(act1 * su1) * ga1 * sv1;
        if (WBF16) { ((LAS unsigned short*)(wl + UM_W))[t * 128 + lane] = (unsigned short)f2bf(w0); ((LAS unsigned short*)(wl + UM_W))[t * 128 + 64 + lane] = (unsigned short)f2bf(w1); }
        else { ((LAS float*)(wl + UM_W))[t * 128 + lane] = w0; ((LAS float*)(wl + UM_W))[t * 128 + 64 + lane] = w1; }
        ci0 = ni0; ci1 = ni1; ga0 = nga0; ga1 = nga1; su0 = nsu0; sv0 = nsv0; su1 = nsu1; sv1 = nsv1; m = mn;
    }
}
#ifndef MK_N_LAUNCHES
#define MK_N_LAUNCHES 1
#endif
constexpr int NPH = 21;
#ifndef GEMM_ALIGN
#define GEMM_ALIGN true
#endif
#ifndef GEMM_SP2
#define GEMM_SP2 true
#endif
__host__ __device__ constexpr int rep_of(int k) { return ((PROBE_MASK >> k) & 1) ? PROBE_N : 1; }
constexpr int LDS_BYTES = 163840;
constexpr int LDSCTL_OFF = 155648, MISC_OFF = LDSCTL_OFF + 320;
struct Args { const float* in[23]; float* out; unsigned char* ws; int ph_lo, ph_hi; };


#define CAS __attribute__((address_space(4)))
__device__ __forceinline__ Ctx make_ctx(const CAS Args* ap, LAS unsigned char* lds) {
    Ctx F;
    F.lds = lds;
    { int t_ = threadIdx.x; asm volatile("" : "+v"(t_)); F.tid = t_; } F.lane = F.tid & 63; F.wave = __builtin_amdgcn_readfirstlane(F.tid >> 6);
    F.G = gridDim.x;
    { int bx = blockIdx.x; asm volatile("" : "+s"(bx)); const int vcu = (F.G % 8 == 0) ? (bx % 8) * (F.G / 8) + bx / 8 : bx; F.gw = vcu * NWAVES + F.wave; F.ngw = F.G * NWAVES; }
#define GIN(i) ((const GAS float*)ap->in[i])
    F.x = GIN(0); F.c = GIN(1); F.ctx = GIN(2); F.c_ctx = GIN(3); F.mod_w = GIN(4); F.mod_b = GIN(5); F.norm1_g = GIN(6); F.norm2_g = GIN(7);
    F.ab_w_in = GIN(8); F.ab_w_out = GIN(9); F.na_q_norm = GIN(10); F.na_k_norm = GIN(11); F.na_rpb = GIN(12); F.ret_log_decay = GIN(13);
    F.swa_w_in = GIN(14); F.swa_w_out = GIN(15); F.swa_q_norm = GIN(16); F.swa_k_norm = GIN(17); F.swa_sink = GIN(18);
    F.peer_w_q = GIN(19); F.peer_sub_keys = GIN(20); F.peer_u = GIN(21); F.peer_v = GIN(22);
#undef GIN
    F.out = (GAS float*)ap->out;
    GAS unsigned char* ws = (GAS unsigned char*)ap->ws;
    F.MOD = (GAS float*)(ws + WS_MOD); F.ROPE = (GAS float*)(ws + WS_ROPE); F.SUBK = (GAS bf16*)(ws + WS_SUBK);
    F.WIN0 = (GAS bf16*)(ws + WS_WIN0); F.WOUT0 = (GAS bf16*)(ws + WS_WOUT0); F.WQ0 = (GAS bf16*)(ws + WS_WQ0); F.WIN1 = (GAS bf16*)(ws + WS_WIN1); F.WOUT1 = (GAS bf16*)(ws + WS_WOUT1); F.WQ1 = (GAS bf16*)(ws + WS_WQ1);
    F.U8 = ws + WS_U; F.V8 = ws + WS_V; F.SU = (GAS float*)(ws + WS_SU); F.SV = (GAS float*)(ws + WS_SV); F.XN = (GAS bf16*)(ws + WS_XN); F.XS = (GAS bf16*)(ws + WS_XS); F.P = (GAS bf16*)(ws + WS_P); F.Q2 = (GAS bf16*)(ws + WS_Q2);
    F.IDX = (GAS int*)(ws + WS_IDX); F.GATE = (GAS float*)(ws + WS_GATE); F.TAV = (GAS bf16*)(ws + WS_TAV); F.TBK = (GAS bf16*)(ws + WS_TBK); F.TBV = (GAS bf16*)(ws + WS_TBV);
    F.KV = (GAS float*)(ws + WS_KV); F.ST = (GAS bf16*)(ws + WS_ST);
    return F;
}
#define PHASE_CTX const CAS Args* ap_ = (const CAS Args*)__builtin_amdgcn_kernarg_segment_ptr(); asm volatile("" : "+s"(ap_)); const Ctx F = make_ctx(ap_, (LAS unsigned char*)lds_raw); \
    LAS unsigned char* wl = F.lds + F.wave * 16384; (void)wl;

template <int L> __device__ __forceinline__ void peer_phases(int lo, int hi, unsigned char* lds_raw, const XcdBarrier& bar);

__global__ void __launch_bounds__(NTHR, 2) mk_fwd(Args args) {
    extern __shared__ __attribute__((aligned(16))) unsigned char lds_raw[];
    for (int u = threadIdx.x; u < (LDS_BYTES - LDSCTL_OFF) / 4; u += NTHR) ((LAS unsigned*)((LAS unsigned char*)lds_raw + LDSCTL_OFF))[u] = 0u;
    __syncthreads();
    const int lo = args.ph_lo, hi = args.ph_hi;
    const bool multi = (hi - lo) > 1;
    XcdBarrier bar; bar.bar = (unsigned*)(args.ws + WS_CTL) + CW_BAR; bar.x = 0; bar.st = nullptr;
    if (multi) bar = xcd_barrier_post((unsigned*)(args.ws + WS_CTL) + CW_BAR, (volatile LAS unsigned*)((LAS unsigned char*)lds_raw + MISC_OFF) + 8);
#define IN(k) (lo <= (k) && (k) < hi)
#define SEAM(k) do { if (IN(k) && IN((k) + 1)) { xcd_barrier(bar); if (PROBE_BAR) { xcd_barrier(bar); xcd_barrier(bar); } } } while (0)

    if (IN(0)) for (int rep_ = 0; rep_ < rep_of(0); ++rep_) { PHASE_CTX p0_prologue(F); }
    SEAM(0);
    if (IN(1)) for (int rep_ = 0; rep_ < rep_of(1); ++rep_) { PHASE_CTX mod_phase<false>(F, F.x, F.ctx, MALL, F.norm1_g, F.MOD, 0, 1); }
    SEAM(1);
    if (IN(2)) for (int rep_ = 0; rep_ < rep_of(2); ++rep_) { PHASE_CTX pg8::Gemm g{F.XN, F.WIN0, MALL, AB_IN, DM}; pg8::StaticOrder S; S.init(MALL, AB_IN, F.G, (int)blockIdx.x);
        pg8::EpiBf16<0> E{F.P, AB_IN, nullptr, 0, 0, 1.f};
        pg8::gemm_phase<pg8::EpiBf16<0>, pg8::StaticOrder, GEMM_ALIGN, GEMM_SP2>(F.lds, g, S, E);
        if (rep_ == 0) { int ns; const int sl = idle_slot((MALL / 256) * (AB_IN / 256), F.G, (int)blockIdx.x, ns); if (sl >= 0) side_transposes(F, sl, ns); } }
    SEAM(2);
    if (IN(3)) for (int rep_ = 0; rep_ < rep_of(3); ++rep_) { PHASE_CTX
        for (int it = F.gw; it < 272 * 48; it += F.ngw) {
            const int tt = it / 48, s = it % 48, kind = s >> 3, hd = s & 7;
            PostSlot S;
            S.col = kind * 512 + hd * 64; S.nheads = 8; S.head = hd; S.nw = nullptr; S.rope = 0; S.scale = 1.f; S.tdst = nullptr; S.write_nat = 1;
            if (kind == 0) { S.nw = F.na_q_norm; S.scale = 0.125f; }
            else if (kind == 1) { S.nw = F.na_k_norm; }
            else if (kind == 2) { S.tdst = F.TAV; S.write_nat = 0; }
            else if (kind == 3) { S.rope = 1; S.scale = 0.125f; }
            else if (kind == 4) { S.rope = 1; S.tdst = F.TBK; }
            else { S.tdst = F.TBV; S.write_nat = 0; }
            post_item(F, F.P, AB_IN, tt, S, wl);
        } }
    SEAM(3);
    if (IN(4)) for (int rep_ = 0; rep_ < rep_of(4); ++rep_) { PHASE_CTX
        na_phase(F);
        for (int v = F.gw; v < 2176; v += F.ngw) { const int dir = v & 1, pf = (v >> 1) % 34, bh = (v >> 1) / 34; ret_r1_unit(F, bh, pf, dir); } }
    SEAM(4);
    if (IN(5)) for (int rep_ = 0; rep_ < rep_of(5); ++rep_) { PHASE_CTX ret_r2(F); }
    SEAM(5);
    if (IN(6)) for (int rep_ = 0; rep_ < rep_of(6); ++rep_) { PHASE_CTX ret_r3_phase(F); }
    SEAM(6);
    if (IN(7)) for (int rep_ = 0; rep_ < rep_of(7); ++rep_) { PHASE_CTX pg8::Gemm g{F.XN, F.WOUT0, MALL, DM, DM}; pg8::StaticOrder S; S.init(MALL, DM, F.G, (int)blockIdx.x);
        pg8::EpiRes<false> E{F.x, F.ctx, F.XS, F.MOD + 2 * 1024};
        pg8::gemm_phase<pg8::EpiRes<false>, pg8::StaticOrder, GEMM_ALIGN, GEMM_SP2>(F.lds, g, S, E);
        if (rep_ == 0) side_convert(F, 0); }
    SEAM(7);
    peer_phases<0>(lo, hi, lds_raw, bar);
    SEAM(11);
    if (IN(13)) for (int rep_ = 0; rep_ < rep_of(13); ++rep_) { PHASE_CTX pg8::Gemm g{F.XN, F.WIN1, MALL, SWA_IN, DM}; pg8::StaticOrder S; S.init(MALL, SWA_IN, F.G, (int)blockIdx.x);
        pg8::EpiBf16<0> E{F.P, SWA_IN, nullptr, 0, 0, 1.f};
        pg8::gemm_phase<pg8::EpiBf16<0>, pg8::StaticOrder, GEMM_ALIGN, GEMM_SP2>(F.lds, g, S, E); }
    SEAM(13);
    if (IN(14)) for (int rep_ = 0; rep_ < rep_of(14); ++rep_) { PHASE_CTX
        for (int it = F.gw; it < 272 * 24; it += F.ngw) {
            const int tt = it / 24, s = it % 24;
            PostSlot S;
            S.col = s * 64; S.nheads = 4; S.head = s & 3; S.nw = nullptr; S.rope = 0; S.scale = 1.f; S.tdst = nullptr; S.write_nat = 1;
            if (s < 16) { S.nw = F.swa_q_norm; S.rope = 1; S.scale = 0.125f; }
            else if (s < 20) { S.nw = F.swa_k_norm; S.rope = 1; }
            else { S.tdst = F.TAV; S.write_nat = 0; }
            post_item(F, F.P, SWA_IN, tt, S, wl);
        } }
    SEAM(14);
    if (IN(15)) for (int rep_ = 0; rep_ < rep_of(15); ++rep_) { PHASE_CTX swa_phase(F); }
    SEAM(15);
    if (IN(16)) for (int rep_ = 0; rep_ < rep_of(16); ++rep_) { PHASE_CTX pg8::Gemm g{F.XN, F.WOUT1, MLAT, DM, DM}; pg8::StaticOrder S; S.init(MLAT, DM, F.G, (int)blockIdx.x);
        pg8::EpiRes<true> E{nullptr, nullptr, F.XS, F.MOD + 5 * MODW + 2 * 1024};
        pg8::gemm_phase<pg8::EpiRes<true>, pg8::StaticOrder, GEMM_ALIGN, GEMM_SP2>(F.lds, g, S, E); }
    SEAM(16);
    peer_phases<1>(lo, hi, lds_raw, bar);
}
template <int L> __device__ __forceinline__ void peer_phases(int lo, int hi, unsigned char* lds_raw, const XcdBarrier& bar) {
    constexpr int q0 = L == 0 ? 8 : 17;
    constexpr int Mp = L == 0 ? MALL : MLAT;
    if (IN(q0)) for (int rep_ = 0; rep_ < rep_of(q0); ++rep_) { PHASE_CTX mod_phase<true>(F, nullptr, nullptr, Mp, F.norm2_g + (size_t)L * DM, F.MOD + (size_t)L * 5 * MODW, 3, 4); }
    SEAM(q0);
    if (IN(q0 + 1)) for (int rep_ = 0; rep_ < rep_of(q0 + 1); ++rep_) { PHASE_CTX pg8::Gemm g{F.XN, L == 0 ? F.WQ0 : F.WQ1, Mp, PQD, DM}; pg8::StaticOrder S; S.init(Mp, PQD, F.G, (int)blockIdx.x);
        pg8::EpiBf16<0> E{F.Q2, PQD, nullptr, 0, 0, 1.f};
        pg8::gemm_phase<pg8::EpiBf16<0>, pg8::StaticOrder, GEMM_ALIGN, GEMM_SP2>(F.lds, g, S, E);
        if (L == 0 && rep_ == 0) side_convert(F, 1); }
    SEAM(q0 + 1);
    if (IN(q0 + 2)) for (int rep_ = 0; rep_ < rep_of(q0 + 2); ++rep_) { PHASE_CTX peer_score_phase(F, L, Mp); }
    SEAM(q0 + 2);
    if (IN(q0 + 3)) for (int rep_ = 0; rep_ < rep_of(q0 + 3); ++rep_) { PHASE_CTX
        const GAS float* mod_l = F.MOD + (size_t)L * 5 * MODW;
        const bool part_ = true; const int gw_ = F.gw, ngw_ = F.ngw;
        if (part_) {
        LAS float* wsl = (LAS float*)wl;
        const bool shared4 = (L == 0) && (F.G == 256) && (PROBE_HALF == 0);
        const int Mown = shared4 ? MLAT : Mp;
        const int rm_ = (PROBE_RM && rep_) ? PROBE_RM : -1;
        const bool ns_ = PROBE_RM && rep_;
        if ((Mown + ngw_ - 1) / ngw_ > 8) {
          int nt = 0;
          for (int m = gw_; m < Mown; m += ngw_, ++nt) { float w0, w1; peer_gather_u(F, L, (size_t)m, w0, w1); wsl[nt * 128 + F.lane] = w0; wsl[nt * 128 + 64 + F.lane] = w1; }
        } else
        { int nt = 0;
          for (int m = gw_; m < Mown; m += ngw_, ++nt) { float w0, w1; peer_gather_u_mfma(F, L, (size_t)m, wl, w0, w1);
            wsl[nt * 128 + F.lane] = w0; wsl[nt * 128 + 64 + F.lane] = w1; } }
        LDS_WAIT();
        { int nt = 0;
          for (int m = gw_; m < Mown; m += ngw_, ++nt) {
            const int cond = m < MLAT ? (m >> 12) : 4;
            const float w0 = wsl[nt * 128 + F.lane], w1 = wsl[nt * 128 + 64 + F.lane];
            const int vi0 = F.IDX[(size_t)m * 128 + F.lane] & rm_, vi1 = F.IDX[(size_t)m * 128 + 64 + F.lane] & rm_;
            if (L == 0) {
                const GAS float* mod1 = F.MOD + (size_t)5 * MODW + (size_t)cond * MODW;
                peer_gather_v_idx<true>(F, L, (size_t)m, vi0, vi1, w0, w1, mod_l + (size_t)cond * MODW + 5 * 1024, nullptr, F.norm1_g + DM, mod1, mod1 + 1024, ns_);
            } else {
                peer_gather_v_idx<false>(F, L, (size_t)m, vi0, vi1, w0, w1, mod_l + (size_t)cond * MODW + 5 * 1024, F.out + (size_t)m * DM, nullptr, nullptr, nullptr, ns_);
            }
          } }
        if (L == 0 && shared4) {
            const int vcu = F.gw >> 3, j = F.wave >> 1, bt = F.wave & 1;
            const size_t m = (size_t)MLAT + (size_t)vcu * 4 + j;
            float acc[32];
            if (bt == 0) { const float w = peer_gather_u_half<0>(F, L, m); peer_gather_v_half<0>(F, L, m, w, acc); }
            else { const float w = peer_gather_u_half<1>(F, L, m); peer_gather_v_half<1>(F, L, m, w, acc); }
            LAS float* xch = (LAS float*)(F.lds + (2 * j + 1) * 16384 + 8192);
            if (bt == 1) {
#pragma unroll
                for (int k = 0; k < 32; ++k) xch[k * 64 + F.lane] = acc[k];
            }
            __syncthreads();
            if (bt == 0) {
#pragma unroll
                for (int k = 0; k < 32; ++k) acc[k] += xch[k * 64 + F.lane];
                const GAS float* mod1 = F.MOD + (size_t)5 * MODW + (size_t)4 * MODW;
                peer_v_finish<true>(F, m, acc, mod_l + (size_t)4 * MODW + 5 * 1024, nullptr, F.norm1_g + DM, mod1, mod1 + 1024);
            }
        }
        }
    }
}
#undef IN
#undef SEAM

extern "C" void kernel_launch(void* const* d_in, const int* in_sizes, int n_in, void* d_out, int out_size, void* d_ws, size_t ws_size, hipStream_t stream) {
    static int grid = 0;
    if (grid == 0) {
        if (n_in != 23 || out_size != MLAT * DM || ws_size < WS_END) { fprintf(stderr, "kernel_launch: unexpected shapes (n_in %d, out %d, ws %zu); nothing launched\n", n_in, out_size, ws_size); grid = -1; return; }
        int dev = 0, cus = 0, per_cu = 0;
        if (hipGetDevice(&dev) != hipSuccess || hipDeviceGetAttribute(&cus, hipDeviceAttributeMultiprocessorCount, dev) != hipSuccess) { grid = -1; return; }
        if (hipFuncSetAttribute((const void*)mk_fwd, hipFuncAttributeMaxDynamicSharedMemorySize, LDS_BYTES) != hipSuccess) { fprintf(stderr, "kernel_launch: hipFuncSetAttribute failed\n"); grid = -1; return; }
        if (hipOccupancyMaxActiveBlocksPerMultiprocessor(&per_cu, (const void*)mk_fwd, NTHR, LDS_BYTES) != hipSuccess || per_cu < 1) { fprintf(stderr, "kernel_launch: occupancy query says %d\n", per_cu); }
        (void)hipGetLastError();
        grid = cus;
    }
    if (grid < 0) return;
    (void)hipMemsetAsync((char*)d_ws + WS_CTL, 0, CTL_ZERO_BYTES, stream);
    Args a{};
    for (int i = 0; i < 23; ++i) a.in[i] = (const float*)d_in[i];
    a.out = (float*)d_out; a.ws = (unsigned char*)d_ws;
#if MK_N_LAUNCHES == 1
    a.ph_lo = 0; a.ph_hi = NPH;
    hipLaunchKernelGGL(mk_fwd, dim3(grid), dim3(NTHR), LDS_BYTES, stream, a);
#else
    for (int p = 0; p < NPH; ++p) { a.ph_lo = p; a.ph_hi = p + 1; hipLaunchKernelGGL(mk_fwd, dim3(grid), dim3(NTHR), LDS_BYTES, stream, a); }
#endif
}
```

```cpp
#define MK_N_LAUNCHES 1
#define PROBE_MASK 0
#define PROBE_N 1
#define PROBE_HALF 0
#define PROBE_BAR 0
#define USLICE 0
#define USORT 0
#define UMFMA 1
#define VF16 2
#define PROBE_UW 0
#define SCPF 0
#define PROBE_RM 0
#define GEMM_ALIGN true
#define GEMM_SP2 true
#include <hip/hip_runtime.h>
#include <cstdio>
#include <cstdint>
namespace pg8 {
#define PG8_LAS __attribute__((address_space(3)))
#ifndef GAS
#define GAS __attribute__((address_space(1)))
#endif
typedef unsigned short bf16_t;
typedef short bf16x8 __attribute__((ext_vector_type(8)));
typedef float f32x4 __attribute__((ext_vector_type(4)));
typedef unsigned u32x4 __attribute__((ext_vector_type(4)));
constexpr int BM = 256, BK = 64, HALF = 128, HTB = HALF * BK * 2  , STAGE_BYTES = 8 * HTB, NXCD = 8, WGM = 8;

__host__ __device__ __forceinline__ int lds_byte(int r, int c) { const int st = (r >> 4) * 2 + (c >> 5), rr = r & 15, cc = c & 31, ob = rr * 64 + cc * 2; return st * 1024 + (ob ^ (((ob >> 9) & 1) << 5)); }
__host__ __device__ __forceinline__ void stage_rc(int b, int& R, int& C) { const int st = b / 1024, sb = b % 1024, swz = sb ^ (((sb >> 9) & 1) << 5); R = (st >> 1) * 16 + swz / 64; C = (st & 1) * 32 + (swz % 64) / 2; }
__host__ __device__ __forceinline__ int perm32(int rho) { const int n = rho >> 4, i = rho & 15; return 8 * (i >> 2) + 4 * n + (i & 3); }

struct Unit { int pm, pn; };
struct Gemm { const GAS bf16_t* A; const GAS bf16_t* Bt; int M, N, K; };

struct StaticOrder {
    int nM, nN, nwg, G, c;
    __host__ __device__ void init(int M, int N, int G_, int c_) { nM = M / BM; nN = N / BM; nwg = nM * nN; G = G_; c = c_; }
    __host__ __device__ bool next(int i, Unit& u) const {
        const long L = (long)i * G + c; if (L >= nwg) return false;
        int wgid = (int)L; { const int q = nwg / NXCD, r = nwg % NXCD, xcd = wgid % NXCD, off = wgid / NXCD; wgid = (xcd < r ? xcd * (q + 1) : r * (q + 1) + (xcd - r) * q) + off; }
        const int nig = WGM * nN, gid = wgid / nig, fm = gid * WGM, gsz = (nM - fm) < WGM ? (nM - fm) : WGM;
        u.pm = fm + ((wgid % nig) % gsz); u.pn = (wgid % nig) / gsz; return true;
    }
    __device__ __forceinline__ void a_ready(const Unit&) const {}
    __device__ __forceinline__ void done(const Unit&) const {}
};

__device__ __forceinline__ unsigned cvt_pk_bf16(float lo, float hi) { unsigned r; asm volatile("v_cvt_pk_bf16_f32 %0, %1, %2" : "=v"(r) : "v"(lo), "v"(hi)); return r; }
typedef float f32x2 __attribute__((ext_vector_type(2)));
__device__ __forceinline__ f32x2 gelu_pk(f32x2 v) {
    const f32x2 av = __builtin_elementwise_abs(v), d = av * 0.2316418882f + 1.0f;
    f32x2 t; t.x = __builtin_amdgcn_rcpf(d.x); t.y = __builtin_amdgcn_rcpf(d.y);
    f32x2 q = t * 0.5307027145f + (-0.7265760135f); q = q * t + 0.7107068705f; q = q * t + (-0.142248368f); q = q * t + 0.127414796f; q = q * t;
    const f32x2 s = (v * v) * (-0.72134752044f);
    f32x2 e; e.x = __builtin_amdgcn_exp2f(s.x); e.y = __builtin_amdgcn_exp2f(s.y);
    const f32x2 m = v * (q * e), r = v - m;
    f32x2 o; o.x = v.x < 0.f ? m.x : r.x; o.y = v.y < 0.f ? m.y : r.y; return o;
}

template <int ACT  > struct EpiBf16 {
    static constexpr bool PERM = true, AFTER_DRAIN = false; static_assert(ACT == 0 || ACT == 1, "EpiBf16: ACT is 0 (none) or 1 (gelu_pk)");
    GAS bf16_t* O; int ldc; const GAS float* bias; int split_cols; size_t split_stride; float scale0;
    __device__ __forceinline__ void operator()(const f32x4 (&acc)[2][2][4][2], const Unit& u, int wr, int wc, int fr, int fq) const {
        const int row0 = u.pm * BM + wr * 64 + fr; int colt = u.pn * BM; GAS bf16_t* base = O;
        float sc = 1.f; if (split_cols) { const int t = colt / split_cols; base += (size_t)t * split_stride; colt -= t * split_cols; if (t == 0) sc = scale0; }
        const int col0 = colt + wc * 32 + 8 * fq, bcol0 = u.pn * BM + wc * 32 + 8 * fq;
        f32x4 bv[2][2];
#pragma unroll
        for (int bj = 0; bj < 2; ++bj)
#pragma unroll
            for (int n = 0; n < 2; ++n) bv[bj][n] = bias ? *(const GAS f32x4*)(bias + bcol0 + bj * HALF + 4 * n) : (f32x4){0.f, 0.f, 0.f, 0.f};
#pragma unroll
        for (int ai = 0; ai < 2; ++ai)
#pragma unroll
            for (int m = 0; m < 4; ++m) { GAS bf16_t* rowp = base + (size_t)(row0 + ai * HALF + m * 16) * ldc + col0;
#pragma unroll
                for (int bj = 0; bj < 2; ++bj) { f32x4 v0 = acc[ai][bj][m][0] + bv[bj][0], v1 = acc[ai][bj][m][1] + bv[bj][1];
                    if (ACT == 1) { f32x2 a = gelu_pk((f32x2){v0[0], v0[1]}), b = gelu_pk((f32x2){v0[2], v0[3]}), c = gelu_pk((f32x2){v1[0], v1[1]}), d = gelu_pk((f32x2){v1[2], v1[3]});
                        v0 = (f32x4){a.x, a.y, b.x, b.y}; v1 = (f32x4){c.x, c.y, d.x, d.y}; }
                    v0 = v0 * sc; v1 = v1 * sc; u32x4 w; w.x = cvt_pk_bf16(v0[0], v0[1]); w.y = cvt_pk_bf16(v0[2], v0[3]); w.z = cvt_pk_bf16(v1[0], v1[1]); w.w = cvt_pk_bf16(v1[2], v1[3]);
                    *(GAS u32x4*)(rowp + bj * HALF) = w; } }
    }
};

template <bool BASEB> struct EpiRes {
    static constexpr bool PERM = false, AFTER_DRAIN = false;
    const GAS float* base_lat; const GAS float* base_ctx; GAS bf16_t* xs; const GAS float* gate;
    __device__ __forceinline__ void operator()(const f32x4 (&acc)[2][2][4][2], const Unit& u, int wr, int wc, int fr, int fq) const {
        typedef unsigned u32x2e __attribute__((ext_vector_type(2)));
        const int rowt = u.pm * BM;
        const int cond = rowt < 16384 ? (rowt >> 12) : 4;
        const GAS float* g = gate + (size_t)cond * 6144;
        const int col0 = u.pn * BM + wc * 32 + 4 * fq;
        f32x4 gv[2][2];
#pragma unroll
        for (int bj = 0; bj < 2; ++bj)
#pragma unroll
            for (int n = 0; n < 2; ++n) gv[bj][n] = *(const GAS f32x4*)(g + col0 + bj * HALF + n * 16);
#pragma unroll
        for (int ai = 0; ai < 2; ++ai)
#pragma unroll
            for (int m = 0; m < 4; ++m) {
                const int r = rowt + ai * HALF + wr * 64 + m * 16 + fr;
                const GAS float* bp = r < 16384 ? base_lat + (size_t)r * 1024 : base_ctx + (size_t)(r - 16384) * 1024;
                GAS bf16_t* op = xs + (size_t)r * 1024;
#pragma unroll
                for (int bj = 0; bj < 2; ++bj)
#pragma unroll
                    for (int n = 0; n < 2; ++n) {
                        const int off = col0 + bj * HALF + n * 16;
                        f32x4 bs;
                        if (BASEB) { const u32x2e w = *(const GAS u32x2e*)(op + off); bs = (f32x4){__uint_as_float(w.x << 16), __uint_as_float(w.x & 0xffff0000u), __uint_as_float(w.y << 16), __uint_as_float(w.y & 0xffff0000u)}; }
                        else bs = *(const GAS f32x4*)(bp + off);
                        const f32x4 o = bs + gv[bj][n] * acc[ai][bj][m][n];
                        u32x2e w; w.x = cvt_pk_bf16(o[0], o[1]); w.y = cvt_pk_bf16(o[2], o[3]);
                        *(GAS u32x2e*)(op + off) = w;
                    }
            }
    }
};

template <class Epi, class Sched, bool ALIGN_EPI = false, bool SP2 = false>
__device__ __forceinline__ void gemm_phase(PG8_LAS unsigned char* lds, const Gemm g, const Sched& S, const Epi& E) {
    const int tid = threadIdx.x, wid = __builtin_amdgcn_readfirstlane(tid >> 6), lane = tid & 63, wr = wid >> 2, wc = wid & 3, fr = lane & 15, fq = lane >> 4;
    const int K = g.K, nt = K / BK;
    unsigned voffA[2], voffB[2];
#pragma unroll
    for (int i = 0; i < 2; ++i) { int R, C; stage_rc(tid * 16 + i * 8192, R, C); const int Rb = Epi::PERM ? ((R & ~31) + perm32(R & 31)) : R;
        voffA[i] = (unsigned)(R * K + C) * 2u; voffB[i] = (unsigned)(Rb * K + C) * 2u; }
    const size_t kstep = (size_t)(BK * 2);
    const size_t hstep = (size_t)HALF * K * 2;
    const size_t tstep = 2 * hstep;
    const unsigned ldsw = (unsigned)wid * 1024u;
    const int aoff = lds_byte(wr * 64 + fr, fq * 8), boff = lds_byte(wc * 32 + fr, fq * 8);
#define PG8_SA(b, h) (((b) * 2 + (h)) * HTB)
#define PG8_SB(b, h) ((4 + (b) * 2 + (h)) * HTB)
#define PG8_STAGE(bufoff, gbase, voff) do { _Pragma("unroll") for (int _i = 0; _i < 2; ++_i) \
        __builtin_amdgcn_global_load_lds((const unsigned*)((const char*)(gbase) + (voff)[_i]), (PG8_LAS unsigned*)(lds + (bufoff) + ldsw + _i * 8192), 16, 0, 0); } while (0)
#define PG8_LDA(dst, b, h) do { _Pragma("unroll") for (int m = 0; m < 4; ++m) _Pragma("unroll") for (int k = 0; k < 2; ++k) dst[m][k] = *(const PG8_LAS bf16x8*)(lds + PG8_SA(b, h) + aoff + m * 2048 + k * 1024); } while (0)
#define PG8_LDB(dst, b, h) do { _Pragma("unroll") for (int n = 0; n < 2; ++n) _Pragma("unroll") for (int k = 0; k < 2; ++k) dst[n][k] = *(const PG8_LAS bf16x8*)(lds + PG8_SB(b, h) + boff + n * 2048 + k * 1024); } while (0)
#define PG8_MMA(ai, bj, At, Bt) do { __builtin_amdgcn_s_setprio(1); _Pragma("unroll") for (int m = 0; m < 4; ++m) _Pragma("unroll") for (int n = 0; n < 2; ++n) _Pragma("unroll") for (int k = 0; k < 2; ++k) \
        acc[ai][bj][m][n] = __builtin_amdgcn_mfma_f32_16x16x32_bf16(Bt[n][k], At[m][k], acc[ai][bj][m][n], 0, 0, 0); __builtin_amdgcn_s_setprio(0); } while (0)
#define PG8_WAIT_V(n) asm volatile("s_waitcnt vmcnt(" #n ")" ::: "memory")
#define PG8_WAIT_L(n) asm volatile("s_waitcnt lgkmcnt(" #n ")" ::: "memory")
#define PG8_BAR __builtin_amdgcn_s_barrier()
#define PG8_SCHED __builtin_amdgcn_sched_barrier(0)
    Unit cur, nxt; int ui = 0;
    if (!S.next(0, cur)) return;
    f32x4 acc[2][2][4][2];
#pragma unroll
    for (int a = 0; a < 2; ++a)
#pragma unroll
        for (int b = 0; b < 2; ++b)
#pragma unroll
            for (int m = 0; m < 4; ++m)
#pragma unroll
                for (int n = 0; n < 2; ++n) acc[a][b][m][n] = (f32x4){0.f, 0.f, 0.f, 0.f};
    bf16x8 At[4][2], B0[2][2], B1[2][2];
    const char* cA = (const char*)g.A + (size_t)cur.pm * tstep; const char* cB = (const char*)g.Bt + (size_t)cur.pn * tstep;
    S.a_ready(cur);
    if constexpr (SP2) {
        PG8_STAGE(PG8_SB(0, 0), cB, voffB); PG8_STAGE(PG8_SB(0, 1), cB + hstep, voffB); PG8_STAGE(PG8_SA(0, 0), cA, voffA); PG8_STAGE(PG8_SA(0, 1), cA + hstep, voffA);
        if (wr == 1) PG8_BAR;
        PG8_WAIT_V(2); PG8_BAR;
        PG8_STAGE(PG8_SB(1, 0), cB + kstep, voffB); PG8_STAGE(PG8_SA(1, 0), cA + kstep, voffA); PG8_STAGE(PG8_SB(1, 1), cB + hstep + kstep, voffB);
        PG8_WAIT_V(6); PG8_BAR;
    } else {
        PG8_STAGE(PG8_SB(0, 0), cB, voffB); PG8_STAGE(PG8_SA(0, 0), cA, voffA); PG8_STAGE(PG8_SB(0, 1), cB + hstep, voffB); PG8_STAGE(PG8_SA(0, 1), cA + hstep, voffA);
        if (wr == 1) PG8_BAR;
        PG8_WAIT_V(4); PG8_BAR;
        PG8_STAGE(PG8_SB(1, 0), cB + kstep, voffB); PG8_STAGE(PG8_SA(1, 0), cA + kstep, voffA); PG8_STAGE(PG8_SB(1, 1), cB + hstep + kstep, voffB);
        PG8_WAIT_V(6); PG8_BAR;
    }
    for (;;) {
        const bool has_next = S.next(ui + 1, nxt);
        const char* nA = has_next ? (const char*)g.A + (size_t)nxt.pm * tstep : cA; const char* nB = has_next ? (const char*)g.Bt + (size_t)nxt.pn * tstep : cB;
        for (int t = 0; t < nt; t += 2) {
            const bool last = (t == nt - 2);
            const char* a1 = cA + (size_t)(t + 1) * kstep;
            const char* a2 = last ? nA : cA + (size_t)(t + 2) * kstep; const char* b2 = last ? nB : cB + (size_t)(t + 2) * kstep;
            const char* a3 = a2 + kstep; const char* b3 = b2 + kstep;
            if (last && has_next) S.a_ready(nxt);
            if constexpr (SP2) {
            PG8_LDB(B0, 0, 0); PG8_LDB(B1, 0, 1); PG8_SCHED; PG8_LDA(At, 0, 0); PG8_STAGE(PG8_SA(1, 1), a1 + hstep, voffA);
            PG8_WAIT_V(8); PG8_WAIT_L(0); PG8_BAR; PG8_MMA(0, 0, At, B0); PG8_MMA(0, 1, At, B1); PG8_BAR; PG8_SCHED;
            PG8_LDA(At, 0, 1); PG8_STAGE(PG8_SB(0, 0), b2, voffB); PG8_STAGE(PG8_SB(0, 1), b2 + hstep, voffB); PG8_STAGE(PG8_SA(0, 0), a2, voffA);
            PG8_WAIT_V(8); PG8_WAIT_L(0); PG8_BAR; PG8_MMA(1, 0, At, B0); PG8_MMA(1, 1, At, B1); PG8_BAR; PG8_SCHED;
            PG8_LDB(B0, 1, 0); PG8_LDB(B1, 1, 1); PG8_SCHED; PG8_LDA(At, 1, 0); PG8_STAGE(PG8_SA(0, 1), a2 + hstep, voffA);
            PG8_WAIT_V(8); PG8_WAIT_L(0); PG8_BAR; PG8_MMA(0, 0, At, B0); PG8_MMA(0, 1, At, B1); PG8_BAR; PG8_SCHED;
            PG8_LDA(At, 1, 1); PG8_STAGE(PG8_SB(1, 0), b3, voffB); PG8_STAGE(PG8_SB(1, 1), b3 + hstep, voffB); PG8_STAGE(PG8_SA(1, 0), a3, voffA);
            PG8_WAIT_V(8); PG8_WAIT_L(0); PG8_BAR; PG8_MMA(1, 0, At, B0); PG8_MMA(1, 1, At, B1); PG8_BAR; PG8_SCHED;
            } else {
            PG8_LDB(B0, 0, 0); PG8_SCHED; PG8_LDA(At, 0, 0); PG8_STAGE(PG8_SA(1, 1), a1 + hstep, voffA);
            PG8_WAIT_L(8); PG8_BAR; PG8_WAIT_L(0); PG8_MMA(0, 0, At, B0); PG8_BAR; PG8_SCHED;
            PG8_LDB(B1, 0, 1); PG8_STAGE(PG8_SB(0, 0), b2, voffB);
            PG8_BAR; PG8_WAIT_L(0); PG8_MMA(0, 1, At, B1); PG8_BAR;
            PG8_LDA(At, 0, 1); PG8_STAGE(PG8_SA(0, 0), a2, voffA);
            PG8_BAR; PG8_WAIT_L(0); PG8_MMA(1, 0, At, B0); PG8_BAR; PG8_SCHED;
            PG8_STAGE(PG8_SB(0, 1), b2 + hstep, voffB);
            PG8_WAIT_V(6); PG8_BAR; PG8_MMA(1, 1, At, B1); PG8_BAR;
            PG8_LDB(B0, 1, 0); PG8_SCHED; PG8_LDA(At, 1, 0); PG8_STAGE(PG8_SA(0, 1), a2 + hstep, voffA);
            PG8_WAIT_L(8); PG8_BAR; PG8_WAIT_L(0); PG8_MMA(0, 0, At, B0); PG8_BAR; PG8_SCHED;
            PG8_LDB(B1, 1, 1); PG8_STAGE(PG8_SB(1, 0), b3, voffB);
            PG8_BAR; PG8_WAIT_L(0); PG8_MMA(0, 1, At, B1); PG8_BAR;
            PG8_LDA(At, 1, 1); PG8_STAGE(PG8_SA(1, 0), a3, voffA);
            PG8_BAR; PG8_WAIT_L(0); PG8_MMA(1, 0, At, B0); PG8_BAR; PG8_SCHED;
            PG8_STAGE(PG8_SB(1, 1), b3 + hstep, voffB);
            PG8_WAIT_V(6); PG8_BAR; PG8_MMA(1, 1, At, B1); PG8_BAR;
            }
        }
        if constexpr (ALIGN_EPI) { if (wr == 0) PG8_BAR; }
        if constexpr (!Epi::AFTER_DRAIN) { E(acc, cur, wr, wc, fr, fq); S.done(cur); }
        if (!has_next) break;
#pragma unroll
        for (int a = 0; a < 2; ++a)
#pragma unroll
            for (int b = 0; b < 2; ++b)
#pragma unroll
                for (int m = 0; m < 4; ++m)
#pragma unroll
                    for (int n = 0; n < 2; ++n) acc[a][b][m][n] = (f32x4){0.f, 0.f, 0.f, 0.f};
        cur = nxt; cA = nA; cB = nB; ++ui;
        if constexpr (ALIGN_EPI) { if (wr == 1) PG8_BAR; }
    }
    PG8_WAIT_V(0);
    if constexpr (!ALIGN_EPI) { if (wr == 0) PG8_BAR; }
    PG8_BAR;
    if constexpr (Epi::AFTER_DRAIN) { E.fused(acc, cur, wr, wc, fr, fq, lds, wid, lane); S.done(cur); }
#undef PG8_SA
#undef PG8_SB
#undef PG8_STAGE
#undef PG8_LDA
#undef PG8_LDB
#undef PG8_MMA
#undef PG8_WAIT_V
#undef PG8_WAIT_L
#undef PG8_BAR
#undef PG8_SCHED
}
}
#define GAS __attribute__((address_space(1)))
#define LAS __attribute__((address_space(3)))
typedef unsigned short bf16;
typedef unsigned v4u __attribute__((ext_vector_type(4)));
typedef float f32x4 __attribute__((ext_vector_type(4)));
typedef short bf16x8 __attribute__((ext_vector_type(8)));
typedef GAS unsigned gu32;
typedef GAS unsigned long long gu64;
#define RLX_AGENT __ATOMIC_RELAXED, __HIP_MEMORY_SCOPE_AGENT
#define LDS_WAIT() asm volatile("s_waitcnt lgkmcnt(0)" ::: "memory")
#define VM_WAIT() asm volatile("s_waitcnt vmcnt(0)" ::: "memory")
__device__ __forceinline__ unsigned long long rt() { return __builtin_amdgcn_s_memrealtime(); }
__device__ __forceinline__ unsigned f2bf(float f) { unsigned u = __builtin_bit_cast(unsigned, f); return (u + 0x7fffu + ((u >> 16) & 1u)) >> 16; }
typedef float pk2_f2_t __attribute__((ext_vector_type(2))); typedef __bf16 pk2_b2_t __attribute__((ext_vector_type(2)));
__device__ __forceinline__ unsigned pk2(float lo, float hi) { pk2_f2_t v = {lo, hi}; return __builtin_bit_cast(unsigned, __builtin_convertvector(v, pk2_b2_t)); }

#define XB_TMO      128
#define XB_XCNT(j)  (256  + 64 * (j))
#define XB_XSUB(j)  (1280 + 64 * (j))
#define XB_XGEN(j)  (2304 + 64 * (j))
#define XB_TOP      3328
#define XB_TOPGEN   3392
#define XCD_BAR_WORDS 3456
#define XB_SPIN_CAP (1u << 18)

__device__ __forceinline__ unsigned xb_ld(unsigned* p)              { return __hip_atomic_load(p, __ATOMIC_RELAXED, __HIP_MEMORY_SCOPE_AGENT); }
__device__ __forceinline__ unsigned xb_add(unsigned* p, unsigned v) { return __hip_atomic_fetch_add(p, v, __ATOMIC_RELAXED, __HIP_MEMORY_SCOPE_AGENT); }
__device__ __forceinline__ unsigned xb_xcc_id() { return (unsigned)__builtin_amdgcn_s_getreg((3 << 11) | 20) & 0xFu; }
#define XB_SPIN(cond, bar) do { unsigned _sp = 0; while (cond) { __builtin_amdgcn_s_sleep(1); \
    if ((++_sp & 255u) == 0u) { if (xb_ld(&(bar)[XB_TMO])) break; if (_sp > XB_SPIN_CAP) { atomicAdd(&(bar)[XB_TMO], 1u); break; } } } } while (0)

struct XcdBarrier {
    unsigned* bar; unsigned x;
    volatile LAS unsigned* st;
};

__device__ __forceinline__ XcdBarrier xcd_barrier_post(unsigned* bar, volatile LAS unsigned* st) {
    XcdBarrier b; b.bar = bar; b.x = xb_xcc_id(); b.st = st;
    if (threadIdx.x == 0) (void)xb_add(&bar[XB_XCNT(b.x)], 1u);
    return b;
}
__device__ __forceinline__ void xcd_barrier_complete(unsigned* bar, unsigned x, unsigned& nloc, unsigned& nx) {
    const unsigned G = gridDim.x * gridDim.y * gridDim.z;
    unsigned sum, cnt, mine, sp = 0u;
    for (;;) {
        sum = 0u; cnt = 0u; mine = 0u;
#pragma unroll
        for (unsigned j = 0; j < 16; ++j) { const unsigned c = xb_ld(&bar[XB_XCNT(j)]); sum += c; cnt += (c > 0u) ? 1u : 0u; mine = (j == x) ? c : mine; }
        if (sum == G) break;
        __builtin_amdgcn_s_sleep(1);
        if ((++sp & 255u) == 0u) { if (xb_ld(&bar[XB_TMO])) break; if (sp > XB_SPIN_CAP) { atomicAdd(&bar[XB_TMO], 1u); break; } }
    }
    nloc = mine > 0u ? mine : 1u; nx = cnt > 0u ? cnt : 1u;
}

__device__ __forceinline__ void xcd_barrier(const XcdBarrier& b) {
    asm volatile("s_waitcnt vmcnt(0)" ::: "memory");
    __syncthreads();
    if (threadIdx.x == 0) {
        unsigned* bar = b.bar;
        __builtin_amdgcn_s_waitcnt(0);
        unsigned nloc = b.st[0], nx = b.st[1];
        if (nloc == 0u) { xcd_barrier_complete(bar, b.x, nloc, nx); b.st[0] = nloc; b.st[1] = nx; }
        const unsigned old = xb_add(&bar[XB_XSUB(b.x)], 1u);
        const unsigned gen = old / nloc;
        if (old + 1u == (gen + 1u) * nloc) {
            __builtin_amdgcn_fence(__ATOMIC_RELEASE, "agent");
            asm volatile("s_waitcnt vmcnt(0)" ::: "memory");
            const unsigned og = xb_add(&bar[XB_TOP], 1u);
            const unsigned tg = og / nx;
            if (og + 1u == (tg + 1u) * nx) xb_add(&bar[XB_TOPGEN], 1u);
            else XB_SPIN(xb_ld(&bar[XB_TOPGEN]) == tg, bar);
            __builtin_amdgcn_fence(__ATOMIC_ACQUIRE, "agent");
            xb_add(&bar[XB_XGEN(b.x)], 1u);
            asm volatile("s_waitcnt vmcnt(0)" ::: "memory");
        } else {
            XB_SPIN(xb_ld(&bar[XB_XGEN(b.x)]) == gen, bar);
            __builtin_amdgcn_fence(__ATOMIC_ACQUIRE, "agent");
            asm volatile("s_waitcnt vmcnt(0)" ::: "memory");
        }
    }
    __syncthreads();
}
constexpr int NWAVES = 8, NTHR = 512;
constexpr int DM = 1024, NBATCH = 4, SEQ = 4096, CL = 256;
constexpr int MLAT = NBATCH * SEQ, MCTX = NBATCH * CL, MALL = MLAT + MCTX;
constexpr int AB_IN = 3584, SWA_IN = 1536, PQD = 2048, MODW = 6144;
constexpr size_t MiB = 1u << 20;
#ifndef U_FP4
#define U_FP4 1
#endif
#ifndef V_FP4
#define V_FP4 1
#endif
constexpr int U_ROWB = U_FP4 ? 512 : 768, V_ROWB = V_FP4 ? 512 : 768;
constexpr size_t WS_CTL = 0, CTL_ZERO_BYTES = 1 * MiB;
constexpr size_t WS_MOD = 1 * MiB;
constexpr size_t WS_ROPE = 1 * MiB + 512 * 1024;
constexpr size_t WS_SU = 1 * MiB + 640 * 1024, WS_SV = 1 * MiB + 768 * 1024;
constexpr size_t WS_SUBK = 2 * MiB;
constexpr size_t WS_WIN0 = 4 * MiB, WS_WOUT0 = 11 * MiB, WS_WQ0 = 13 * MiB, WS_WIN1 = 17 * MiB, WS_WOUT1 = 20 * MiB, WS_WQ1 = 22 * MiB;
constexpr size_t WS_U = 32 * MiB, WS_V = 96 * MiB;
constexpr size_t WS_XN = 160 * MiB;
constexpr size_t WS_XS = 194 * MiB;
constexpr size_t WS_P = 262 * MiB;
constexpr size_t WS_Q2 = 262 * MiB;
constexpr size_t WS_IDX = 330 * MiB, WS_GATE = 339 * MiB;
constexpr size_t WS_TAV = 381 * MiB, WS_TBK = 398 * MiB, WS_TBV = 415 * MiB;
constexpr size_t WS_KV = 432 * MiB;
constexpr size_t WS_ST = 466 * MiB;
constexpr size_t WS_END = 483 * MiB;
constexpr int CW_BAR = 4096;

typedef unsigned v2u __attribute__((ext_vector_type(2)));
typedef __bf16 bf16x2_t __attribute__((ext_vector_type(2)));
__device__ __forceinline__ float bflo(unsigned u) { return __uint_as_float(u << 16); }
__device__ __forceinline__ float bfhi(unsigned u) { return __uint_as_float(u & 0xffff0000u); }
__device__ __forceinline__ float bf1(bf16 u) { return __uint_as_float((unsigned)u << 16); }
__device__ __forceinline__ v4u ld16(const GAS bf16* p) { return *(const GAS v4u*)p; }
__device__ __forceinline__ bf16x8 ldfrag(const GAS bf16* p) { return __builtin_bit_cast(bf16x8, *(const GAS v4u*)p); }
__device__ __forceinline__ f32x4 mfma16(bf16x8 a, bf16x8 b, f32x4 c) { return __builtin_amdgcn_mfma_f32_16x16x32_bf16(a, b, c, 0, 0, 0); }
__device__ __forceinline__ float wave_sum(float v) {
#pragma unroll
    for (int o = 1; o < 64; o <<= 1) v += __shfl_xor(v, o);
    return v;
}
__device__ __forceinline__ float fexp2(float x) { return __builtin_amdgcn_exp2f(x); }
__device__ __forceinline__ float fexp(float x) { return __builtin_amdgcn_exp2f(x * 1.4426950408889634f); }
__device__ __forceinline__ bf16x8 pack8(const f32x4& a, const f32x4& b) {
    v4u w; w.x = pk2(a[0], a[1]); w.y = pk2(a[2], a[3]); w.z = pk2(b[0], b[1]); w.w = pk2(b[2], b[3]);
    return __builtin_bit_cast(bf16x8, w);
}
__device__ __forceinline__ float dot2bf(unsigned a, unsigned b, float acc) {
    return __builtin_amdgcn_fdot2_f32_bf16(__builtin_bit_cast(bf16x2_t, a), __builtin_bit_cast(bf16x2_t, b), acc, false);
}
__device__ __forceinline__ float gelu_erf(float v) {
    const float av = fabsf(v), d = av * 0.2316418882f + 1.0f;
    const float t = __builtin_amdgcn_rcpf(d);
    float q = t * 0.5307027145f + (-0.7265760135f); q = q * t + 0.7107068705f; q = q * t + (-0.142248368f); q = q * t + 0.127414796f; q = q * t;
    const float e = __builtin_amdgcn_exp2f((v * v) * (-0.72134752044f));
    const float m = v * (q * e), r = v - m;
    return v < 0.f ? m : r;
}

struct Ctx {
    LAS unsigned char* lds;
    int tid, lane, wave, gw, ngw, G;
    const GAS float *x, *c, *ctx, *c_ctx, *mod_w, *mod_b, *norm1_g, *norm2_g, *ab_w_in, *ab_w_out, *na_q_norm, *na_k_norm, *na_rpb, *ret_log_decay,
                *swa_w_in, *swa_w_out, *swa_q_norm, *swa_k_norm, *swa_sink, *peer_w_q, *peer_sub_keys, *peer_u, *peer_v;
    GAS float* out;
    GAS float* MOD; GAS float* ROPE; GAS bf16* SUBK; GAS bf16 *WIN0, *WOUT0, *WQ0, *WIN1, *WOUT1, *WQ1; GAS unsigned char *U8, *V8; GAS float *SU, *SV; GAS bf16* XN; GAS bf16* XS; GAS bf16* P; GAS bf16* Q2;
    GAS int* IDX; GAS float* GATE; GAS bf16 *TAV, *TBK, *TBV; GAS float* KV; GAS bf16* ST;
};

__device__ __forceinline__ void p0_transpose_item(const GAS float* W, int K, int N, GAS bf16* WT, LAS float* scr, int item, int lane) {
    const int nblk = N / 32, kb = item / nblk, nb = item % nblk, k0 = 64 * kb, n0 = 32 * nb;
#pragma unroll 8
    for (int i = 0; i < 32; ++i) { const int kk = 2 * i + (lane >> 5); scr[kk * 33 + (lane & 31)] = W[(size_t)(k0 + kk) * N + n0 + (lane & 31)]; }
    LDS_WAIT(); asm volatile("" ::: "memory");
    const int c = lane & 7;
#pragma unroll
    for (int j = 0; j < 4; ++j) { const int n = (lane >> 3) + 8 * j; const LAS float* s = scr + (8 * c) * 33 + n;
        v4u o; o.x = pk2(s[0 * 33], s[1 * 33]); o.y = pk2(s[2 * 33], s[3 * 33]); o.z = pk2(s[4 * 33], s[5 * 33]); o.w = pk2(s[6 * 33], s[7 * 33]);
        *(GAS v4u*)(WT + (size_t)(n0 + n) * K + k0 + 8 * c) = o; }
    LDS_WAIT(); asm volatile("" ::: "memory");
}
__device__ __forceinline__ void p0_convert(const Ctx& F, const GAS float* src, GAS bf16* dst, size_t n8) {
    const size_t gt = (size_t)F.gw * 64 + F.lane, NT = (size_t)F.ngw * 64;
    for (size_t i = gt; i < n8; i += NT) {
        const f32x4 a = *(const GAS f32x4*)(src + i * 8), b = *(const GAS f32x4*)(src + i * 8 + 4);
        v4u o; o.x = pk2(a[0], a[1]); o.y = pk2(a[2], a[3]); o.z = pk2(b[0], b[1]); o.w = pk2(b[2], b[3]);
        *(GAS v4u*)(dst + i * 8) = o;
    }
}

#ifndef FP6_PACK_INTERLEAVED
#define FP6_PACK_INTERLEAVED 1
#endif
typedef float f32x16v __attribute__((ext_vector_type(16)));
typedef float f32x32v __attribute__((ext_vector_type(32)));
typedef unsigned u32x6v __attribute__((ext_vector_type(6)));
__device__ __forceinline__ void convert_fp6_rows(const Ctx& F, int rbeg, int rend) {
    const int q = F.lane & 31, hf = F.lane >> 5;
    for (int R0 = rbeg + F.wave * 2; R0 < rend; R0 += NWAVES * 2) {
        const int R = R0 + hf;
        if (R >= rend) continue;
        const bool isv = R >= 32768; const int r = R & 32767;
        const GAS float* xr = (isv ? F.peer_v : F.peer_u) + (size_t)r * 1024 + 32 * q;
        f32x16v a, b; float am = 0.f;
#pragma unroll
        for (int j = 0; j < 4; ++j) { const f32x4 v = *(const GAS f32x4*)(xr + 4 * j); a[4 * j] = v[0]; a[4 * j + 1] = v[1]; a[4 * j + 2] = v[2]; a[4 * j + 3] = v[3];
            am = fmaxf(fmaxf(fmaxf(fabsf(v[0]), fabsf(v[1])), fmaxf(fabsf(v[2]), fabsf(v[3]))), am); }
#pragma unroll
        for (int j = 0; j < 4; ++j) { const f32x4 v = *(const GAS f32x4*)(xr + 16 + 4 * j); b[4 * j] = v[0]; b[4 * j + 1] = v[1]; b[4 * j + 2] = v[2]; b[4 * j + 3] = v[3];
            am = fmaxf(fmaxf(fmaxf(fabsf(v[0]), fabsf(v[1])), fmaxf(fabsf(v[2]), fabsf(v[3]))), am); }
#pragma unroll
        for (int o = 1; o < 32; o <<= 1) am = fmaxf(am, __shfl_xor(am, o));
        const bool fp4 = isv ? (V_FP4 != 0) : (U_FP4 != 0);
        const float sc = am > 0.f ? am * (fp4 ? (1.0f / 6.0f) : (1.0f / 7.5f)) : 1.0f, inv = 1.0f / sc;
        a = a * inv; b = b * inv;
        if (fp4) {
            v4u o;
#pragma unroll
            for (int d = 0; d < 4; ++d) { unsigned pk = 0;
#define X_(e) ((e) < 16 ? a[(e) & 15] : b[(e) & 15])
                pk = __builtin_amdgcn_cvt_scalef32_pk_fp4_f32(pk, X_(8 * d + 0), X_(8 * d + 1), 1.0f, 0);
                pk = __builtin_amdgcn_cvt_scalef32_pk_fp4_f32(pk, X_(8 * d + 2), X_(8 * d + 3), 1.0f, 1);
                pk = __builtin_amdgcn_cvt_scalef32_pk_fp4_f32(pk, X_(8 * d + 4), X_(8 * d + 5), 1.0f, 2);
                pk = __builtin_amdgcn_cvt_scalef32_pk_fp4_f32(pk, X_(8 * d + 6), X_(8 * d + 7), 1.0f, 3);
#undef X_
                o[d] = pk; }
            *(GAS v4u*)((isv ? F.V8 : F.U8) + (size_t)r * 512 + 16 * q) = o;
        } else {
        { f32x16v a2, b2;
#pragma unroll
          for (int i = 0; i < 8; ++i) { a2[i] = a[2 * i]; b2[i] = a[2 * i + 1]; a2[8 + i] = b[2 * i]; b2[8 + i] = b[2 * i + 1]; }
          a = a2; b = b2; }
        const u32x6v pk = __builtin_amdgcn_cvt_scalef32_2xpk16_fp6_f32(a, b, 1.0f);
        GAS unsigned* dp = (GAS unsigned*)((isv ? F.V8 : F.U8) + (size_t)r * 768 + 24 * q);
        *(GAS v2u*)dp = (v2u){pk[0], pk[1]}; *(GAS v2u*)(dp + 2) = (v2u){pk[2], pk[3]}; *(GAS v2u*)(dp + 4) = (v2u){pk[4], pk[5]};
        }
        if (q == 0) { if (isv) F.SV[r] = sc; else F.SU[r] = sc; }
    }
}
__device__ __forceinline__ int idle_slot(int nwg, int G, int c, int& nslots) {
    const int mx = (nwg + G - 1) / G, full = nwg - (mx - 1) * G;
    nslots = G - full;
    if (nslots == 0) { nslots = G; return c; }
    return c >= full ? c - full : -1;
}
__device__ __forceinline__ void side_transposes(const Ctx& F, int slot, int nslots) {
    LAS float* scr = (LAS float*)(F.lds + F.wave * 16384);
    constexpr int I_O = 16 * 32, I_Q = 16 * (PQD / 32), I_IN1 = 16 * (SWA_IN / 32);
    constexpr int NITEMS = I_O + I_Q + I_IN1 + I_O + I_Q;
    for (int it = slot * NWAVES + F.wave; it < NITEMS; it += nslots * NWAVES) {
        int r = it;
        if (r < I_O) { p0_transpose_item(F.ab_w_out, DM, DM, F.WOUT0, scr, r, F.lane); continue; } r -= I_O;
        if (r < I_Q) { p0_transpose_item(F.peer_w_q, DM, PQD, F.WQ0, scr, r, F.lane); continue; } r -= I_Q;
        if (r < I_IN1) { p0_transpose_item(F.swa_w_in, DM, SWA_IN, F.WIN1, scr, r, F.lane); continue; } r -= I_IN1;
        if (r < I_O) { p0_transpose_item(F.swa_w_out, DM, DM, F.WOUT1, scr, r, F.lane); continue; } r -= I_O;
        p0_transpose_item(F.peer_w_q + (size_t)DM * PQD, DM, PQD, F.WQ1, scr, r, F.lane);
    }
}
__device__ __forceinline__ void side_convert(const Ctx& F, int part) {
    int n7, n9; const int s7 = idle_slot((MALL / 256) * (DM / 256), F.G, (int)blockIdx.x, n7), s9 = idle_slot((MALL / 256) * (PQD / 256), F.G, (int)blockIdx.x, n9);
    const int slot = part == 0 ? s7 : (s9 < 0 ? -1 : n7 + s9);
    if (slot < 0) return;
    const int per = (65536 + n7 + n9 - 1) / (n7 + n9);
    const int rbeg = min(slot * per, 65536), rend = min(rbeg + per, 65536);
    convert_fp6_rows(F, rbeg, rend);
}
__device__ __forceinline__ void p0_prologue(const Ctx& F) {
    if (blockIdx.x < 192) {
        const int l = blockIdx.x / 96, cb = blockIdx.x % 96, col = cb * 64 + F.lane;
        LAS float* s = (LAS float*)F.lds;
        LAS float* part = (LAS float*)(F.lds + 20480);
        for (int i = F.tid; i < 5120; i += NTHR) { const int r = i >> 10, k = i & 1023; const float cv = r < 4 ? F.c[r * 1024 + k] : F.c_ctx[k]; s[i] = cv / (1.f + __expf(-cv)); }
        __syncthreads();
        float acc[5] = {0.f, 0.f, 0.f, 0.f, 0.f};
        const GAS float* wp = F.mod_w + ((size_t)l * 1024 + F.wave * 128) * MODW + col;
#pragma unroll 32
        for (int k = 0; k < 128; ++k) { const float wv = wp[(size_t)k * MODW];
#pragma unroll
            for (int r = 0; r < 5; ++r) acc[r] += s[r * 1024 + F.wave * 128 + k] * wv; }
#pragma unroll
        for (int r = 0; r < 5; ++r) part[(F.wave * 5 + r) * 64 + F.lane] = acc[r];
        __syncthreads();
        if (F.wave < 5) { float t = F.mod_b[l * MODW + col];
#pragma unroll
            for (int w = 0; w < 8; ++w) t += part[(w * 5 + F.wave) * 64 + F.lane];
            F.MOD[(size_t)(l * 5 + F.wave) * MODW + col] = t; }
        __syncthreads();
    }
    { const int gt = F.gw * 64 + F.lane;
      if (gt < 1024) { const int pos = gt >> 4, f = gt & 15; const float invf = fexp2(-(float)f * (13.287712379549449f / 16.f)); const float rev = (float)pos * invf * 0.15915494309189535f;
          F.ROPE[gt * 2] = __builtin_amdgcn_cosf(rev); F.ROPE[gt * 2 + 1] = __builtin_amdgcn_sinf(rev); } }
    { LAS float* scr = (LAS float*)(F.lds + F.wave * 16384);
      constexpr int I_IN0 = 16 * (AB_IN / 32);
      for (int it = F.gw; it < I_IN0; it += F.ngw) p0_transpose_item(F.ab_w_in, DM, AB_IN, F.WIN0, scr, it, F.lane); }
    p0_convert(F, F.peer_sub_keys, F.SUBK, (size_t)2 * 8 * 2 * 128 * 128 / 8);
}

template <bool SRCB>
__device__ __forceinline__ void mod_phase(const Ctx& F, const GAS float* src_lat, const GAS float* src_ctx, int M, const GAS float* normg, const GAS float* mod_l, int sh, int sc) {
    for (int m = F.gw; m < M; m += F.ngw) {
        const int cond = m < MLAT ? (m >> 12) : 4;
        const GAS float* shp = mod_l + (size_t)cond * MODW + sh * 1024; const GAS float* scp = mod_l + (size_t)cond * MODW + sc * 1024;
        f32x4 v[4]; float s = 0.f;
#pragma unroll
        for (int j = 0; j < 4; ++j) {
            if (SRCB) { const v2u w = *(const GAS v2u*)(F.XS + (size_t)m * DM + 4 * F.lane + 256 * j); v[j] = (f32x4){bflo(w.x), bfhi(w.x), bflo(w.y), bfhi(w.y)}; }
            else { const GAS float* xr = m < MLAT ? src_lat + (size_t)m * DM : src_ctx + (size_t)(m - MLAT) * DM; v[j] = *(const GAS f32x4*)(xr + 4 * F.lane + 256 * j); }
            s += (v[j][0] * v[j][0] + v[j][1] * v[j][1]) + (v[j][2] * v[j][2] + v[j][3] * v[j][3]); }
        const float r = 1.0f / sqrtf(wave_sum(s) * (1.f / DM) + 1e-6f);
        GAS bf16* orow = F.XN + (size_t)m * DM;
#pragma unroll
        for (int j = 0; j < 4; ++j) { const int k = 4 * F.lane + 256 * j;
            const f32x4 g = *(const GAS f32x4*)(normg + k), a = *(const GAS f32x4*)(scp + k), b = *(const GAS f32x4*)(shp + k);
            f32x4 o;
#pragma unroll
            for (int e = 0; e < 4; ++e) o[e] = v[j][e] * r * g[e] * (1.f + a[e]) + b[e];
            v2u w; w.x = pk2(o[0], o[1]); w.y = pk2(o[2], o[3]); *(GAS v2u*)(orow + k) = w; }
    }
}

struct PostSlot { int col; const GAS float* nw; int rope; float scale; GAS bf16* tdst; int nheads; int head; int write_nat; };
__device__ __forceinline__ void post_item(const Ctx& F, GAS bf16* P, int ld, int tt, const PostSlot& S, LAS unsigned char* wl) {
    const int lane = F.lane, c = lane & 7, rsub = lane >> 3;
    const bool latent = tt < 256;
    const int m0 = tt * 64;
    const int b = latent ? (tt >> 6) : ((tt - 256) >> 2);
    const int t0 = latent ? ((tt & 63) * 64) : (((tt - 256) & 3) * 64);
    f32x4 nwa = {1.f, 1.f, 1.f, 1.f}, nwb = {1.f, 1.f, 1.f, 1.f};
    if (S.nw) { nwa = *(const GAS f32x4*)(S.nw + 8 * c); nwb = *(const GAS f32x4*)(S.nw + 8 * c + 4); }
#pragma unroll
    for (int it = 0; it < 8; ++it) {
        const int row = it * 8 + rsub;
        GAS bf16* pp = P + (size_t)(m0 + row) * ld + S.col + 8 * c;
        const v4u raw = *(const GAS v4u*)pp;
        float v[8] = {bflo(raw.x), bfhi(raw.x), bflo(raw.y), bfhi(raw.y), bflo(raw.z), bfhi(raw.z), bflo(raw.w), bfhi(raw.w)};
        if (S.nw) {
            float ss = 0.f;
#pragma unroll
            for (int e = 0; e < 8; ++e) ss += v[e] * v[e];
            ss += __shfl_xor(ss, 1); ss += __shfl_xor(ss, 2); ss += __shfl_xor(ss, 4);
            const float r = 1.0f / sqrtf(ss * (1.f / 64.f) + 1e-6f);
#pragma unroll
            for (int e = 0; e < 4; ++e) { v[e] *= r * nwa[e]; v[4 + e] *= r * nwb[e]; }
        }
        if (S.rope && latent) {
            const int t = t0 + row, pos = ((c & 3) < 2) ? (t >> 6) : (t & 63), f0 = (c & 1) * 8;
            const GAS float* rp = F.ROPE + (size_t)(pos * 16 + f0) * 2;
#pragma unroll
            for (int e = 0; e < 8; ++e) {
                const float other = __shfl_xor(v[e], 4);
                const float cs = rp[2 * e], sn = rp[2 * e + 1];
                v[e] = (c < 4) ? (v[e] * cs - other * sn) : (other * sn + v[e] * cs);
            }
        }
        v4u o; o.x = pk2(v[0] * S.scale, v[1] * S.scale); o.y = pk2(v[2] * S.scale, v[3] * S.scale); o.z = pk2(v[4] * S.scale, v[5] * S.scale); o.w = pk2(v[6] * S.scale, v[7] * S.scale);
        if (S.write_nat) *(GAS v4u*)pp = o;
        if (S.tdst) *(LAS v4u*)(wl + row * 144 + 16 * c) = o;
    }
    if (S.tdst) {
        LDS_WAIT(); asm volatile("" ::: "memory");
        const int tlen = latent ? SEQ : CL;
        GAS bf16* dst = S.tdst + (latent ? (size_t)0 : (size_t)NBATCH * S.nheads * 64 * SEQ) + ((size_t)(b * S.nheads + S.head) * 64 + lane) * tlen + t0;
#pragma unroll
        for (int q = 0; q < 8; ++q) {
            unsigned w[4];
#pragma unroll
            for (int e = 0; e < 4; ++e) {
                const unsigned lo = *(LAS const unsigned short*)(wl + (8 * q + 2 * e) * 144 + 2 * lane);
                const unsigned hi = *(LAS const unsigned short*)(wl + (8 * q + 2 * e + 1) * 144 + 2 * lane);
                w[e] = lo | (hi << 16);
            }
            v4u o; o.x = w[0]; o.y = w[1]; o.z = w[2]; o.w = w[3];
            *(GAS v4u*)(dst + 8 * q) = o;
        }
        LDS_WAIT(); asm volatile("" ::: "memory");
    }
}
#define NEG_BIG (-1.0e30f)
constexpr int SW_KP = 144, SW_CK = 0, SW_CVP = 528, SW_CV = 36864, SW_LK = 70656, SW_LVP = 592, SW_LV = 112128, SW_END = 150016;
__device__ __forceinline__ int kswz(int row, int c8) { const int t = row & 31; return ((row & ~31) + 16 * ((t >> 2) & 1) + 4 * (t >> 3) + (t & 3)) * 144 + 16 * c8; }
__device__ __forceinline__ bf16x8 ldsfrag(LAS const unsigned char* p) { return __builtin_bit_cast(bf16x8, *(LAS const v4u*)p); }

constexpr int NA_RPB = 70656;
template <bool CTXQ>
__device__ __forceinline__ void na_unit2(const Ctx& F, int b, int h, int r, int cg, float Bl2) {
    const int lane = F.lane, qi = lane & 15, g = lane >> 4;
    const GAS bf16* P = F.P;
    LAS const unsigned char* L = F.lds;
    const int c = cg * 16 + qi;
    const size_t qrow = CTXQ ? (size_t)(MLAT + b * CL + r * 16 + qi) : (size_t)(b * SEQ + r * 64 + c);
    const GAS bf16* qp = P + qrow * AB_IN + h * 64 + 8 * g;
    bf16x8 bq[2]; bq[0] = ldfrag(qp); bq[1] = ldfrag(qp + 32);
    const int arow = 8 * (qi >> 2) + (qi & 3);
    const int kz0 = 16 * g, kz1 = kz0 + 64;
    float l = 0.f;
    f32x4 o[4];
#pragma unroll
    for (int db = 0; db < 4; ++db) o[db] = (f32x4){0.f, 0.f, 0.f, 0.f};
    if (!CTXQ) {
        const int kr0 = min(max(r - 4, 0), 56), kc0 = cg == 0 ? 0 : (cg == 1 ? 8 : (cg == 2 ? 24 : 32)), start = min(max(c - 8, 0), 48);
        LAS const float* rpb = (LAS const float*)(L + NA_RPB);
        const GAS bf16* vx = F.TAV + ((size_t)(b * 8 + h) * 64 + qi) * SEQ + 8 * g;
#pragma unroll 4
        for (int y = 0; y < 8; ++y) {
            const int T0 = (kr0 + y) * 64 + kc0;
            LAS const float* rpr = rpb + ((kr0 + y) - r + 7) * 31;
            f32x4 st[2];
#pragma unroll
            for (int hh = 0; hh < 2; ++hh) {
                const GAS bf16* kp = P + (size_t)(b * SEQ + T0 + arow + 4 * hh) * AB_IN + 512 + h * 64 + 8 * g;
                f32x4 a = {0.f, 0.f, 0.f, 0.f};
                a = mfma16(ldfrag(kp), bq[0], a); a = mfma16(ldfrag(kp + 32), bq[1], a);
#pragma unroll
                for (int rr = 0; rr < 4; ++rr) {
                    const int kc = kc0 + 8 * g + 4 * hh + rr;
                    const bool valid = (kc >= start) && (kc < start + 16);
                    const int bi = min(max(kc - c + 15, 0), 30);
                    const float p = fexp2((a[rr] + rpr[bi]) * 1.4426950408889634f - Bl2);
                    a[rr] = valid ? p : 0.f; l += a[rr];
                }
                st[hh] = a;
            }
            const bf16x8 bp = pack8(st[0], st[1]);
#pragma unroll
            for (int db = 0; db < 4; ++db) o[db] = mfma16(ldfrag(vx + (size_t)(16 * db) * SEQ + T0), bp, o[db]);
        }
    }
#pragma unroll 2
    for (int y = 0; y < 8; ++y) {
        f32x4 st[2];
#pragma unroll
        for (int hh = 0; hh < 2; ++hh) {
            LAS const unsigned char* kp = L + SW_CK + (32 * y + 16 * hh + qi) * SW_KP;
            f32x4 a = {0.f, 0.f, 0.f, 0.f};
            a = mfma16(ldsfrag(kp + kz0), bq[0], a); a = mfma16(ldsfrag(kp + kz1), bq[1], a);
#pragma unroll
            for (int rr = 0; rr < 4; ++rr) { const float p = fexp2(a[rr] * 1.4426950408889634f - Bl2); a[rr] = p; l += p; }
            st[hh] = a;
        }
        const bf16x8 bp = pack8(st[0], st[1]);
#pragma unroll
        for (int db = 0; db < 4; ++db) o[db] = mfma16(ldsfrag(L + SW_CV + (16 * db + qi) * SW_CVP + (32 * y + 8 * g) * 2), bp, o[db]);
    }
    l += __shfl_xor(l, 16); l += __shfl_xor(l, 32);
    const float inv = 1.0f / l;
    GAS bf16* op = F.XN + qrow * DM + h * 64 + 4 * g;
#pragma unroll
    for (int db = 0; db < 4; ++db) { v2u w; w.x = pk2(o[db][0] * inv, o[db][1] * inv); w.y = pk2(o[db][2] * inv, o[db][3] * inv); *(GAS v2u*)(op + 16 * db) = w; }
}
__device__ __forceinline__ void swa_phase(const Ctx& F) {
    const int lane = F.lane, qi = lane & 15, g = lane >> 4, tid = F.tid;
    const GAS bf16* P = F.P;
    LAS unsigned char* L = F.lds;
    float mq = fabsf(F.swa_q_norm[lane]), mk = fabsf(F.swa_k_norm[lane]);
#pragma unroll
    for (int o = 1; o < 64; o <<= 1) { mq = fmaxf(mq, __shfl_xor(mq, o)); mk = fmaxf(mk, __shfl_xor(mk, o)); }
    const float Bl2 = 8.1f * mq * mk * 1.4426950408889634f;
    const int arow = 8 * (qi >> 2) + (qi & 3);
    const int vcu = F.gw >> 3;
    for (int su = vcu; su < 256; su += F.G) {
        const int b = su >> 6, kvh = (su >> 4) & 3, qb0 = (su & 15) * 8;
        const int hq = kvh * 4 + (F.wave >> 1), sb = F.wave & 1;
        __syncthreads();
#pragma unroll
        for (int j = 0; j < 4; ++j) {
            const int cid = tid + 512 * j;
            { const int row = cid >> 3, c8 = cid & 7;
              *(LAS v4u*)(L + SW_CK + kswz(row, c8)) = ld16(P + (size_t)(MLAT + b * CL + row) * SWA_IN + 1024 + kvh * 64 + 8 * c8); }
            { const int d = cid >> 5, c = cid & 31;
              *(LAS v4u*)(L + SW_CV + d * SW_CVP + 16 * c) = ld16(F.TAV + (size_t)NBATCH * 4 * 64 * SEQ + ((size_t)(b * 4 + kvh) * 64 + d) * CL + 8 * c); }
        }
        const float sinkp = fexp2(F.swa_sink[hq] * 1.4426950408889634f - Bl2);
        v4u kreg[5], vreg[5];
#define SW_PREFETCH(T0) do { _Pragma("unroll") for (int j = 0; j < 5; ++j) { const int cid = tid + 512 * j; if (cid < 2304) { \
            { const int row = cid >> 3, c8 = cid & 7; const int s_ = min(max((T0) - 128 + row, 0), SEQ - 1); kreg[j] = ld16(P + (size_t)(b * SEQ + s_) * SWA_IN + 1024 + kvh * 64 + 8 * c8); } \
            { const int d = cid / 36, c = cid - d * 36; const int tok = min(max((T0) - 128 + 8 * c, 0), SEQ - 8); vreg[j] = ld16(F.TAV + ((size_t)(b * 4 + kvh) * 64 + d) * SEQ + tok); } } } } while (0)
        SW_PREFETCH(32 * qb0);
#pragma unroll 1
        for (int iq = 0; iq < 8; ++iq) {
            const int t0 = 32 * (qb0 + iq);
            if (iq > 0) __syncthreads();
#pragma unroll
            for (int j = 0; j < 5; ++j) {
                const int cid = tid + 512 * j;
                if (cid < 2304) {
                    { const int row = cid >> 3, c8 = cid & 7; *(LAS v4u*)(L + SW_LK + kswz(row, c8)) = kreg[j]; }
                    { const int d = cid / 36, c = cid - d * 36; *(LAS v4u*)(L + SW_LV + d * SW_LVP + 16 * c) = vreg[j]; }
                }
            }
            if (iq + 1 < 8) SW_PREFETCH(t0 + 32);
            const int t = t0 + 16 * sb + qi;
            const GAS bf16* qp = P + (size_t)(b * SEQ + t) * SWA_IN + hq * 64 + 8 * g;
            bf16x8 bq[2]; bq[0] = ldfrag(qp); bq[1] = ldfrag(qp + 32);
            __syncthreads();
            float l = 0.f;
            f32x4 o[4];
#pragma unroll
            for (int db = 0; db < 4; ++db) o[db] = (f32x4){0.f, 0.f, 0.f, 0.f};
            f32x4 Sraw[2][2]; bf16x8 Ppk[2];
            const int kc0 = 16 * g, kc1 = kc0 + 64;
#define SW_A(y) do { _Pragma("unroll") for (int hh = 0; hh < 2; ++hh) { \
                LAS const unsigned char* kp = ((y) < 9) ? (L + SW_LK + (32 * (y) + 16 * hh + qi) * SW_KP) : (L + SW_CK + (32 * ((y) - 9) + 16 * hh + qi) * SW_KP); \
                f32x4 a = {0.f, 0.f, 0.f, 0.f}; a = mfma16(ldsfrag(kp + kc0), bq[0], a); a = mfma16(ldsfrag(kp + kc1), bq[1], a); Sraw[(y) & 1][hh] = a; } } while (0)
#define SW_B(y) do { f32x4 st[2]; _Pragma("unroll") for (int hh = 0; hh < 2; ++hh) { f32x4 a = Sraw[(y) & 1][hh]; \
                _Pragma("unroll") for (int rr = 0; rr < 4; ++rr) { float p = fexp2(a[rr] * 1.4426950408889634f - Bl2); \
                    if ((y) < 9) { const int s_ = t0 - 128 + 32 * (y) + 8 * g + 4 * hh + rr; const int d = t - s_; \
                        const bool valid = (s_ >= 0) && (s_ < SEQ) && (d <= 128) && (d >= -128); p = valid ? p : 0.f; } \
                    a[rr] = p; l += p; } st[hh] = a; } Ppk[(y) & 1] = pack8(st[0], st[1]); } while (0)
#define SW_C(y) do { _Pragma("unroll") for (int db = 0; db < 4; ++db) { \
                LAS const unsigned char* vp = ((y) < 9) ? (L + SW_LV + (16 * db + qi) * SW_LVP + (32 * (y) + 8 * g) * 2) : (L + SW_CV + (16 * db + qi) * SW_CVP + (32 * ((y) - 9) + 8 * g) * 2); \
                o[db] = mfma16(ldsfrag(vp), Ppk[(y) & 1], o[db]); } } while (0)
            SW_A(0);
            SW_A(1); SW_B(0);
#pragma unroll
            for (int y = 1; y < 17; ++y) {
                if (y + 1 < 17) SW_A(y + 1);
                SW_C(y - 1);
                SW_B(y);
            }
            SW_C(16);
#undef SW_A
#undef SW_B
#undef SW_C
            l += __shfl_xor(l, 16); l += __shfl_xor(l, 32);
            l += sinkp;
            const float inv = 1.0f / l;
            GAS bf16* op = F.XN + (size_t)(b * SEQ + t) * DM + hq * 64 + 4 * g;
#pragma unroll
            for (int db = 0; db < 4; ++db) { v2u w; w.x = pk2(o[db][0] * inv, o[db][1] * inv); w.y = pk2(o[db][2] * inv, o[db][3] * inv); *(GAS v2u*)(op + 16 * db) = w; }
        }
#undef SW_PREFETCH
    }
    __syncthreads();
}

__device__ __forceinline__ void na_phase(const Ctx& F) {
    const int lane = F.lane, tid = F.tid;
    const GAS bf16* P = F.P;
    LAS unsigned char* L = F.lds;
    float mq = fabsf(F.na_q_norm[lane]), mk = fabsf(F.na_k_norm[lane]);
#pragma unroll
    for (int o = 1; o < 64; o <<= 1) { mq = fmaxf(mq, __shfl_xor(mq, o)); mk = fmaxf(mk, __shfl_xor(mk, o)); }
    const int vcu = F.gw >> 3;
    for (int su = vcu; su < 256; su += F.G) {
        const int bh = su >> 3, e8 = su & 7, b = bh >> 3, h = bh & 7;
        __syncthreads();
#pragma unroll
        for (int j = 0; j < 4; ++j) {
            const int cid = tid + 512 * j;
            { const int row = cid >> 3, c8 = cid & 7;
              *(LAS v4u*)(L + SW_CK + kswz(row, c8)) = ld16(P + (size_t)(MLAT + b * CL + row) * AB_IN + 512 + h * 64 + 8 * c8); }
            { const int d = cid >> 5, c = cid & 31;
              *(LAS v4u*)(L + SW_CV + d * SW_CVP + 16 * c) = ld16(F.TAV + (size_t)NBATCH * 8 * 64 * SEQ + ((size_t)(b * 8 + h) * 64 + d) * CL + 8 * c); }
        }
        float mb = 0.f;
        if (tid < 465) { const float v = F.na_rpb[h * 465 + tid]; ((LAS float*)(L + NA_RPB))[tid] = v; }
        for (int i = lane; i < 465; i += 64) mb = fmaxf(mb, fabsf(F.na_rpb[h * 465 + i]));
#pragma unroll
        for (int o = 1; o < 64; o <<= 1) mb = fmaxf(mb, __shfl_xor(mb, o));
        const float Bl2 = (8.1f * mq * mk + mb) * 1.4426950408889634f;
        __syncthreads();
#pragma unroll 1
        for (int k = 0; k < 4; ++k) { const int i = F.wave + 8 * k; na_unit2<false>(F, b, h, e8 * 8 + (i >> 2), i & 3, Bl2); }
        if (F.wave < 2) na_unit2<true>(F, b, h, e8 * 2 + F.wave, 0, Bl2);
    }
    __syncthreads();
}

__device__ __forceinline__ int ret_pb(int pf) { return pf < 2 ? 32 + pf : pf - 2; }
__device__ __forceinline__ void ret_r1_unit(const Ctx& F, int bh, int pf, int dir) {
    const int lane = F.lane, qi = lane & 15, g = lane >> 4;
    const int h = bh & 7;
    const float lg2 = -__expf(F.ret_log_decay[dir * 8 + h]) * 1.4426950408889634f;
    const bool isctx = pf < 2;
    const int tlen = isctx ? CL : SEQ;
    const size_t boff = (isctx ? (size_t)NBATCH * 8 * 64 * SEQ : (size_t)0) + (size_t)bh * 64 * tlen + (isctx ? pf * 128 : (pf - 2) * 128);
    const GAS bf16* kt = F.TBK + boff + (size_t)qi * tlen + 8 * g;
    const GAS bf16* vt = F.TBV + boff + (size_t)qi * tlen + 8 * g;
    f32x4 acc[4][4];
#pragma unroll
    for (int db = 0; db < 4; ++db)
#pragma unroll
        for (int kb = 0; kb < 4; ++kb) acc[db][kb] = (f32x4){0.f, 0.f, 0.f, 0.f};
#pragma unroll 1
    for (int js = 0; js < 4; ++js) {
        float w[8];
#pragma unroll
        for (int jj = 0; jj < 8; ++jj) { const int j = 32 * js + 8 * g + jj; w[jj] = fexp2(lg2 * (float)(dir == 0 ? 127 - j : j)); }
        bf16x8 bk[4];
#pragma unroll
        for (int kb = 0; kb < 4; ++kb) {
            const v4u raw = ld16(kt + (size_t)(16 * kb) * tlen + 32 * js);
            v4u o; o.x = pk2(bflo(raw.x) * w[0], bfhi(raw.x) * w[1]); o.y = pk2(bflo(raw.y) * w[2], bfhi(raw.y) * w[3]);
            o.z = pk2(bflo(raw.z) * w[4], bfhi(raw.z) * w[5]); o.w = pk2(bflo(raw.w) * w[6], bfhi(raw.w) * w[7]);
            bk[kb] = __builtin_bit_cast(bf16x8, o);
        }
#pragma unroll
        for (int db = 0; db < 4; ++db) {
            const bf16x8 a = ldfrag(vt + (size_t)(16 * db) * tlen + 32 * js);
#pragma unroll
            for (int kb = 0; kb < 4; ++kb) acc[db][kb] = mfma16(a, bk[kb], acc[db][kb]);
        }
    }
    const int idx = dir == 0 ? pf : ret_pb(pf);
    GAS float* out = F.KV + ((size_t)(bh * 2 + dir) * 34 + idx) * 4096;
#pragma unroll
    for (int db = 0; db < 4; ++db)
#pragma unroll
        for (int kb = 0; kb < 4; ++kb)
#pragma unroll
            for (int rr = 0; rr < 4; ++rr) out[(16 * db + 4 * g + rr) * 64 + 16 * kb + qi] = acc[db][kb][rr];
}
__device__ __forceinline__ void ret_r2(const Ctx& F) {
    const int NT = F.ngw * 64;
    for (int it = F.gw * 64 + F.lane; it < 64 * 4096; it += NT) {
        const int unit = it >> 12, e = it & 4095;
        const int dir = unit & 1, h = (unit >> 1) & 7;
        const float gC = fexp2(-__expf(F.ret_log_decay[dir * 8 + h]) * 1.4426950408889634f * 128.f);
        const GAS float* kv = F.KV + (size_t)unit * 34 * 4096 + e;
        GAS bf16* st = F.ST + (size_t)unit * 34 * 4096 + e;
        float S = 0.f;
        if (dir == 0) { for (int p = 0; p < 34; ++p) { st[(size_t)p * 4096] = (bf16)f2bf(S); S = S * gC + kv[(size_t)p * 4096]; } }
        else { for (int p = 33; p >= 0; --p) { st[(size_t)p * 4096] = (bf16)f2bf(S); S = S * gC + kv[(size_t)p * 4096]; } }
    }
}
constexpr int R3_KP = 144, R3_K = 0, R3_VP = 272, R3_V = 18432, R3_SP = 144, R3_SF = 35840, R3_SB = 45056, R3_END = 54272;
__device__ __forceinline__ void ret_r3_phase(const Ctx& F) {
    const int lane = F.lane, qi = lane & 15, g = lane >> 4, tid = F.tid, ib = F.wave;
    const GAS bf16* P = F.P;
    LAS unsigned char* L = F.lds;
    const int arow = 8 * (qi >> 2) + (qi & 3);
    const int kc0 = 16 * g, kc1 = kc0 + 64;
    const int vcu = F.gw >> 3;
    for (int grp = vcu; grp < 32 * 34; grp += F.G) {
        const int bh = grp / 34, pf = grp - bh * 34;
        const int b = bh >> 3, h = bh & 7;
        const bool isctx = pf < 2;
        const size_t row0 = isctx ? (size_t)(MLAT + b * CL + pf * 128) : (size_t)(b * SEQ + (pf - 2) * 128);
        const int tlen = isctx ? CL : SEQ;
        const GAS bf16* vt = F.TBV + (isctx ? (size_t)NBATCH * 8 * 64 * SEQ : (size_t)0) + (size_t)bh * 64 * tlen + (isctx ? pf * 128 : (pf - 2) * 128);
        const GAS bf16* sfp = F.ST + ((size_t)(bh * 2 + 0) * 34 + pf) * 4096;
        const GAS bf16* sbp = F.ST + ((size_t)(bh * 2 + 1) * 34 + ret_pb(pf)) * 4096;
        __syncthreads();
#pragma unroll
        for (int j = 0; j < 2; ++j) {
            const int cid = tid + 512 * j;
            { const int row = cid >> 3, c8 = cid & 7; *(LAS v4u*)(L + R3_K + kswz(row, c8)) = ld16(P + (row0 + row) * AB_IN + 2048 + h * 64 + 8 * c8); }
            { const int d = cid >> 4, c = cid & 15; *(LAS v4u*)(L + R3_V + d * R3_VP + 16 * c) = ld16(vt + (size_t)d * tlen + 8 * c); }
        }
        { const int d = tid >> 3, c8 = tid & 7;
          *(LAS v4u*)(L + R3_SF + d * R3_SP + 16 * c8) = ld16(sfp + d * 64 + 8 * c8);
          *(LAS v4u*)(L + R3_SB + d * R3_SP + 16 * c8) = ld16(sbp + d * 64 + 8 * c8); }
        const int i = 16 * ib + qi;
        const float lgf = -__expf(F.ret_log_decay[h]) * 1.4426950408889634f, lgb = -__expf(F.ret_log_decay[8 + h]) * 1.4426950408889634f;
        const GAS bf16* qp = P + (row0 + i) * AB_IN + 1536 + h * 64 + 8 * g;
        bf16x8 bq[2]; bq[0] = ldfrag(qp); bq[1] = ldfrag(qp + 32);
        __syncthreads();
        f32x4 o[4];
#pragma unroll
        for (int db = 0; db < 4; ++db) o[db] = (f32x4){0.f, 0.f, 0.f, 0.f};
#pragma unroll
        for (int y = 0; y < 4; ++y) {
            f32x4 st[2];
#pragma unroll
            for (int hh = 0; hh < 2; ++hh) {
                LAS const unsigned char* kp = L + R3_K + (32 * y + 16 * hh + qi) * R3_KP;
                f32x4 a = {0.f, 0.f, 0.f, 0.f};
                a = mfma16(ldsfrag(kp + kc0), bq[0], a); a = mfma16(ldsfrag(kp + kc1), bq[1], a);
#pragma unroll
                for (int rr = 0; rr < 4; ++rr) {
                    const int j = 32 * y + 8 * g + 4 * hh + rr; const int d = i - j;
                    const float w = d > 0 ? fexp2(lgf * (float)d) : (d < 0 ? fexp2(lgb * (float)(-d)) : 1.0f);
                    a[rr] *= w;
                }
                st[hh] = a;
            }
            const bf16x8 bp = pack8(st[0], st[1]);
#pragma unroll
            for (int db = 0; db < 4; ++db) o[db] = mfma16(ldsfrag(L + R3_V + (16 * db + qi) * R3_VP + (32 * y + 8 * g) * 2), bp, o[db]);
        }
        {
            const float df = fexp2(lgf * (float)(i + 1)), dbk = fexp2(lgb * (float)(128 - i));
#pragma unroll
            for (int db = 0; db < 4; ++db) {
                LAS const unsigned char* sf = L + R3_SF + (16 * db + qi) * R3_SP + 16 * g;
                LAS const unsigned char* sb = L + R3_SB + (16 * db + qi) * R3_SP + 16 * g;
                f32x4 xf = {0.f, 0.f, 0.f, 0.f}, xb = {0.f, 0.f, 0.f, 0.f};
                xf = mfma16(ldsfrag(sf), bq[0], xf); xf = mfma16(ldsfrag(sf + 64), bq[1], xf);
                xb = mfma16(ldsfrag(sb), bq[0], xb); xb = mfma16(ldsfrag(sb + 64), bq[1], xb);
                o[db] = o[db] + xf * df + xb * dbk;
            }
        }
        float s = 0.f;
#pragma unroll
        for (int db = 0; db < 4; ++db) s += (o[db][0] + o[db][1]) + (o[db][2] + o[db][3]);
        s += __shfl_xor(s, 16); s += __shfl_xor(s, 32);
        const float mu = s * (1.f / 64.f);
        float q = 0.f;
#pragma unroll
        for (int db = 0; db < 4; ++db)
#pragma unroll
            for (int rr = 0; rr < 4; ++rr) { const float d = o[db][rr] - mu; o[db][rr] = d; q += d * d; }
        q += __shfl_xor(q, 16); q += __shfl_xor(q, 32);
        const float rstd = 1.0f / sqrtf(q * (1.f / 64.f) + 1e-5f);
        const GAS bf16* gp = P + (row0 + i) * AB_IN + 3072 + h * 64 + 4 * g;
        GAS bf16* op = F.XN + (row0 + i) * DM + 512 + h * 64 + 4 * g;
#pragma unroll
        for (int db = 0; db < 4; ++db) {
            const v2u gr = *(const GAS v2u*)(gp + 16 * db);
            const float gv[4] = {bflo(gr.x), bfhi(gr.x), bflo(gr.y), bfhi(gr.y)};
            float r[4];
#pragma unroll
            for (int rr = 0; rr < 4; ++rr) r[rr] = o[db][rr] * rstd * (gv[rr] / (1.f + fexp(-gv[rr])));
            v2u w; w.x = pk2(r[0], r[1]); w.y = pk2(r[2], r[3]); *(GAS v2u*)(op + 16 * db) = w;
        }
    }
    __syncthreads();
}
__device__ __constant__ unsigned char CAND_TAB[52] = {
    0x00,0x01,0x02,0x03,0x04,0x05,0x06,0x07,0x08,0x09,0x0a,0x0b,0x0c,0x0d,0x0e,0x0f,
    0x10,0x11,0x12,0x13,0x14,0x15,0x16,0x17,
    0x20,0x21,0x22,0x23,0x24,
    0x30,0x31,0x32,0x33,
    0x40,0x41,0x42, 0x50,0x51, 0x60,0x61, 0x70,0x71,
    0x80,0x90,0xa0,0xb0,0xc0,0xd0,0xe0,0xf0,
    0x00,0x00 };
#define SORT_NEG (-3.0e38f)
template <int LOGN>
__device__ __forceinline__ void bitonic_sort_desc(float (&v)[1 << LOGN]) {
    constexpr int N = 1 << LOGN;
#pragma unroll
    for (int kk = 1; kk <= LOGN; ++kk) {
#pragma unroll
        for (int jj = kk - 1; jj >= 0; --jj) {
#pragma unroll
            for (int i = 0; i < N; ++i) {
                const int k = 1 << kk, j = 1 << jj, l = i ^ j;
                if (l > i) {
                    const bool desc = ((i & k) == 0);
                    const float a = v[i], b = v[l];
                    const float hi = fmaxf(a, b), lo = fminf(a, b);
                    v[i] = desc ? hi : lo; v[l] = desc ? lo : hi;
                }
            }
        }
    }
}
__device__ __forceinline__ void merge_top16(float (&v)[16], int mask) {
    float c[16];
#pragma unroll
    for (int i = 0; i < 16; ++i) c[i] = fmaxf(v[i], __shfl_xor(v[15 - i], mask));
#pragma unroll
    for (int jj = 3; jj >= 0; --jj) {
#pragma unroll
        for (int i = 0; i < 16; ++i) { const int j = 1 << jj, l = i ^ j;
            if (l > i) { const float a = c[i], b = c[l]; c[i] = fmaxf(a, b); c[l] = fminf(a, b); } }
    }
#pragma unroll
    for (int i = 0; i < 16; ++i) v[i] = c[i];
}
__device__ __forceinline__ void merge_top16_local(float (&a)[16], const float (&b)[16]) {
    float c[16];
#pragma unroll
    for (int i = 0; i < 16; ++i) c[i] = fmaxf(a[i], b[15 - i]);
#pragma unroll
    for (int jj = 3; jj >= 0; --jj) {
#pragma unroll
        for (int i = 0; i < 16; ++i) { const int j = 1 << jj, l = i ^ j;
            if (l > i) { const float x = c[i], y = c[l]; c[i] = fmaxf(x, y); c[l] = fminf(x, y); } }
    }
#pragma unroll
    for (int i = 0; i < 16; ++i) a[i] = c[i];
}
constexpr int SC_KP = 272, SC_KEYS = 0, SC_PSTRIDE = 128 * SC_KP, SC_WL = 73728;
__device__ __forceinline__ void peer_score_unit(const Ctx& F, int tb, int h, LAS unsigned* wl, bf16x8 (&bq0)[4], int tbn) {
    const int lane = F.lane, qi = lane & 15, g = lane >> 4;
    const size_t m = (size_t)tb * 16 + qi;
    bf16x8 bq1[4];
#pragma unroll 1
    for (int p = 0; p < 2; ++p) {
        bf16x8 bq[4];
        const GAS bf16* qp = F.Q2 + m * PQD + h * 256 + p * 128 + 8 * g;
#pragma unroll
        for (int ks = 0; ks < 4; ++ks) bq[ks] = ldfrag(qp + 32 * ks);
        LAS const unsigned char* kp = F.lds + SC_KEYS + p * SC_PSTRIDE + qi * SC_KP + 16 * g;
        float va[16], vb[16];
#pragma unroll
        for (int kb = 0; kb < 8; ++kb) {
            f32x4 a = {0.f, 0.f, 0.f, 0.f};
#pragma unroll
            for (int ks = 0; ks < 4; ++ks) a = mfma16(ldsfrag(kp + (16 * kb) * SC_KP + 64 * ks), bq[ks], a);
#pragma unroll
            for (int rr = 0; rr < 4; ++rr) {
                const float pv = __uint_as_float((__float_as_uint(a[rr]) & ~127u) | (unsigned)(16 * kb + 4 * g + rr));
                if (kb < 4) va[4 * kb + rr] = pv; else vb[4 * (kb - 4) + rr] = pv;
            }
        }
        bitonic_sort_desc<4>(va); bitonic_sort_desc<4>(vb);
        merge_top16_local(va, vb);
        merge_top16(va, 16); merge_top16(va, 32);
        if (g == 0) {
#pragma unroll
            for (int i = 0; i < 16; ++i) wl[(qi * 2 + p) * 16 + i] = __float_as_uint(va[i]);
        }
    }
    LDS_WAIT(); asm volatile("" ::: "memory");
    LAS const unsigned char* tab = (LAS const unsigned char*)(wl + 512);
    float cd[16];
#pragma unroll
    for (int k = 0; k < 13; ++k) {
        const int code = g * 13 + k;
        const unsigned ij = tab[code];
        const unsigned a = wl[(qi * 2 + 0) * 16 + (ij >> 4)], b = wl[(qi * 2 + 1) * 16 + (ij & 15)];
        const float s = __uint_as_float(a & ~127u) + __uint_as_float(b & ~127u);
        cd[k] = code < 50 ? __uint_as_float((__float_as_uint(s) & ~63u) | (unsigned)code) : SORT_NEG;
    }
    cd[13] = SORT_NEG; cd[14] = SORT_NEG; cd[15] = SORT_NEG;
    bitonic_sort_desc<4>(cd);
    merge_top16(cd, 16); merge_top16(cd, 32);
    float e[16]; float sum = 0.f;
    const float mx = __uint_as_float(__float_as_uint(cd[0]) & ~63u);
#pragma unroll
    for (int k = 0; k < 16; ++k) { e[k] = fexp(__uint_as_float(__float_as_uint(cd[k]) & ~63u) - mx); sum += e[k]; }
    const float inv = 1.0f / sum;
    typedef int i32x4 __attribute__((ext_vector_type(4)));
    i32x4 oi; f32x4 og;
#pragma unroll
    for (int k = 0; k < 4; ++k) {
        const float cv = g == 0 ? cd[k] : (g == 1 ? cd[4 + k] : (g == 2 ? cd[8 + k] : cd[12 + k]));
        const float ev = g == 0 ? e[k] : (g == 1 ? e[4 + k] : (g == 2 ? e[8 + k] : e[12 + k]));
        const unsigned code = __float_as_uint(cv) & 63u;
        const unsigned ij = tab[code];
        const unsigned a = wl[(qi * 2 + 0) * 16 + (ij >> 4)] & 127u, b = wl[(qi * 2 + 1) * 16 + (ij & 15)] & 127u;
        oi[k] = (int)(a * 128u + b);
        og[k] = ev * inv;
    }
    *(GAS i32x4*)(F.IDX + m * 128 + h * 16 + 4 * g) = oi;
    *(GAS f32x4*)(F.GATE + m * 128 + h * 16 + 4 * g) = og;
    LDS_WAIT(); asm volatile("" ::: "memory");
}
__device__ __forceinline__ void peer_score_phase(const Ctx& F, int l, int Mp) {
    const int vcu = F.gw >> 3, tid = F.tid;
    LAS unsigned* wl = (LAS unsigned*)(F.lds + SC_WL + F.wave * 4096);
    if (F.lane < 52) ((LAS unsigned char*)(wl + 512))[F.lane] = CAND_TAB[F.lane];
    const int nj = (F.G >= 8) ? F.G / 8 : 1;
    const int nb = Mp / 16;
    for (int hh = vcu & 7; hh < 8; hh += (F.G >= 8 ? 8 : F.G)) {
        __syncthreads();
        const GAS bf16* src = F.SUBK + (size_t)((l * 8 + hh) * 2) * 128 * 128;
#pragma unroll
        for (int j = 0; j < 8; ++j) { const int cid = tid + 512 * j; const int row = cid >> 4, c16 = cid & 15;
            *(LAS v4u*)(F.lds + SC_KEYS + row * SC_KP + 16 * c16) = ld16(src + (size_t)row * 128 + 8 * c16); }
        __syncthreads();
        { const int tb0 = (vcu >> 3) % nj + nj * F.wave, qi = F.lane & 15, g = F.lane >> 4;
          bf16x8 bq0[4];
          if (SCPF && tb0 < nb) {
#pragma unroll
              for (int ks = 0; ks < 4; ++ks) bq0[ks] = ldfrag(F.Q2 + ((size_t)tb0 * 16 + qi) * PQD + hh * 256 + 8 * g + 32 * ks);
          }
          for (int tb = tb0; tb < nb; tb += nj * NWAVES) { const int tbn = tb + nj * NWAVES; peer_score_unit(F, tb, hh, wl, bq0, tbn < nb ? tbn : -1); } }
    }
    __syncthreads();
}

typedef float f32x2 __attribute__((ext_vector_type(2)));
#define DPP_XOR1(x) __builtin_bit_cast(float, __builtin_amdgcn_update_dpp(0, __builtin_bit_cast(int, (x)), 0xB1, 0xf, 0xf, false))
#define DPP_XOR2(x) __builtin_bit_cast(float, __builtin_amdgcn_update_dpp(0, __builtin_bit_cast(int, (x)), 0x4E, 0xf, 0xf, false))
#define DPP_ROR4(x) __builtin_bit_cast(float, __builtin_amdgcn_update_dpp(0, __builtin_bit_cast(int, (x)), 0x124, 0xf, 0xf, false))
#define DPP_ROR8(x) __builtin_bit_cast(float, __builtin_amdgcn_update_dpp(0, __builtin_bit_cast(int, (x)), 0x128, 0xf, 0xf, false))
__device__ __forceinline__ float xsum16(float x) { auto rr = __builtin_amdgcn_permlane16_swap(__float_as_uint(x), __float_as_uint(x), false, false); return __uint_as_float(rr[0]) + __uint_as_float(rr[1]); }
__device__ __forceinline__ float xsum32(float x) { auto rr = __builtin_amdgcn_permlane32_swap(__float_as_uint(x), __float_as_uint(x), false, false); return __uint_as_float(rr[0]) + __uint_as_float(rr[1]); }
__device__ __forceinline__ float reduce16pairs(const float (&p)[16], int lane) {
    const bool o1 = lane & 1, o2 = lane & 2;
    float a[8];
#pragma unroll
    for (int k = 0; k < 8; ++k) { const float keep = o1 ? p[2 * k + 1] : p[2 * k], send = o1 ? p[2 * k] : p[2 * k + 1]; a[k] = keep + DPP_XOR1(send); }
    float b[4];
#pragma unroll
    for (int k = 0; k < 4; ++k) { const float keep = o2 ? a[2 * k + 1] : a[2 * k], send = o2 ? a[2 * k] : a[2 * k + 1]; b[k] = keep + DPP_XOR2(send); }
#pragma unroll
    for (int k = 0; k < 4; ++k) { b[k] += DPP_ROR4(b[k]); b[k] += DPP_ROR8(b[k]); b[k] = xsum16(b[k]); }
    const int j = (lane >> 2) & 3;
    return j == 0 ? b[0] : (j == 1 ? b[1] : (j == 2 ? b[2] : b[3]));
}
typedef unsigned u32x16v __attribute__((ext_vector_type(16)));
__device__ __forceinline__ u32x6v ld24(const GAS unsigned char* p) {
    const v2u a = *(const GAS v2u*)p, b = *(const GAS v2u*)(p + 8), c = *(const GAS v2u*)(p + 16);
    return (u32x6v){a.x, a.y, b.x, b.y, c.x, c.y};
}
template <bool FP4> struct RowBuf { typedef u32x6v T; };
template <> struct RowBuf<true> { typedef v4u T; };
__device__ __forceinline__ void row_ld(v4u& r, const GAS unsigned char* T, unsigned row, unsigned q) { r = *(const GAS v4u*)(T + (row * 512u + 16u * q)); }
__device__ __forceinline__ void row_ld(u32x6v& r, const GAS unsigned char* T, unsigned row, unsigned q) { r = ld24(T + (row * 768u + 24u * q)); }
__device__ __forceinline__ u32x16v row_unpack(const v4u& r) {
    u32x16v f;
#pragma unroll
    for (int d = 0; d < 4; ++d) {
        f[4 * d + 0] = __builtin_bit_cast(unsigned, __builtin_amdgcn_cvt_scalef32_pk_bf16_fp4(r[d], 1.0f, 0));
        f[4 * d + 1] = __builtin_bit_cast(unsigned, __builtin_amdgcn_cvt_scalef32_pk_bf16_fp4(r[d], 1.0f, 1));
        f[4 * d + 2] = __builtin_bit_cast(unsigned, __builtin_amdgcn_cvt_scalef32_pk_bf16_fp4(r[d], 1.0f, 2));
        f[4 * d + 3] = __builtin_bit_cast(unsigned, __builtin_amdgcn_cvt_scalef32_pk_bf16_fp4(r[d], 1.0f, 3));
    }
    return f;
}
__device__ __forceinline__ u32x16v row_unpack(const u32x6v& r) { return __builtin_bit_cast(u32x16v, __builtin_amdgcn_cvt_scalef32_pk32_bf16_fp6(r, 1.0f)); }
template <int S, bool FP4>
__device__ __forceinline__ void pg_load(typename RowBuf<FP4>::T (&r)[8], const GAS unsigned char* T, int i0, int i1, bool up, unsigned q) {
    constexpr int bt = S >> 2, c = (S >> 1) & 1, sub = S & 1;
    const int idv = bt ? i1 : i0;
    constexpr int j0 = c * 16 + sub * 8;
    row_ld(r[0], T, (unsigned)__builtin_amdgcn_ds_swizzle(idv, (j0 + 0) << 5), q); row_ld(r[1], T, (unsigned)__builtin_amdgcn_ds_swizzle(idv, (j0 + 1) << 5), q);
    row_ld(r[2], T, (unsigned)__builtin_amdgcn_ds_swizzle(idv, (j0 + 2) << 5), q); row_ld(r[3], T, (unsigned)__builtin_amdgcn_ds_swizzle(idv, (j0 + 3) << 5), q);
    row_ld(r[4], T, (unsigned)__builtin_amdgcn_ds_swizzle(idv, (j0 + 4) << 5), q); row_ld(r[5], T, (unsigned)__builtin_amdgcn_ds_swizzle(idv, (j0 + 5) << 5), q);
    row_ld(r[6], T, (unsigned)__builtin_amdgcn_ds_swizzle(idv, (j0 + 6) << 5), q); row_ld(r[7], T, (unsigned)__builtin_amdgcn_ds_swizzle(idv, (j0 + 7) << 5), q);
#pragma unroll
    for (int k = 0; k < 8; ++k) {
    }
}
template <int S, bool FP4, bool LDO = false>
__device__ __forceinline__ void pg_dot(const typename RowBuf<FP4>::T (&r)[8], const unsigned (&h)[16], const f32x2 (&hf)[16], float (&p)[16]) {
    constexpr int sub = S & 1;
#pragma unroll
    for (int k = 0; k < 8; ++k) {
        if (LDO) { p[sub * 8 + k] = __uint_as_float((r[k][0] ^ r[k][1] ^ r[k][2] ^ r[k][3]) & 0x3fffffffu); }
        else if (FP4) {
            f32x2 s0 = {0.f, 0.f}, s1 = {0.f, 0.f};
#pragma unroll
            for (int d = 0; d < 4; ++d) {
                s0 += __builtin_amdgcn_cvt_scalef32_pk_f32_fp4(r[k][d], 1.0f, 0) * hf[4 * d + 0];
                s1 += __builtin_amdgcn_cvt_scalef32_pk_f32_fp4(r[k][d], 1.0f, 1) * hf[4 * d + 1];
                s0 += __builtin_amdgcn_cvt_scalef32_pk_f32_fp4(r[k][d], 1.0f, 2) * hf[4 * d + 2];
                s1 += __builtin_amdgcn_cvt_scalef32_pk_f32_fp4(r[k][d], 1.0f, 3) * hf[4 * d + 3];
            }
            const f32x2 t = s0 + s1;
            p[sub * 8 + k] = t.x + t.y;
        } else {
            const u32x16v f = row_unpack(r[k]);
            float s0 = 0.f, s1 = 0.f;
#pragma unroll
            for (int e = 0; e < 16; e += 2) { s0 = dot2bf(f[e], h[e], s0); s1 = dot2bf(f[e + 1], h[e + 1], s1); }
            p[sub * 8 + k] = s0 + s1;
        }
    }
}
template <int S, bool FP4, bool LDO = false>
__device__ __forceinline__ void pg_axpy(const typename RowBuf<FP4>::T (&r)[8], float wgt0, float wgt1, bool up, float (&acc)[32]) {
    constexpr int bt = S >> 2, c = (S >> 1) & 1, sub = S & 1;
    const float wgt = bt ? wgt1 : wgt0;
#pragma unroll
    for (int k = 0; k < 8; ++k) {
        if (LDO) { acc[(S * 8 + k) & 31] += __uint_as_float((r[k][0] ^ r[k][1] ^ r[k][2] ^ r[k][3]) & 0x3fffffffu); continue; }
        const float wA = __uint_as_float(__builtin_amdgcn_readlane(__float_as_uint(wgt), c * 16 + sub * 8 + k));
        const float wB = __uint_as_float(__builtin_amdgcn_readlane(__float_as_uint(wgt), 32 + c * 16 + sub * 8 + k));
        const float w = up ? wB : wA;
        if (FP4) {
            const f32x2 w2 = (f32x2){w, w};
#pragma unroll
            for (int d = 0; d < 4; ++d) {
                { const f32x2 f = __builtin_amdgcn_cvt_scalef32_pk_f32_fp4(r[k][d], 1.0f, 0); const f32x2 a = (f32x2){acc[8 * d + 0], acc[8 * d + 1]} + w2 * f; acc[8 * d + 0] = a.x; acc[8 * d + 1] = a.y; }
                { const f32x2 f = __builtin_amdgcn_cvt_scalef32_pk_f32_fp4(r[k][d], 1.0f, 1); const f32x2 a = (f32x2){acc[8 * d + 2], acc[8 * d + 3]} + w2 * f; acc[8 * d + 2] = a.x; acc[8 * d + 3] = a.y; }
                { const f32x2 f = __builtin_amdgcn_cvt_scalef32_pk_f32_fp4(r[k][d], 1.0f, 2); const f32x2 a = (f32x2){acc[8 * d + 4], acc[8 * d + 5]} + w2 * f; acc[8 * d + 4] = a.x; acc[8 * d + 5] = a.y; }
                { const f32x2 f = __builtin_amdgcn_cvt_scalef32_pk_f32_fp4(r[k][d], 1.0f, 3); const f32x2 a = (f32x2){acc[8 * d + 6], acc[8 * d + 7]} + w2 * f; acc[8 * d + 6] = a.x; acc[8 * d + 7] = a.y; }
            }
        } else {
            const unsigned wlo = f2bf(w), whi = wlo << 16;
            const u32x16v f = row_unpack(r[k]);
#pragma unroll
            for (int e = 0; e < 16; ++e) { acc[2 * e] = dot2bf(f[e], wlo, acc[2 * e]); acc[2 * e + 1] = dot2bf(f[e], whi, acc[2 * e + 1]); }
        }
    }
}
typedef _Float16 h2v __attribute__((ext_vector_type(2)));
template <int S>
__device__ __forceinline__ void pg_axpy_h(const v4u (&r)[8], float wgt0, float wgt1, bool up, h2v (&acc)[16]) {
    constexpr int bt = S >> 2, c = (S >> 1) & 1, sub = S & 1, j0 = c * 16 + sub * 8;
    const int wp = __float_as_int(bt ? wgt1 : wgt0);
    const int wsw[8] = {__builtin_amdgcn_ds_swizzle(wp, (j0 + 0) << 5), __builtin_amdgcn_ds_swizzle(wp, (j0 + 1) << 5), __builtin_amdgcn_ds_swizzle(wp, (j0 + 2) << 5), __builtin_amdgcn_ds_swizzle(wp, (j0 + 3) << 5),
                        __builtin_amdgcn_ds_swizzle(wp, (j0 + 4) << 5), __builtin_amdgcn_ds_swizzle(wp, (j0 + 5) << 5), __builtin_amdgcn_ds_swizzle(wp, (j0 + 6) << 5), __builtin_amdgcn_ds_swizzle(wp, (j0 + 7) << 5)};
#pragma unroll
    for (int k = 0; k < 8; ++k) {
        const h2v wh = __builtin_bit_cast(h2v, wsw[k]);
        int f[16];
#pragma unroll
        for (int d = 0; d < 4; ++d) {
            f[4 * d + 0] = __builtin_bit_cast(int, __builtin_amdgcn_cvt_scalef32_pk_f16_fp4(r[k][d], 1.0f, 0));
            f[4 * d + 1] = __builtin_bit_cast(int, __builtin_amdgcn_cvt_scalef32_pk_f16_fp4(r[k][d], 1.0f, 1));
            f[4 * d + 2] = __builtin_bit_cast(int, __builtin_amdgcn_cvt_scalef32_pk_f16_fp4(r[k][d], 1.0f, 2));
            f[4 * d + 3] = __builtin_bit_cast(int, __builtin_amdgcn_cvt_scalef32_pk_f16_fp4(r[k][d], 1.0f, 3));
        }
        asm volatile("" : "+v"(f[0]), "+v"(f[1]), "+v"(f[2]), "+v"(f[3]), "+v"(f[4]), "+v"(f[5]), "+v"(f[6]), "+v"(f[7]), "+v"(f[8]), "+v"(f[9]), "+v"(f[10]), "+v"(f[11]), "+v"(f[12]), "+v"(f[13]), "+v"(f[14]), "+v"(f[15]));
#pragma unroll
        for (int e = 0; e < 16; ++e) acc[e] = __builtin_elementwise_fma(wh, __builtin_bit_cast(h2v, f[e]), acc[e]);
    }
}
template <bool LDO = false>
__device__ __forceinline__ void peer_gather_u(const Ctx& F, int l, size_t m, float& wgt0, float& wgt1, int rm = -1) {
    const int lane = F.lane, q = lane & 31;
    const bool up = lane >= 32;
    const GAS int* ip = F.IDX + m * 128; const GAS float* gp = F.GATE + m * 128;
    const int i0 = ip[lane] & rm, i1 = ip[64 + lane] & rm;
    const float ga0 = gp[lane], ga1 = gp[64 + lane];
    const GAS unsigned char* U = F.U8 + (size_t)l * 16384 * U_ROWB;
    typename RowBuf<U_FP4 != 0>::T ra[8], rb[8];
    pg_load<0, U_FP4 != 0>(ra, U, i0, i1, up, (unsigned)q);
    unsigned h[16];
    { const GAS bf16* hp = F.XN + m * DM + 32 * q;
#pragma unroll
      for (int j = 0; j < 4; ++j) { const v4u w = ld16(hp + 8 * j); h[4 * j] = w.x; h[4 * j + 1] = w.y; h[4 * j + 2] = w.z; h[4 * j + 3] = w.w; } }
    f32x2 hf[16];
#pragma unroll
    for (int i = 0; i < 16; ++i) hf[i] = (f32x2){bflo(h[i]), bfhi(h[i])};
    const GAS float* SU = F.SU + l * 16384; const GAS float* SV = F.SV + l * 16384;
    const float su0 = SU[i0], sv0 = SV[i0], su1 = SU[i1], sv1 = SV[i1];
    const int cl = (lane >> 4) & 1;
    float p[16]; float act0 = 0.f, act1 = 0.f, tot;
    pg_load<1, U_FP4 != 0>(rb, U, i0, i1, up, (unsigned)q); pg_dot<0, U_FP4 != 0, LDO>(ra, h, hf, p);
    pg_load<2, U_FP4 != 0>(ra, U, i0, i1, up, (unsigned)q); pg_dot<1, U_FP4 != 0, LDO>(rb, h, hf, p); tot = reduce16pairs(p, lane); act0 = (cl == 0) ? tot : act0;
    pg_load<3, U_FP4 != 0>(rb, U, i0, i1, up, (unsigned)q); pg_dot<2, U_FP4 != 0, LDO>(ra, h, hf, p);
    pg_load<4, U_FP4 != 0>(ra, U, i0, i1, up, (unsigned)q); pg_dot<3, U_FP4 != 0, LDO>(rb, h, hf, p); tot = reduce16pairs(p, lane); act0 = (cl == 1) ? tot : act0;
    pg_load<5, U_FP4 != 0>(rb, U, i0, i1, up, (unsigned)q); pg_dot<4, U_FP4 != 0, LDO>(ra, h, hf, p);
    pg_load<6, U_FP4 != 0>(ra, U, i0, i1, up, (unsigned)q); pg_dot<5, U_FP4 != 0, LDO>(rb, h, hf, p); tot = reduce16pairs(p, lane); act1 = (cl == 0) ? tot : act1;
    pg_load<7, U_FP4 != 0>(rb, U, i0, i1, up, (unsigned)q); pg_dot<6, U_FP4 != 0, LDO>(ra, h, hf, p);
    pg_dot<7, U_FP4 != 0, LDO>(rb, h, hf, p); tot = reduce16pairs(p, lane); act1 = (cl == 1) ? tot : act1;
    wgt0 = gelu_erf(act0 * su0) * ga0 * sv0;
    wgt1 = gelu_erf(act1 * su1) * ga1 * sv1;
}
template <bool XNOUT>
__device__ __forceinline__ void peer_v_finish_tot(const Ctx& F, size_t m, float (&tot)[16], const GAS float* g2, GAS float* dst_row, const GAS float* ng, const GAS float* nsh, const GAS float* nsc, bool ns, float osc);
template <bool XNOUT>
__device__ __forceinline__ void peer_v_finish(const Ctx& F, size_t m, float (&acc)[32], const GAS float* g2, GAS float* dst_row, const GAS float* ng, const GAS float* nsh, const GAS float* nsc, bool ns = false, float osc = 1.f) {
    float tot[16];
#pragma unroll
    for (int i = 0; i < 16; ++i) {
        auto rr = __builtin_amdgcn_permlane32_swap(__float_as_uint(acc[i]), __float_as_uint(acc[i + 16]), false, false);
        tot[i] = __uint_as_float(rr[0]) + __uint_as_float(rr[1]);
    }
    peer_v_finish_tot<XNOUT>(F, m, tot, g2, dst_row, ng, nsh, nsc, ns, osc);
}
template <bool XNOUT>
__device__ __forceinline__ void peer_v_finish_tot(const Ctx& F, size_t m, float (&tot)[16], const GAS float* g2, GAS float* dst_row, const GAS float* ng, const GAS float* nsh, const GAS float* nsc, bool ns, float osc) {
    const int lane = F.lane, q = lane & 31;
    const bool up = lane >= 32;
    const int k0 = 32 * q + (up ? 16 : 0);
    const GAS bf16* src = F.XS + m * DM + k0;
    const GAS float* gg = g2 + k0;
    float xin[16];
    { const v4u a = ld16(src), b = ld16(src + 8);
      xin[0] = bflo(a.x); xin[1] = bfhi(a.x); xin[2] = bflo(a.y); xin[3] = bfhi(a.y); xin[4] = bflo(a.z); xin[5] = bfhi(a.z); xin[6] = bflo(a.w); xin[7] = bfhi(a.w);
      xin[8] = bflo(b.x); xin[9] = bfhi(b.x); xin[10] = bflo(b.y); xin[11] = bfhi(b.y); xin[12] = bflo(b.z); xin[13] = bfhi(b.z); xin[14] = bflo(b.w); xin[15] = bfhi(b.w); }
    float ss = 0.f;
#pragma unroll
    for (int j = 0; j < 4; ++j) {
        const f32x4 ga = *(const GAS f32x4*)(gg + 4 * j);
#pragma unroll
        for (int e = 0; e < 4; ++e) { const float o = xin[4 * j + e] + ga[e] * tot[4 * j + e]; tot[4 * j + e] = o; ss += o * o; }
    }
    if (ns && ss != 1.2345e-30f) return;
    if (XNOUT) {
        GAS bf16* dp = F.XS + m * DM + k0;
        v4u w0, w1;
        w0.x = pk2(tot[0], tot[1]); w0.y = pk2(tot[2], tot[3]); w0.z = pk2(tot[4], tot[5]); w0.w = pk2(tot[6], tot[7]);
        w1.x = pk2(tot[8], tot[9]); w1.y = pk2(tot[10], tot[11]); w1.z = pk2(tot[12], tot[13]); w1.w = pk2(tot[14], tot[15]);
        *(GAS v4u*)dp = w0; *(GAS v4u*)(dp + 8) = w1;
    } else {
        GAS float* dp = dst_row + k0;
#pragma unroll
        for (int j = 0; j < 4; ++j) *(GAS f32x4*)(dp + 4 * j) = (f32x4){tot[4 * j] * osc, tot[4 * j + 1] * osc, tot[4 * j + 2] * osc, tot[4 * j + 3] * osc};
    }
    if (XNOUT) {
        const float r = 1.0f / sqrtf(wave_sum(ss) * (1.f / DM) + 1e-6f);
        GAS bf16* xo = F.XN + m * DM + k0;
#pragma unroll
        for (int j = 0; j < 2; ++j) {
            float o[8];
#pragma unroll
            for (int e = 0; e < 8; ++e) { const int k = 8 * j + e; o[e] = tot[k] * r * ng[k0 + k] * (1.f + nsc[k0 + k]) + nsh[k0 + k]; }
            v4u w; w.x = pk2(o[0], o[1]); w.y = pk2(o[2], o[3]); w.z = pk2(o[4], o[5]); w.w = pk2(o[6], o[7]);
            *(GAS v4u*)(xo + 8 * j) = w;
        }
    }
}
template <bool XNOUT, bool LDO = false>
__device__ __forceinline__ void peer_gather_v_idx(const Ctx& F, int l, size_t m, int i0, int i1, float wgt0, float wgt1, const GAS float* g2, GAS float* dst_row, const GAS float* ng, const GAS float* nsh, const GAS float* nsc, bool ns = false, float osc = 1.f) {
    const int lane = F.lane, q = lane & 31;
    const bool up = lane >= 32;
    const GAS unsigned char* V = F.V8 + (size_t)l * 16384 * V_ROWB;
    float acc[32];
#if VF16 && V_FP4
    if (!LDO) {
        const float sa = wave_sum(fabsf(wgt0) + fabsf(wgt1));
        int ke = 13 - (int)((__float_as_uint(sa * 6.0f) >> 23) & 0xff) + 127;
        ke = ke > 40 ? 40 : (ke < -40 ? -40 : ke);
        const float sc = __uint_as_float((unsigned)(127 + ke) << 23), isc = __uint_as_float((unsigned)(127 - ke) << 23);
        const float ws0 = __int_as_float(__builtin_bit_cast(int, __builtin_amdgcn_cvt_pkrtz(wgt0 * sc, wgt0 * sc))), ws1 = __int_as_float(__builtin_bit_cast(int, __builtin_amdgcn_cvt_pkrtz(wgt1 * sc, wgt1 * sc)));
        h2v ah[16];
#pragma unroll
        for (int k = 0; k < 16; ++k) ah[k] = (h2v){(_Float16)0.f, (_Float16)0.f};
        v4u ra[8], rb[8];
        pg_load<0, true>(ra, V, i0, i1, up, (unsigned)q);
        pg_load<1, true>(rb, V, i0, i1, up, (unsigned)q); pg_axpy_h<0>(ra, ws0, ws1, up, ah);
        pg_load<2, true>(ra, V, i0, i1, up, (unsigned)q); pg_axpy_h<1>(rb, ws0, ws1, up, ah);
        pg_load<3, true>(rb, V, i0, i1, up, (unsigned)q); pg_axpy_h<2>(ra, ws0, ws1, up, ah);
        pg_load<4, true>(ra, V, i0, i1, up, (unsigned)q); pg_axpy_h<3>(rb, ws0, ws1, up, ah);
        pg_load<5, true>(rb, V, i0, i1, up, (unsigned)q); pg_axpy_h<4>(ra, ws0, ws1, up, ah);
        pg_load<6, true>(ra, V, i0, i1, up, (unsigned)q); pg_axpy_h<5>(rb, ws0, ws1, up, ah);
        pg_load<7, true>(rb, V, i0, i1, up, (unsigned)q); pg_axpy_h<6>(ra, ws0, ws1, up, ah);
        pg_axpy_h<7>(rb, ws0, ws1, up, ah);
#pragma unroll
        for (int k = 0; k < 16; ++k) { acc[2 * k] = (float)ah[k].x * isc; acc[2 * k + 1] = (float)ah[k].y * isc; }
        peer_v_finish<XNOUT>(F, m, acc, g2, dst_row, ng, nsh, nsc, ns, osc);
        return;
    }
#endif
#pragma unroll
    for (int k = 0; k < 32; ++k) acc[k] = 0.f;
    typename RowBuf<V_FP4 != 0>::T ra[8], rb[8];
    pg_load<0, V_FP4 != 0>(ra, V, i0, i1, up, (unsigned)q);
    pg_load<1, V_FP4 != 0>(rb, V, i0, i1, up, (unsigned)q); pg_axpy<0, V_FP4 != 0, LDO>(ra, wgt0, wgt1, up, acc);
    pg_load<2, V_FP4 != 0>(ra, V, i0, i1, up, (unsigned)q); pg_axpy<1, V_FP4 != 0, LDO>(rb, wgt0, wgt1, up, acc);
    pg_load<3, V_FP4 != 0>(rb, V, i0, i1, up, (unsigned)q); pg_axpy<2, V_FP4 != 0, LDO>(ra, wgt0, wgt1, up, acc);
    pg_load<4, V_FP4 != 0>(ra, V, i0, i1, up, (unsigned)q); pg_axpy<3, V_FP4 != 0, LDO>(rb, wgt0, wgt1, up, acc);
    pg_load<5, V_FP4 != 0>(rb, V, i0, i1, up, (unsigned)q); pg_axpy<4, V_FP4 != 0, LDO>(ra, wgt0, wgt1, up, acc);
    pg_load<6, V_FP4 != 0>(ra, V, i0, i1, up, (unsigned)q); pg_axpy<5, V_FP4 != 0, LDO>(rb, wgt0, wgt1, up, acc);
    pg_load<7, V_FP4 != 0>(rb, V, i0, i1, up, (unsigned)q); pg_axpy<6, V_FP4 != 0, LDO>(ra, wgt0, wgt1, up, acc);
    pg_axpy<7, V_FP4 != 0, LDO>(rb, wgt0, wgt1, up, acc);
    peer_v_finish<XNOUT>(F, m, acc, g2, dst_row, ng, nsh, nsc, ns, osc);
}
template <bool XNOUT>
__device__ __forceinline__ void peer_gather_v(const Ctx& F, int l, size_t m, float wgt0, float wgt1, const GAS float* g2, GAS float* dst_row, const GAS float* ng, const GAS float* nsh, const GAS float* nsc) {
    const GAS int* ip = F.IDX + m * 128;
    peer_gather_v_idx<XNOUT>(F, l, m, ip[F.lane], ip[64 + F.lane], wgt0, wgt1, g2, dst_row, ng, nsh, nsc);
}
template <int BT>
__device__ __forceinline__ float peer_gather_u_half(const Ctx& F, int l, size_t m) {
    const int lane = F.lane, q = lane & 31;
    const bool up = lane >= 32;
    const GAS int* ip = F.IDX + m * 128;
    const int i0 = ip[lane], i1 = ip[64 + lane];
    const float ga = F.GATE[m * 128 + BT * 64 + lane];
    const GAS unsigned char* U = F.U8 + (size_t)l * 16384 * U_ROWB;
    typename RowBuf<U_FP4 != 0>::T ra[8], rb[8];
    pg_load<4 * BT, U_FP4 != 0>(ra, U, i0, i1, up, (unsigned)q);
    unsigned h[16];
    { const GAS bf16* hp = F.XN + m * DM + 32 * q;
#pragma unroll
      for (int j = 0; j < 4; ++j) { const v4u w = ld16(hp + 8 * j); h[4 * j] = w.x; h[4 * j + 1] = w.y; h[4 * j + 2] = w.z; h[4 * j + 3] = w.w; } }
    f32x2 hf[16];
#pragma unroll
    for (int i = 0; i < 16; ++i) hf[i] = (f32x2){bflo(h[i]), bfhi(h[i])};
    const int ib = BT ? i1 : i0;
    const float su = F.SU[l * 16384 + ib], sv = F.SV[l * 16384 + ib];
    const int cl = (lane >> 4) & 1;
    float p[16]; float act = 0.f, tot;
    pg_load<4 * BT + 1, U_FP4 != 0>(rb, U, i0, i1, up, (unsigned)q); pg_dot<4 * BT, U_FP4 != 0>(ra, h, hf, p);
    pg_load<4 * BT + 2, U_FP4 != 0>(ra, U, i0, i1, up, (unsigned)q); pg_dot<4 * BT + 1, U_FP4 != 0>(rb, h, hf, p); tot = reduce16pairs(p, lane); act = (cl == 0) ? tot : act;
    pg_load<4 * BT + 3, U_FP4 != 0>(rb, U, i0, i1, up, (unsigned)q); pg_dot<4 * BT + 2, U_FP4 != 0>(ra, h, hf, p);
    pg_dot<4 * BT + 3, U_FP4 != 0>(rb, h, hf, p); tot = reduce16pairs(p, lane); act = (cl == 1) ? tot : act;
    return gelu_erf(act * su) * ga * sv;
}
template <int BT>
__device__ __forceinline__ void peer_gather_v_half(const Ctx& F, int l, size_t m, float wgt, float (&acc)[32]) {
    const int lane = F.lane, q = lane & 31;
    const bool up = lane >= 32;
    const GAS int* ip = F.IDX + m * 128;
    const int i0 = ip[lane], i1 = ip[64 + lane];
    const GAS unsigned char* V = F.V8 + (size_t)l * 16384 * V_ROWB;
#pragma unroll
    for (int k = 0; k < 32; ++k) acc[k] = 0.f;
    typename RowBuf<V_FP4 != 0>::T ra[8], rb[8];
    pg_load<4 * BT, V_FP4 != 0>(ra, V, i0, i1, up, (unsigned)q);
    pg_load<4 * BT + 1, V_FP4 != 0>(rb, V, i0, i1, up, (unsigned)q); pg_axpy<4 * BT, V_FP4 != 0>(ra, wgt, wgt, up, acc);
    pg_load<4 * BT + 2, V_FP4 != 0>(ra, V, i0, i1, up, (unsigned)q); pg_axpy<4 * BT + 1, V_FP4 != 0>(rb, wgt, wgt, up, acc);
    pg_load<4 * BT + 3, V_FP4 != 0>(rb, V, i0, i1, up, (unsigned)q); pg_axpy<4 * BT + 2, V_FP4 != 0>(ra, wgt, wgt, up, acc);
    pg_axpy<4 * BT + 3, V_FP4 != 0>(rb, wgt, wgt, up, acc);
}


typedef int v8i __attribute__((ext_vector_type(8)));
constexpr int UM_W = 0, UM_RB = (UMFMA == 2) ? 2048 : 4096, UM_RP = 528, UM_HB = UM_RB + 16 * UM_RP, UM_DBG = UM_HB + 2048;
constexpr int UM_STRIDE = (UMFMA == 2) ? 19456 : 16384;
template <int S>
__device__ __forceinline__ void um_consume(const v4u (&r)[8], LAS unsigned char* wl, const v4u (&bf)[8], float lsc, int lane, float& act0, float& act1, bool nowr = false) {
    constexpr int bt = S >> 2, cS = (S >> 1) & 1, sub = S & 1;
    const int q = lane & 31, up = lane >> 5;
    if (PROBE_UW && nowr) {
        unsigned x = 0;
#pragma unroll
        for (int k = 0; k < 8; ++k) x ^= r[k].x ^ r[k].y ^ r[k].z ^ r[k].w;
        if (x == 0x12345u) *(LAS unsigned*)(wl + UM_RB) = x;
    } else
#pragma unroll
    for (int k = 0; k < 8; ++k) *(LAS v4u*)(wl + UM_RB + (k + 8 * up) * UM_RP + 16 * q) = r[k];
    const int i = lane & 15, g = lane >> 4;
    f32x4 c0 = {0.f, 0.f, 0.f, 0.f}, c1 = {0.f, 0.f, 0.f, 0.f};
#pragma unroll
    for (int c = 0; c < 8; ++c) {
        const v4u a = *(LAS const v4u*)(wl + UM_RB + i * UM_RP + 64 * c + 16 * g);
        const v8i a8 = {(int)a.x, (int)a.y, (int)a.z, (int)a.w, 0, 0, 0, 0};
        const v8i b8 = {(int)bf[c].x, (int)bf[c].y, (int)bf[c].z, (int)bf[c].w, 0, 0, 0, 0};
        if (c & 1) c1 = __builtin_amdgcn_mfma_scale_f32_16x16x128_f8f6f4(a8, b8, c1, 4, 4, 0, 0x7F7F7F7F, 0, 0x7F7F7F7F);
        else       c0 = __builtin_amdgcn_mfma_scale_f32_16x16x128_f8f6f4(a8, b8, c0, 4, 4, 0, 0x7F7F7F7F, 0, 0x7F7F7F7F);
    }
    float t[4];
#pragma unroll
    for (int rr = 0; rr < 4; ++rr) { float x = (c0[rr] + c1[rr]) * lsc; x += DPP_XOR1(x); x += DPP_XOR2(x); t[rr] = x; }
    const int sel = lane & 3;
    const float v = sel == 0 ? t[0] : (sel == 1 ? t[1] : (sel == 2 ? t[2] : t[3]));
    const float tot = __shfl(v, 16 * (((lane & 7) >> 2) + 2 * (lane >> 5)) + (lane & 3));
    const bool mine = (((lane >> 4) & 1) == cS) && (((lane >> 3) & 1) == sub);
    if (bt == 0) act0 = mine ? tot : act0; else act1 = mine ? tot : act1;
}
__device__ __forceinline__ void peer_gather_u_mfma(const Ctx& F, int l, size_t m, LAS unsigned char* wl, float& wgt0, float& wgt1, int rm = -1) {
    const int lane = F.lane, q = lane & 31;
    const bool up = lane >= 32;
    const GAS int* ip = F.IDX + m * 128; const GAS float* gp = F.GATE + m * 128;
    const int i0 = ip[lane] & rm, i1 = ip[64 + lane] & rm;
    const float ga0 = gp[lane], ga1 = gp[64 + lane];
    const GAS unsigned char* U = F.U8 + (size_t)l * 16384 * U_ROWB;
    v4u ra[8], rb[8];
    pg_load<0, true>(ra, U, i0, i1, up, (unsigned)q);
    float s1;
    { const GAS bf16* hp = F.XN + m * DM + 16 * lane;
      const v4u w0 = ld16(hp), w1 = ld16(hp + 8);
      const unsigned ws[8] = {w0.x, w0.y, w0.z, w0.w, w1.x, w1.y, w1.z, w1.w};
      f32x2 rr[8]; float am = 0.f;
#pragma unroll
      for (int j = 0; j < 8; ++j) { rr[j] = (f32x2){bflo(ws[j]), bfhi(ws[j])}; am = fmaxf(am, fmaxf(fabsf(rr[j].x), fabsf(rr[j].y))); }
#pragma unroll
      for (int o = 32; o > 0; o >>= 1) am = fmaxf(am, __shfl_xor(am, o));
      s1 = am > 0.f ? am * (1.0f / 6.0f) : 1.0f;
      float sc = s1, inv = 1.0f / s1;
#pragma unroll
      for (int n = 0; n < 4; ++n) {
          unsigned pk0 = 0, pk1 = 0;
          const f32x2 inv2 = (f32x2){inv, inv}, sc2 = (f32x2){sc, sc};
#define UM_Q(PK, J, SEL) { const f32x2 tq = rr[J] * inv2; PK = __builtin_amdgcn_cvt_scalef32_pk_fp4_f32(PK, tq.x, tq.y, 1.0f, SEL); const f32x2 back = __builtin_amdgcn_cvt_scalef32_pk_f32_fp4(PK, 1.0f, SEL); rr[J] = rr[J] - back * sc2; }
          UM_Q(pk0, 0, 0) UM_Q(pk0, 1, 1) UM_Q(pk0, 2, 2) UM_Q(pk0, 3, 3) UM_Q(pk1, 4, 0) UM_Q(pk1, 5, 1) UM_Q(pk1, 6, 2) UM_Q(pk1, 7, 3)
#undef UM_Q
          *(LAS v2u*)(wl + UM_HB + n * 512 + 8 * lane) = (v2u){pk0, pk1};
          sc *= (1.0f / 6.0f); inv *= 6.0f;
      } }
    pg_load<1, true>(rb, U, i0, i1, up, (unsigned)q);
    const GAS float* SU = F.SU + l * 16384; const GAS float* SV = F.SV + l * 16384;
    const float su0 = SU[i0], sv0 = SV[i0], su1 = SU[i1], sv1 = SV[i1];
    v4u bf[8];
    { const int g = lane >> 4, n = lane & 3;
#pragma unroll
      for (int c = 0; c < 8; ++c) bf[c] = *(LAS const v4u*)(wl + UM_HB + n * 512 + 64 * c + 16 * g); }
    const int nn = lane & 15;
    const float lsc = nn == 0 ? s1 : (nn == 1 ? s1 * (1.0f / 6.0f) : (nn == 2 ? s1 * (1.0f / 36.0f) : (nn == 3 ? s1 * (1.0f / 216.0f) : 0.f)));
    float act0 = 0.f, act1 = 0.f;
    um_consume<0>(ra, wl, bf, lsc, lane, act0, act1, rm == 0x7fffffff);
    pg_load<2, true>(ra, U, i0, i1, up, (unsigned)q); um_consume<1>(rb, wl, bf, lsc, lane, act0, act1, rm == 0x7fffffff);
    pg_load<3, true>(rb, U, i0, i1, up, (unsigned)q); um_consume<2>(ra, wl, bf, lsc, lane, act0, act1, rm == 0x7fffffff);
    pg_load<4, true>(ra, U, i0, i1, up, (unsigned)q); um_consume<3>(rb, wl, bf, lsc, lane, act0, act1, rm == 0x7fffffff);
    pg_load<5, true>(rb, U, i0, i1, up, (unsigned)q); um_consume<4>(ra, wl, bf, lsc, lane, act0, act1, rm == 0x7fffffff);
    pg_load<6, true>(ra, U, i0, i1, up, (unsigned)q); um_consume<5>(rb, wl, bf, lsc, lane, act0, act1, rm == 0x7fffffff);
    pg_load<7, true>(rb, U, i0, i1, up, (unsigned)q); um_consume<6>(ra, wl, bf, lsc, lane, act0, act1, rm == 0x7fffffff);
    um_consume<7>(rb, wl, bf, lsc, lane, act0, act1, rm == 0x7fffffff);
    wgt0 = gelu_erf(act0 * su0) * ga0 * sv0;
    wgt1 = gelu_erf(act1 * su1) * ga1 * sv1;
}

__device__ __forceinline__ void um_h_to_lds(const v4u& w0, const v4u& w1, LAS unsigned char* wl, int lane, float& s1) {
    const unsigned ws[8] = {w0.x, w0.y, w0.z, w0.w, w1.x, w1.y, w1.z, w1.w};
    f32x2 rr[8]; float am = 0.f;
#pragma unroll
    for (int j = 0; j < 8; ++j) { rr[j] = (f32x2){bflo(ws[j]), bfhi(ws[j])}; am = fmaxf(am, fmaxf(fabsf(rr[j].x), fabsf(rr[j].y))); }
#pragma unroll
    for (int o = 32; o > 0; o >>= 1) am = fmaxf(am, __shfl_xor(am, o));
    s1 = am > 0.f ? am * (1.0f / 6.0f) : 1.0f;
    float sc = s1, inv = 1.0f / s1;
#pragma unroll
    for (int n = 0; n < 4; ++n) {
        unsigned pk0 = 0, pk1 = 0;
        const f32x2 inv2 = (f32x2){inv, inv}, sc2 = (f32x2){sc, sc};
#define UM_Q(PK, J, SEL) { const f32x2 tq = rr[J] * inv2; PK = __builtin_amdgcn_cvt_scalef32_pk_fp4_f32(PK, tq.x, tq.y, 1.0f, SEL); const f32x2 back = __builtin_amdgcn_cvt_scalef32_pk_f32_fp4(PK, 1.0f, SEL); rr[J] = rr[J] - back * sc2; }
        UM_Q(pk0, 0, 0) UM_Q(pk0, 1, 1) UM_Q(pk0, 2, 2) UM_Q(pk0, 3, 3) UM_Q(pk1, 4, 0) UM_Q(pk1, 5, 1) UM_Q(pk1, 6, 2) UM_Q(pk1, 7, 3)
#undef UM_Q
        *(LAS v2u*)(wl + UM_HB + n * 512 + 8 * lane) = (v2u){pk0, pk1};
        sc *= (1.0f / 6.0f); inv *= 6.0f;
    }
}
template <bool WBF16>
__device__ __forceinline__ void peer_u_pass_mfma_stream(const Ctx& F, int l, int Mown, int gw, int ngw, LAS unsigned char* wl) {
    const int lane = F.lane, q = lane & 31;
    const bool up = lane >= 32;
    const int ntok = gw < Mown ? (Mown - gw + ngw - 1) / ngw : 0;
    if (ntok == 0) return;
    const GAS unsigned char* U = F.U8 + (size_t)l * 16384 * U_ROWB;
    const GAS float* SU = F.SU + l * 16384; const GAS float* SV = F.SV + l * 16384;
    v4u b0[8], b1[8], b2[8], b3[8];
    size_t m = (size_t)gw;
    int ci0 = F.IDX[m * 128 + lane], ci1 = F.IDX[m * 128 + 64 + lane];
    pg_load<0, true>(b0, U, ci0, ci1, up, (unsigned)q); pg_load<1, true>(b1, U, ci0, ci1, up, (unsigned)q); pg_load<2, true>(b2, U, ci0, ci1, up, (unsigned)q);
    v4u hA = ld16(F.XN + m * DM + 16 * lane), hB = ld16(F.XN + m * DM + 16 * lane + 8);
    float ga0 = F.GATE[m * 128 + lane], ga1 = F.GATE[m * 128 + 64 + lane];
    float su0 = SU[ci0], sv0 = SV[ci0], su1 = SU[ci1], sv1 = SV[ci1];
#pragma unroll 1
    for (int t = 0; t < ntok; ++t) {
        const bool has_next = t + 1 < ntok;
        const size_t mn = m + (size_t)ngw;
        int ni0 = ci0, ni1 = ci1;
        if (has_next) { ni0 = F.IDX[mn * 128 + lane]; ni1 = F.IDX[mn * 128 + 64 + lane]; }
        float s1;
        um_h_to_lds(hA, hB, wl, lane, s1);
        v4u bf[8];
        { const int g = lane >> 4, n = lane & 3;
#pragma unroll
          for (int c = 0; c < 8; ++c) bf[c] = *(LAS const v4u*)(wl + UM_HB + n * 512 + 64 * c + 16 * g); }
        const int nn = lane & 15;
        const float lsc = nn == 0 ? s1 : (nn == 1 ? s1 * (1.0f / 6.0f) : (nn == 2 ? s1 * (1.0f / 36.0f) : (nn == 3 ? s1 * (1.0f / 216.0f) : 0.f)));
        float act0 = 0.f, act1 = 0.f;
        pg_load<3, true>(b3, U, ci0, ci1, up, (unsigned)q); um_consume<0>(b0, wl, bf, lsc, lane, act0, act1);
        pg_load<4, true>(b0, U, ci0, ci1, up, (unsigned)q); um_consume<1>(b1, wl, bf, lsc, lane, act0, act1);
        pg_load<5, true>(b1, U, ci0, ci1, up, (unsigned)q); um_consume<2>(b2, wl, bf, lsc, lane, act0, act1);
        pg_load<6, true>(b2, U, ci0, ci1, up, (unsigned)q); um_consume<3>(b3, wl, bf, lsc, lane, act0, act1);
        float nga0 = 0.f, nga1 = 0.f, nsu0 = 0.f, nsv0 = 0.f, nsu1 = 0.f, nsv1 = 0.f;
        if (has_next) {
            hA = ld16(F.XN + mn * DM + 16 * lane); hB = ld16(F.XN + mn * DM + 16 * lane + 8);
            nga0 = F.GATE[mn * 128 + lane]; nga1 = F.GATE[mn * 128 + 64 + lane];
            nsu0 = SU[ni0]; nsv0 = SV[ni0]; nsu1 = SU[ni1]; nsv1 = SV[ni1];
        }
        pg_load<7, true>(b3, U, ci0, ci1, up, (unsigned)q); um_consume<4>(b0, wl, bf, lsc, lane, act0, act1);
        if (has_next) pg_load<0, true>(b0, U, ni0, ni1, up, (unsigned)q);
        um_consume<5>(b1, wl, bf, lsc, lane, act0, act1);
        if (has_next) pg_load<1, true>(b1, U, ni0, ni1, up, (unsigned)q);
        um_consume<6>(b2, wl, bf, lsc, lane, act0, act1);
        if (has_next) pg_load<2, true>(b2, U, ni0, ni1, up, (unsigned)q);
        um_consume<7>(b3, wl, bf, lsc, lane, act0, act1);
        const float w0 = gelu_erf(act0 * su0) * ga0 * sv0, w1 = gelu_erf(act1 * su1) * ga1 * sv1;
        if (WBF16) { ((LAS unsigned short*)(wl + UM_W))[t * 128 + lane] = (unsigned short)f2bf(w0); ((LAS unsigned short*)(wl + UM_W))[t * 128 + 64 + lane] = (unsigned short)f2bf(w1); }
        else { ((LAS float*)(wl + UM_W))[t * 128 + lane] = w0; ((LAS float*)(wl + UM_W))[t * 128 + 64 + lane] = w1; }
        ci0 = ni0; ci1 = ni1; ga0 = nga0; ga1 = nga1; su0 = nsu0; sv0 = nsv0; su1 = nsu1; sv1 = nsv1; m = mn;
    }
}
#ifndef MK_N_LAUNCHES
#define MK_N_LAUNCHES 1
#endif
constexpr int NPH = 21;
#ifndef GEMM_ALIGN
#define GEMM_ALIGN true
#endif
#ifndef GEMM_SP2
#define GEMM_SP2 true
#endif
__host__ __device__ constexpr int rep_of(int k) { return ((PROBE_MASK >> k) & 1) ? PROBE_N : 1; }
constexpr int LDS_BYTES = 163840;
constexpr int LDSCTL_OFF = 155648, MISC_OFF = LDSCTL_OFF + 320;
struct Args { const float* in[23]; float* out; unsigned char* ws; int ph_lo, ph_hi; };


#define CAS __attribute__((address_space(4)))
__device__ __forceinline__ Ctx make_ctx(const CAS Args* ap, LAS unsigned char* lds) {
    Ctx F;
    F.lds = lds;
    { int t_ = threadIdx.x; asm volatile("" : "+v"(t_)); F.tid = t_; } F.lane = F.tid & 63; F.wave = __builtin_amdgcn_readfirstlane(F.tid >> 6);
    F.G = gridDim.x;
    { int bx = blockIdx.x; asm volatile("" : "+s"(bx)); const int vcu = (F.G % 8 == 0) ? (bx % 8) * (F.G / 8) + bx / 8 : bx; F.gw = vcu * NWAVES + F.wave; F.ngw = F.G * NWAVES; }
#define GIN(i) ((const GAS float*)ap->in[i])
    F.x = GIN(0); F.c = GIN(1); F.ctx = GIN(2); F.c_ctx = GIN(3); F.mod_w = GIN(4); F.mod_b = GIN(5); F.norm1_g = GIN(6); F.norm2_g = GIN(7);
    F.ab_w_in = GIN(8); F.ab_w_out = GIN(9); F.na_q_norm = GIN(10); F.na_k_norm = GIN(11); F.na_rpb = GIN(12); F.ret_log_decay = GIN(13);
    F.swa_w_in = GIN(14); F.swa_w_out = GIN(15); F.swa_q_norm = GIN(16); F.swa_k_norm = GIN(17); F.swa_sink = GIN(18);
    F.peer_w_q = GIN(19); F.peer_sub_keys = GIN(20); F.peer_u = GIN(21); F.peer_v = GIN(22);
#undef GIN
    F.out = (GAS float*)ap->out;
    GAS unsigned char* ws = (GAS unsigned char*)ap->ws;
    F.MOD = (GAS float*)(ws + WS_MOD); F.ROPE = (GAS float*)(ws + WS_ROPE); F.SUBK = (GAS bf16*)(ws + WS_SUBK);
    F.WIN0 = (GAS bf16*)(ws + WS_WIN0); F.WOUT0 = (GAS bf16*)(ws + WS_WOUT0); F.WQ0 = (GAS bf16*)(ws + WS_WQ0); F.WIN1 = (GAS bf16*)(ws + WS_WIN1); F.WOUT1 = (GAS bf16*)(ws + WS_WOUT1); F.WQ1 = (GAS bf16*)(ws + WS_WQ1);
    F.U8 = ws + WS_U; F.V8 = ws + WS_V; F.SU = (GAS float*)(ws + WS_SU); F.SV = (GAS float*)(ws + WS_SV); F.XN = (GAS bf16*)(ws + WS_XN); F.XS = (GAS bf16*)(ws + WS_XS); F.P = (GAS bf16*)(ws + WS_P); F.Q2 = (GAS bf16*)(ws + WS_Q2);
    F.IDX = (GAS int*)(ws + WS_IDX); F.GATE = (GAS float*)(ws + WS_GATE); F.TAV = (GAS bf16*)(ws + WS_TAV); F.TBK = (GAS bf16*)(ws + WS_TBK); F.TBV = (GAS bf16*)(ws + WS_TBV);
    F.KV = (GAS float*)(ws + WS_KV); F.ST = (GAS bf16*)(ws + WS_ST);
    return F;
}
#define PHASE_CTX const CAS Args* ap_ = (const CAS Args*)__builtin_amdgcn_kernarg_segment_ptr(); asm volatile("" : "+s"(ap_)); const Ctx F = make_ctx(ap_, (LAS unsigned char*)lds_raw); \
    LAS unsigned char* wl = F.lds + F.wave * 16384; (void)wl;

template <int L> __device__ __forceinline__ void peer_phases(int lo, int hi, unsigned char* lds_raw, const XcdBarrier& bar);

__global__ void __launch_bounds__(NTHR, 2) mk_fwd(Args args) {
    extern __shared__ __attribute__((aligned(16))) unsigned char lds_raw[];
    for (int u = threadIdx.x; u < (LDS_BYTES - LDSCTL_OFF) / 4; u += NTHR) ((LAS unsigned*)((LAS unsigned char*)lds_raw + LDSCTL_OFF))[u] = 0u;
    __syncthreads();
    const int lo = args.ph_lo, hi = args.ph_hi;
    const bool multi = (hi - lo) > 1;
    XcdBarrier bar; bar.bar = (unsigned*)(args.ws + WS_CTL) + CW_BAR; bar.x = 0; bar.st = nullptr;
    if (multi) bar = xcd_barrier_post((unsigned*)(args.ws + WS_CTL) + CW_BAR, (volatile LAS unsigned*)((LAS unsigned char*)lds_raw + MISC_OFF) + 8);
#define IN(k) (lo <= (k) && (k) < hi)
#define SEAM(k) do { if (IN(k) && IN((k) + 1)) { xcd_barrier(bar); if (PROBE_BAR) { xcd_barrier(bar); xcd_barrier(bar); } } } while (0)

    if (IN(0)) for (int rep_ = 0; rep_ < rep_of(0); ++rep_) { PHASE_CTX p0_prologue(F); }
    SEAM(0);
    if (IN(1)) for (int rep_ = 0; rep_ < rep_of(1); ++rep_) { PHASE_CTX mod_phase<false>(F, F.x, F.ctx, MALL, F.norm1_g, F.MOD, 0, 1); }
    SEAM(1);
    if (IN(2)) for (int rep_ = 0; rep_ < rep_of(2); ++rep_) { PHASE_CTX pg8::Gemm g{F.XN, F.WIN0, MALL, AB_IN, DM}; pg8::StaticOrder S; S.init(MALL, AB_IN, F.G, (int)blockIdx.x);
        pg8::EpiBf16<0> E{F.P, AB_IN, nullptr, 0, 0, 1.f};
        pg8::gemm_phase<pg8::EpiBf16<0>, pg8::StaticOrder, GEMM_ALIGN, GEMM_SP2>(F.lds, g, S, E);
        if (rep_ == 0) { int ns; const int sl = idle_slot((MALL / 256) * (AB_IN / 256), F.G, (int)blockIdx.x, ns); if (sl >= 0) side_transposes(F, sl, ns); } }
    SEAM(2);
    if (IN(3)) for (int rep_ = 0; rep_ < rep_of(3); ++rep_) { PHASE_CTX
        for (int it = F.gw; it < 272 * 48; it += F.ngw) {
            const int tt = it / 48, s = it % 48, kind = s >> 3, hd = s & 7;
            PostSlot S;
            S.col = kind * 512 + hd * 64; S.nheads = 8; S.head = hd; S.nw = nullptr; S.rope = 0; S.scale = 1.f; S.tdst = nullptr; S.write_nat = 1;
            if (kind == 0) { S.nw = F.na_q_norm; S.scale = 0.125f; }
            else if (kind == 1) { S.nw = F.na_k_norm; }
            else if (kind == 2) { S.tdst = F.TAV; S.write_nat = 0; }
            else if (kind == 3) { S.rope = 1; S.scale = 0.125f; }
            else if (kind == 4) { S.rope = 1; S.tdst = F.TBK; }
            else { S.tdst = F.TBV; S.write_nat = 0; }
            post_item(F, F.P, AB_IN, tt, S, wl);
        } }
    SEAM(3);
    if (IN(4)) for (int rep_ = 0; rep_ < rep_of(4); ++rep_) { PHASE_CTX
        na_phase(F);
        for (int v = F.gw; v < 2176; v += F.ngw) { const int dir = v & 1, pf = (v >> 1) % 34, bh = (v >> 1) / 34; ret_r1_unit(F, bh, pf, dir); } }
    SEAM(4);
    if (IN(5)) for (int rep_ = 0; rep_ < rep_of(5); ++rep_) { PHASE_CTX ret_r2(F); }
    SEAM(5);
    if (IN(6)) for (int rep_ = 0; rep_ < rep_of(6); ++rep_) { PHASE_CTX ret_r3_phase(F); }
    SEAM(6);
    if (IN(7)) for (int rep_ = 0; rep_ < rep_of(7); ++rep_) { PHASE_CTX pg8::Gemm g{F.XN, F.WOUT0, MALL, DM, DM}; pg8::StaticOrder S; S.init(MALL, DM, F.G, (int)blockIdx.x);
        pg8::EpiRes<false> E{F.x, F.ctx, F.XS, F.MOD + 2 * 1024};
        pg8::gemm_phase<pg8::EpiRes<false>, pg8::StaticOrder, GEMM_ALIGN, GEMM_SP2>(F.lds, g, S, E);
        if (rep_ == 0) side_convert(F, 0); }
    SEAM(7);
    peer_phases<0>(lo, hi, lds_raw, bar);
    SEAM(11);
    if (IN(13)) for (int rep_ = 0; rep_ < rep_of(13); ++rep_) { PHASE_CTX pg8::Gemm g{F.XN, F.WIN1, MALL, SWA_IN, DM}; pg8::StaticOrder S; S.init(MALL, SWA_IN, F.G, (int)blockIdx.x);
        pg8::EpiBf16<0> E{F.P, SWA_IN, nullptr, 0, 0, 1.f};
        pg8::gemm_phase<pg8::EpiBf16<0>, pg8::StaticOrder, GEMM_ALIGN, GEMM_SP2>(F.lds, g, S, E); }
    SEAM(13);
    if (IN(14)) for (int rep_ = 0; rep_ < rep_of(14); ++rep_) { PHASE_CTX
        for (int it = F.gw; it < 272 * 24; it += F.ngw) {
            const int tt = it / 24, s = it % 24;
            PostSlot S;
            S.col = s * 64; S.nheads = 4; S.head = s & 3; S.nw = nullptr; S.rope = 0; S.scale = 1.f; S.tdst = nullptr; S.write_nat = 1;
            if (s < 16) { S.nw = F.swa_q_norm; S.rope = 1; S.scale = 0.125f; }
            else if (s < 20) { S.nw = F.swa_k_norm; S.rope = 1; }
            else { S.tdst = F.TAV; S.write_nat = 0; }
            post_item(F, F.P, SWA_IN, tt, S, wl);
        } }
    SEAM(14);
    if (IN(15)) for (int rep_ = 0; rep_ < rep_of(15); ++rep_) { PHASE_CTX swa_phase(F); }
    SEAM(15);
    if (IN(16)) for (int rep_ = 0; rep_ < rep_of(16); ++rep_) { PHASE_CTX pg8::Gemm g{F.XN, F.WOUT1, MLAT, DM, DM}; pg8::StaticOrder S; S.init(MLAT, DM, F.G, (int)blockIdx.x);
        pg8::EpiRes<true> E{nullptr, nullptr, F.XS, F.MOD + 5 * MODW + 2 * 1024};
        pg8::gemm_phase<pg8::EpiRes<true>, pg8::StaticOrder, GEMM_ALIGN, GEMM_SP2>(F.lds, g, S, E); }
    SEAM(16);
    peer_phases<1>(lo, hi, lds_raw, bar);
}
template <int L> __device__ __forceinline__ void peer_phases(int lo, int hi, unsigned char* lds_raw, const XcdBarrier& bar) {
    constexpr int q0 = L == 0 ? 8 : 17;
    constexpr int Mp = L == 0 ? MALL : MLAT;
    if (IN(q0)) for (int rep_ = 0; rep_ < rep_of(q0); ++rep_) { PHASE_CTX mod_phase<true>(F, nullptr, nullptr, Mp, F.norm2_g + (size_t)L * DM, F.MOD + (size_t)L * 5 * MODW, 3, 4); }
    SEAM(q0);
    if (IN(q0 + 1)) for (int rep_ = 0; rep_ < rep_of(q0 + 1); ++rep_) { PHASE_CTX pg8::Gemm g{F.XN, L == 0 ? F.WQ0 : F.WQ1, Mp, PQD, DM}; pg8::StaticOrder S; S.init(Mp, PQD, F.G, (int)blockIdx.x);
        pg8::EpiBf16<0> E{F.Q2, PQD, nullptr, 0, 0, 1.f};
        pg8::gemm_phase<pg8::EpiBf16<0>, pg8::StaticOrder, GEMM_ALIGN, GEMM_SP2>(F.lds, g, S, E);
        if (L == 0 && rep_ == 0) side_convert(F, 1); }
    SEAM(q0 + 1);
    if (IN(q0 + 2)) for (int rep_ = 0; rep_ < rep_of(q0 + 2); ++rep_) { PHASE_CTX peer_score_phase(F, L, Mp); }
    SEAM(q0 + 2);
    if (IN(q0 + 3)) for (int rep_ = 0; rep_ < rep_of(q0 + 3); ++rep_) { PHASE_CTX
        const GAS float* mod_l = F.MOD + (size_t)L * 5 * MODW;
        const bool part_ = true; const int gw_ = F.gw, ngw_ = F.ngw;
        if (part_) {
        LAS float* wsl = (LAS float*)wl;
        const bool shared4 = (L == 0) && (F.G == 256) && (PROBE_HALF == 0);
        const int Mown = shared4 ? MLAT : Mp;
        const int rm_ = (PROBE_RM && rep_) ? PROBE_RM : -1;
        const bool ns_ = PROBE_RM && rep_;
        for (int mb_ = gw_; mb_ < Mown; mb_ += ((UMFMA == 1) ? 8 : 4096) * ngw_) {
        const int me_ = (UMFMA == 1 && Mown - mb_ > 8 * ngw_) ? mb_ + 8 * ngw_ : Mown;
        { int nt = 0;
          for (int m = mb_; m < me_; m += ngw_, ++nt) { float w0, w1; peer_gather_u_mfma(F, L, (size_t)m, wl, w0, w1);
            wsl[nt * 128 + F.lane] = w0; wsl[nt * 128 + 64 + F.lane] = w1; } }
        LDS_WAIT();
        { int nt = 0;
          for (int m = mb_; m < me_; m += ngw_, ++nt) {
            const int cond = m < MLAT ? (m >> 12) : 4;
            const float w0 = wsl[nt * 128 + F.lane], w1 = wsl[nt * 128 + 64 + F.lane];
            const int vi0 = F.IDX[(size_t)m * 128 + F.lane] & rm_, vi1 = F.IDX[(size_t)m * 128 + 64 + F.lane] & rm_;
            if (L == 0) {
                const GAS float* mod1 = F.MOD + (size_t)5 * MODW + (size_t)cond * MODW;
                peer_gather_v_idx<true>(F, L, (size_t)m, vi0, vi1, w0, w1, mod_l + (size_t)cond * MODW + 5 * 1024, nullptr, F.norm1_g + DM, mod1, mod1 + 1024, ns_);
            } else {
                peer_gather_v_idx<false>(F, L, (size_t)m, vi0, vi1, w0, w1, mod_l + (size_t)cond * MODW + 5 * 1024, F.out + (size_t)m * DM, nullptr, nullptr, nullptr, ns_);
            }
          } }
        LDS_WAIT();
        }
        if (L == 0 && shared4) {
            const int vcu = F.gw >> 3, j = F.wave >> 1, bt = F.wave & 1;
            const size_t m = (size_t)MLAT + (size_t)vcu * 4 + j;
            float acc[32];
            if (bt == 0) { const float w = peer_gather_u_half<0>(F, L, m); peer_gather_v_half<0>(F, L, m, w, acc); }
            else { const float w = peer_gather_u_half<1>(F, L, m); peer_gather_v_half<1>(F, L, m, w, acc); }
            LAS float* xch = (LAS float*)(F.lds + (2 * j + 1) * 16384 + 8192);
            if (bt == 1) {
#pragma unroll
                for (int k = 0; k < 32; ++k) xch[k * 64 + F.lane] = acc[k];
            }
            __syncthreads();
            if (bt == 0) {
#pragma unroll
                for (int k = 0; k < 32; ++k) acc[k] += xch[k * 64 + F.lane];
                const GAS float* mod1 = F.MOD + (size_t)5 * MODW + (size_t)4 * MODW;
                peer_v_finish<true>(F, m, acc, mod_l + (size_t)4 * MODW + 5 * 1024, nullptr, F.norm1_g + DM, mod1, mod1 + 1024);
            }
        }
        }
    }
}
#undef IN
#undef SEAM

extern "C" void kernel_launch(void* const* d_in, const int* in_sizes, int n_in, void* d_out, int out_size, void* d_ws, size_t ws_size, hipStream_t stream) {
    static int grid = 0;
    if (grid == 0) {
        if (n_in != 23 || out_size != MLAT * DM || ws_size < WS_END) { fprintf(stderr, "kernel_launch: unexpected shapes (n_in %d, out %d, ws %zu); nothing launched\n", n_in, out_size, ws_size); grid = -1; return; }
        int dev = 0, cus = 0, per_cu = 0;
        if (hipGetDevice(&dev) != hipSuccess || hipDeviceGetAttribute(&cus, hipDeviceAttributeMultiprocessorCount, dev) != hipSuccess) { grid = -1; return; }
        if (hipFuncSetAttribute((const void*)mk_fwd, hipFuncAttributeMaxDynamicSharedMemorySize, LDS_BYTES) != hipSuccess) { fprintf(stderr, "kernel_launch: hipFuncSetAttribute failed\n"); grid = -1; return; }
        if (hipOccupancyMaxActiveBlocksPerMultiprocessor(&per_cu, (const void*)mk_fwd, NTHR, LDS_BYTES) != hipSuccess || per_cu < 1) { fprintf(stderr, "kernel_launch: occupancy query says %d\n", per_cu); }
        (void)hipGetLastError();
        grid = cus;
    }
    if (grid < 0) return;
    (void)hipMemsetAsync((char*)d_ws + WS_CTL, 0, CTL_ZERO_BYTES, stream);
    Args a{};
    for (int i = 0; i < 23; ++i) a.in[i] = (const float*)d_in[i];
    a.out = (float*)d_out; a.ws = (unsigned char*)d_ws;
#if MK_N_LAUNCHES == 1
    a.ph_lo = 0; a.ph_hi = NPH;
    hipLaunchKernelGGL(mk_fwd, dim3(grid), dim3(NTHR), LDS_BYTES, stream, a);
#else
    for (int p = 0; p < NPH; ++p) { a.ph_lo = p; a.ph_hi = p + 1; hipLaunchKernelGGL(mk_fwd, dim3(grid), dim3(NTHR), LDS_BYTES, stream, a); }
#endif
}
```

```cpp
#define MK_N_LAUNCHES 1
#define PROBE_MASK 0
#define PROBE_N 1
#define PROBE_HALF 0
#define PROBE_BAR 0
#define USLICE 0
#define USORT 0
#define UMFMA 1
#define VF16 2
#define PROBE_UW 0
#define SCPF 0
#define SC2 0
#define PROBE_VH 0
#define PROBE_RM 0
#define GEMM_ALIGN true
#define GEMM_SP2 true
#include <hip/hip_runtime.h>
#include <cstdio>
#include <cstdint>
namespace pg8 {
#define PG8_LAS __attribute__((address_space(3)))
#ifndef GAS
#define GAS __attribute__((address_space(1)))
#endif
typedef unsigned short bf16_t;
typedef short bf16x8 __attribute__((ext_vector_type(8)));
typedef float f32x4 __attribute__((ext_vector_type(4)));
typedef unsigned u32x4 __attribute__((ext_vector_type(4)));
constexpr int BM = 256, BK = 64, HALF = 128, HTB = HALF * BK * 2  , STAGE_BYTES = 8 * HTB, NXCD = 8, WGM = 8;

__host__ __device__ __forceinline__ int lds_byte(int r, int c) { const int st = (r >> 4) * 2 + (c >> 5), rr = r & 15, cc = c & 31, ob = rr * 64 + cc * 2; return st * 1024 + (ob ^ (((ob >> 9) & 1) << 5)); }
__host__ __device__ __forceinline__ void stage_rc(int b, int& R, int& C) { const int st = b / 1024, sb = b % 1024, swz = sb ^ (((sb >> 9) & 1) << 5); R = (st >> 1) * 16 + swz / 64; C = (st & 1) * 32 + (swz % 64) / 2; }
__host__ __device__ __forceinline__ int perm32(int rho) { const int n = rho >> 4, i = rho & 15; return 8 * (i >> 2) + 4 * n + (i & 3); }

struct Unit { int pm, pn; };
struct Gemm { const GAS bf16_t* A; const GAS bf16_t* Bt; int M, N, K; };

struct StaticOrder {
    int nM, nN, nwg, G, c;
    __host__ __device__ void init(int M, int N, int G_, int c_) { nM = M / BM; nN = N / BM; nwg = nM * nN; G = G_; c = c_; }
    __host__ __device__ bool next(int i, Unit& u) const {
        const long L = (long)i * G + c; if (L >= nwg) return false;
        int wgid = (int)L; { const int q = nwg / NXCD, r = nwg % NXCD, xcd = wgid % NXCD, off = wgid / NXCD; wgid = (xcd < r ? xcd * (q + 1) : r * (q + 1) + (xcd - r) * q) + off; }
        const int nig = WGM * nN, gid = wgid / nig, fm = gid * WGM, gsz = (nM - fm) < WGM ? (nM - fm) : WGM;
        u.pm = fm + ((wgid % nig) % gsz); u.pn = (wgid % nig) / gsz; return true;
    }
    __device__ __forceinline__ void a_ready(const Unit&) const {}
    __device__ __forceinline__ void done(const Unit&) const {}
};

__device__ __forceinline__ unsigned cvt_pk_bf16(float lo, float hi) { unsigned r; asm volatile("v_cvt_pk_bf16_f32 %0, %1, %2" : "=v"(r) : "v"(lo), "v"(hi)); return r; }
typedef float f32x2 __attribute__((ext_vector_type(2)));
__device__ __forceinline__ f32x2 gelu_pk(f32x2 v) {
    const f32x2 av = __builtin_elementwise_abs(v), d = av * 0.2316418882f + 1.0f;
    f32x2 t; t.x = __builtin_amdgcn_rcpf(d.x); t.y = __builtin_amdgcn_rcpf(d.y);
    f32x2 q = t * 0.5307027145f + (-0.7265760135f); q = q * t + 0.7107068705f; q = q * t + (-0.142248368f); q = q * t + 0.127414796f; q = q * t;
    const f32x2 s = (v * v) * (-0.72134752044f);
    f32x2 e; e.x = __builtin_amdgcn_exp2f(s.x); e.y = __builtin_amdgcn_exp2f(s.y);
    const f32x2 m = v * (q * e), r = v - m;
    f32x2 o; o.x = v.x < 0.f ? m.x : r.x; o.y = v.y < 0.f ? m.y : r.y; return o;
}

template <int ACT  > struct EpiBf16 {
    static constexpr bool PERM = true, AFTER_DRAIN = false; static_assert(ACT == 0 || ACT == 1, "EpiBf16: ACT is 0 (none) or 1 (gelu_pk)");
    GAS bf16_t* O; int ldc; const GAS float* bias; int split_cols; size_t split_stride; float scale0;
    __device__ __forceinline__ void operator()(const f32x4 (&acc)[2][2][4][2], const Unit& u, int wr, int wc, int fr, int fq) const {
        const int row0 = u.pm * BM + wr * 64 + fr; int colt = u.pn * BM; GAS bf16_t* base = O;
        float sc = 1.f; if (split_cols) { const int t = colt / split_cols; base += (size_t)t * split_stride; colt -= t * split_cols; if (t == 0) sc = scale0; }
        const int col0 = colt + wc * 32 + 8 * fq, bcol0 = u.pn * BM + wc * 32 + 8 * fq;
        f32x4 bv[2][2];
#pragma unroll
        for (int bj = 0; bj < 2; ++bj)
#pragma unroll
            for (int n = 0; n < 2; ++n) bv[bj][n] = bias ? *(const GAS f32x4*)(bias + bcol0 + bj * HALF + 4 * n) : (f32x4){0.f, 0.f, 0.f, 0.f};
#pragma unroll
        for (int ai = 0; ai < 2; ++ai)
#pragma unroll
            for (int m = 0; m < 4; ++m) { GAS bf16_t* rowp = base + (size_t)(row0 + ai * HALF + m * 16) * ldc + col0;
#pragma unroll
                for (int bj = 0; bj < 2; ++bj) { f32x4 v0 = acc[ai][bj][m][0] + bv[bj][0], v1 = acc[ai][bj][m][1] + bv[bj][1];
                    if (ACT == 1) { f32x2 a = gelu_pk((f32x2){v0[0], v0[1]}), b = gelu_pk((f32x2){v0[2], v0[3]}), c = gelu_pk((f32x2){v1[0], v1[1]}), d = gelu_pk((f32x2){v1[2], v1[3]});
                        v0 = (f32x4){a.x, a.y, b.x, b.y}; v1 = (f32x4){c.x, c.y, d.x, d.y}; }
                    v0 = v0 * sc; v1 = v1 * sc; u32x4 w; w.x = cvt_pk_bf16(v0[0], v0[1]); w.y = cvt_pk_bf16(v0[2], v0[3]); w.z = cvt_pk_bf16(v1[0], v1[1]); w.w = cvt_pk_bf16(v1[2], v1[3]);
                    *(GAS u32x4*)(rowp + bj * HALF) = w; } }
    }
};

template <bool BASEB> struct EpiRes {
    static constexpr bool PERM = false, AFTER_DRAIN = false;
    const GAS float* base_lat; const GAS float* base_ctx; GAS bf16_t* xs; const GAS float* gate;
    __device__ __forceinline__ void operator()(const f32x4 (&acc)[2][2][4][2], const Unit& u, int wr, int wc, int fr, int fq) const {
        typedef unsigned u32x2e __attribute__((ext_vector_type(2)));
        const int rowt = u.pm * BM;
        const int cond = rowt < 16384 ? (rowt >> 12) : 4;
        const GAS float* g = gate + (size_t)cond * 6144;
        const int col0 = u.pn * BM + wc * 32 + 4 * fq;
        f32x4 gv[2][2];
#pragma unroll
        for (int bj = 0; bj < 2; ++bj)
#pragma unroll
            for (int n = 0; n < 2; ++n) gv[bj][n] = *(const GAS f32x4*)(g + col0 + bj * HALF + n * 16);
#pragma unroll
        for (int ai = 0; ai < 2; ++ai)
#pragma unroll
            for (int m = 0; m < 4; ++m) {
                const int r = rowt + ai * HALF + wr * 64 + m * 16 + fr;
                const GAS float* bp = r < 16384 ? base_lat + (size_t)r * 1024 : base_ctx + (size_t)(r - 16384) * 1024;
                GAS bf16_t* op = xs + (size_t)r * 1024;
#pragma unroll
                for (int bj = 0; bj < 2; ++bj)
#pragma unroll
                    for (int n = 0; n < 2; ++n) {
                        const int off = col0 + bj * HALF + n * 16;
                        f32x4 bs;
                        if (BASEB) { const u32x2e w = *(const GAS u32x2e*)(op + off); bs = (f32x4){__uint_as_float(w.x << 16), __uint_as_float(w.x & 0xffff0000u), __uint_as_float(w.y << 16), __uint_as_float(w.y & 0xffff0000u)}; }
                        else bs = *(const GAS f32x4*)(bp + off);
                        const f32x4 o = bs + gv[bj][n] * acc[ai][bj][m][n];
                        u32x2e w; w.x = cvt_pk_bf16(o[0], o[1]); w.y = cvt_pk_bf16(o[2], o[3]);
                        *(GAS u32x2e*)(op + off) = w;
                    }
            }
    }
};

template <class Epi, class Sched, bool ALIGN_EPI = false, bool SP2 = false>
__device__ __forceinline__ void gemm_phase(PG8_LAS unsigned char* lds, const Gemm g, const Sched& S, const Epi& E) {
    const int tid = threadIdx.x, wid = __builtin_amdgcn_readfirstlane(tid >> 6), lane = tid & 63, wr = wid >> 2, wc = wid & 3, fr = lane & 15, fq = lane >> 4;
    const int K = g.K, nt = K / BK;
    unsigned voffA[2], voffB[2];
#pragma unroll
    for (int i = 0; i < 2; ++i) { int R, C; stage_rc(tid * 16 + i * 8192, R, C); const int Rb = Epi::PERM ? ((R & ~31) + perm32(R & 31)) : R;
        voffA[i] = (unsigned)(R * K + C) * 2u; voffB[i] = (unsigned)(Rb * K + C) * 2u; }
    const size_t kstep = (size_t)(BK * 2);
    const size_t hstep = (size_t)HALF * K * 2;
    const size_t tstep = 2 * hstep;
    const unsigned ldsw = (unsigned)wid * 1024u;
    const int aoff = lds_byte(wr * 64 + fr, fq * 8), boff = lds_byte(wc * 32 + fr, fq * 8);
#define PG8_SA(b, h) (((b) * 2 + (h)) * HTB)
#define PG8_SB(b, h) ((4 + (b) * 2 + (h)) * HTB)
#define PG8_STAGE(bufoff, gbase, voff) do { _Pragma("unroll") for (int _i = 0; _i < 2; ++_i) \
        __builtin_amdgcn_global_load_lds((const unsigned*)((const char*)(gbase) + (voff)[_i]), (PG8_LAS unsigned*)(lds + (bufoff) + ldsw + _i * 8192), 16, 0, 0); } while (0)
#define PG8_LDA(dst, b, h) do { _Pragma("unroll") for (int m = 0; m < 4; ++m) _Pragma("unroll") for (int k = 0; k < 2; ++k) dst[m][k] = *(const PG8_LAS bf16x8*)(lds + PG8_SA(b, h) + aoff + m * 2048 + k * 1024); } while (0)
#define PG8_LDB(dst, b, h) do { _Pragma("unroll") for (int n = 0; n < 2; ++n) _Pragma("unroll") for (int k = 0; k < 2; ++k) dst[n][k] = *(const PG8_LAS bf16x8*)(lds + PG8_SB(b, h) + boff + n * 2048 + k * 1024); } while (0)
#define PG8_MMA(ai, bj, At, Bt) do { __builtin_amdgcn_s_setprio(1); _Pragma("unroll") for (int m = 0; m < 4; ++m) _Pragma("unroll") for (int n = 0; n < 2; ++n) _Pragma("unroll") for (int k = 0; k < 2; ++k) \
        acc[ai][bj][m][n] = __builtin_amdgcn_mfma_f32_16x16x32_bf16(Bt[n][k], At[m][k], acc[ai][bj][m][n], 0, 0, 0); __builtin_amdgcn_s_setprio(0); } while (0)
#define PG8_WAIT_V(n) asm volatile("s_waitcnt vmcnt(" #n ")" ::: "memory")
#define PG8_WAIT_L(n) asm volatile("s_waitcnt lgkmcnt(" #n ")" ::: "memory")
#define PG8_BAR __builtin_amdgcn_s_barrier()
#define PG8_SCHED __builtin_amdgcn_sched_barrier(0)
    Unit cur, nxt; int ui = 0;
    if (!S.next(0, cur)) return;
    f32x4 acc[2][2][4][2];
#pragma unroll
    for (int a = 0; a < 2; ++a)
#pragma unroll
        for (int b = 0; b < 2; ++b)
#pragma unroll
            for (int m = 0; m < 4; ++m)
#pragma unroll
                for (int n = 0; n < 2; ++n) acc[a][b][m][n] = (f32x4){0.f, 0.f, 0.f, 0.f};
    bf16x8 At[4][2], B0[2][2], B1[2][2];
    const char* cA = (const char*)g.A + (size_t)cur.pm * tstep; const char* cB = (const char*)g.Bt + (size_t)cur.pn * tstep;
    S.a_ready(cur);
    if constexpr (SP2) {
        PG8_STAGE(PG8_SB(0, 0), cB, voffB); PG8_STAGE(PG8_SB(0, 1), cB + hstep, voffB); PG8_STAGE(PG8_SA(0, 0), cA, voffA); PG8_STAGE(PG8_SA(0, 1), cA + hstep, voffA);
        if (wr == 1) PG8_BAR;
        PG8_WAIT_V(2); PG8_BAR;
        PG8_STAGE(PG8_SB(1, 0), cB + kstep, voffB); PG8_STAGE(PG8_SA(1, 0), cA + kstep, voffA); PG8_STAGE(PG8_SB(1, 1), cB + hstep + kstep, voffB);
        PG8_WAIT_V(6); PG8_BAR;
    } else {
        PG8_STAGE(PG8_SB(0, 0), cB, voffB); PG8_STAGE(PG8_SA(0, 0), cA, voffA); PG8_STAGE(PG8_SB(0, 1), cB + hstep, voffB); PG8_STAGE(PG8_SA(0, 1), cA + hstep, voffA);
        if (wr == 1) PG8_BAR;
        PG8_WAIT_V(4); PG8_BAR;
        PG8_STAGE(PG8_SB(1, 0), cB + kstep, voffB); PG8_STAGE(PG8_SA(1, 0), cA + kstep, voffA); PG8_STAGE(PG8_SB(1, 1), cB + hstep + kstep, voffB);
        PG8_WAIT_V(6); PG8_BAR;
    }
    for (;;) {
        const bool has_next = S.next(ui + 1, nxt);
        const char* nA = has_next ? (const char*)g.A + (size_t)nxt.pm * tstep : cA; const char* nB = has_next ? (const char*)g.Bt + (size_t)nxt.pn * tstep : cB;
        for (int t = 0; t < nt; t += 2) {
            const bool last = (t == nt - 2);
            const char* a1 = cA + (size_t)(t + 1) * kstep;
            const char* a2 = last ? nA : cA + (size_t)(t + 2) * kstep; const char* b2 = last ? nB : cB + (size_t)(t + 2) * kstep;
            const char* a3 = a2 + kstep; const char* b3 = b2 + kstep;
            if (last && has_next) S.a_ready(nxt);
            if constexpr (SP2) {
            PG8_LDB(B0, 0, 0); PG8_LDB(B1, 0, 1); PG8_SCHED; PG8_LDA(At, 0, 0); PG8_STAGE(PG8_SA(1, 1), a1 + hstep, voffA);
            PG8_WAIT_V(8); PG8_WAIT_L(0); PG8_BAR; PG8_MMA(0, 0, At, B0); PG8_MMA(0, 1, At, B1); PG8_BAR; PG8_SCHED;
            PG8_LDA(At, 0, 1); PG8_STAGE(PG8_SB(0, 0), b2, voffB); PG8_STAGE(PG8_SB(0, 1), b2 + hstep, voffB); PG8_STAGE(PG8_SA(0, 0), a2, voffA);
            PG8_WAIT_V(8); PG8_WAIT_L(0); PG8_BAR; PG8_MMA(1, 0, At, B0); PG8_MMA(1, 1, At, B1); PG8_BAR; PG8_SCHED;
            PG8_LDB(B0, 1, 0); PG8_LDB(B1, 1, 1); PG8_SCHED; PG8_LDA(At, 1, 0); PG8_STAGE(PG8_SA(0, 1), a2 + hstep, voffA);
            PG8_WAIT_V(8); PG8_WAIT_L(0); PG8_BAR; PG8_MMA(0, 0, At, B0); PG8_MMA(0, 1, At, B1); PG8_BAR; PG8_SCHED;
            PG8_LDA(At, 1, 1); PG8_STAGE(PG8_SB(1, 0), b3, voffB); PG8_STAGE(PG8_SB(1, 1), b3 + hstep, voffB); PG8_STAGE(PG8_SA(1, 0), a3, voffA);
            PG8_WAIT_V(8); PG8_WAIT_L(0); PG8_BAR; PG8_MMA(1, 0, At, B0); PG8_MMA(1, 1, At, B1); PG8_BAR; PG8_SCHED;
            } else {
            PG8_LDB(B0, 0, 0); PG8_SCHED; PG8_LDA(At, 0, 0); PG8_STAGE(PG8_SA(1, 1), a1 + hstep, voffA);
            PG8_WAIT_L(8); PG8_BAR; PG8_WAIT_L(0); PG8_MMA(0, 0, At, B0); PG8_BAR; PG8_SCHED;
            PG8_LDB(B1, 0, 1); PG8_STAGE(PG8_SB(0, 0), b2, voffB);
            PG8_BAR; PG8_WAIT_L(0); PG8_MMA(0, 1, At, B1); PG8_BAR;
            PG8_LDA(At, 0, 1); PG8_STAGE(PG8_SA(0, 0), a2, voffA);
            PG8_BAR; PG8_WAIT_L(0); PG8_MMA(1, 0, At, B0); PG8_BAR; PG8_SCHED;
            PG8_STAGE(PG8_SB(0, 1), b2 + hstep, voffB);
            PG8_WAIT_V(6); PG8_BAR; PG8_MMA(1, 1, At, B1); PG8_BAR;
            PG8_LDB(B0, 1, 0); PG8_SCHED; PG8_LDA(At, 1, 0); PG8_STAGE(PG8_SA(0, 1), a2 + hstep, voffA);
            PG8_WAIT_L(8); PG8_BAR; PG8_WAIT_L(0); PG8_MMA(0, 0, At, B0); PG8_BAR; PG8_SCHED;
            PG8_LDB(B1, 1, 1); PG8_STAGE(PG8_SB(1, 0), b3, voffB);
            PG8_BAR; PG8_WAIT_L(0); PG8_MMA(0, 1, At, B1); PG8_BAR;
            PG8_LDA(At, 1, 1); PG8_STAGE(PG8_SA(1, 0), a3, voffA);
            PG8_BAR; PG8_WAIT_L(0); PG8_MMA(1, 0, At, B0); PG8_BAR; PG8_SCHED;
            PG8_STAGE(PG8_SB(1, 1), b3 + hstep, voffB);
            PG8_WAIT_V(6); PG8_BAR; PG8_MMA(1, 1, At, B1); PG8_BAR;
            }
        }
        if constexpr (ALIGN_EPI) { if (wr == 0) PG8_BAR; }
        if constexpr (!Epi::AFTER_DRAIN) { E(acc, cur, wr, wc, fr, fq); S.done(cur); }
        if (!has_next) break;
#pragma unroll
        for (int a = 0; a < 2; ++a)
#pragma unroll
            for (int b = 0; b < 2; ++b)
#pragma unroll
                for (int m = 0; m < 4; ++m)
#pragma unroll
                    for (int n = 0; n < 2; ++n) acc[a][b][m][n] = (f32x4){0.f, 0.f, 0.f, 0.f};
        cur = nxt; cA = nA; cB = nB; ++ui;
        if constexpr (ALIGN_EPI) { if (wr == 1) PG8_BAR; }
    }
    PG8_WAIT_V(0);
    if constexpr (!ALIGN_EPI) { if (wr == 0) PG8_BAR; }
    PG8_BAR;
    if constexpr (Epi::AFTER_DRAIN) { E.fused(acc, cur, wr, wc, fr, fq, lds, wid, lane); S.done(cur); }
#undef PG8_SA
#undef PG8_SB
#undef PG8_STAGE
#undef PG8_LDA
#undef PG8_LDB
#undef PG8_MMA
#undef PG8_WAIT_V
#undef PG8_WAIT_L
#undef PG8_BAR
#undef PG8_SCHED
}
}
#define GAS __attribute__((address_space(1)))
#define LAS __attribute__((address_space(3)))
typedef unsigned short bf16;
typedef unsigned v4u __attribute__((ext_vector_type(4)));
typedef float f32x4 __attribute__((ext_vector_type(4)));
typedef short bf16x8 __attribute__((ext_vector_type(8)));
typedef GAS unsigned gu32;
typedef GAS unsigned long long gu64;
#define RLX_AGENT __ATOMIC_RELAXED, __HIP_MEMORY_SCOPE_AGENT
#define LDS_WAIT() asm volatile("s_waitcnt lgkmcnt(0)" ::: "memory")
#define VM_WAIT() asm volatile("s_waitcnt vmcnt(0)" ::: "memory")
__device__ __forceinline__ unsigned long long rt() { return __builtin_amdgcn_s_memrealtime(); }
__device__ __forceinline__ unsigned f2bf(float f) { unsigned u = __builtin_bit_cast(unsigned, f); return (u + 0x7fffu + ((u >> 16) & 1u)) >> 16; }
typedef float pk2_f2_t __attribute__((ext_vector_type(2))); typedef __bf16 pk2_b2_t __attribute__((ext_vector_type(2)));
__device__ __forceinline__ unsigned pk2(float lo, float hi) { pk2_f2_t v = {lo, hi}; return __builtin_bit_cast(unsigned, __builtin_convertvector(v, pk2_b2_t)); }

#define XB_TMO      128
#define XB_XCNT(j)  (256  + 64 * (j))
#define XB_XSUB(j)  (1280 + 64 * (j))
#define XB_XGEN(j)  (2304 + 64 * (j))
#define XB_TOP      3328
#define XB_TOPGEN   3392
#define XCD_BAR_WORDS 3456
#define XB_SPIN_CAP (1u << 18)

__device__ __forceinline__ unsigned xb_ld(unsigned* p)              { return __hip_atomic_load(p, __ATOMIC_RELAXED, __HIP_MEMORY_SCOPE_AGENT); }
__device__ __forceinline__ unsigned xb_add(unsigned* p, unsigned v) { return __hip_atomic_fetch_add(p, v, __ATOMIC_RELAXED, __HIP_MEMORY_SCOPE_AGENT); }
__device__ __forceinline__ unsigned xb_xcc_id() { return (unsigned)__builtin_amdgcn_s_getreg((3 << 11) | 20) & 0xFu; }
#define XB_SPIN(cond, bar) do { unsigned _sp = 0; while (cond) { __builtin_amdgcn_s_sleep(1); \
    if ((++_sp & 255u) == 0u) { if (xb_ld(&(bar)[XB_TMO])) break; if (_sp > XB_SPIN_CAP) { atomicAdd(&(bar)[XB_TMO], 1u); break; } } } } while (0)

struct XcdBarrier {
    unsigned* bar; unsigned x;
    volatile LAS unsigned* st;
};

__device__ __forceinline__ XcdBarrier xcd_barrier_post(unsigned* bar, volatile LAS unsigned* st) {
    XcdBarrier b; b.bar = bar; b.x = xb_xcc_id(); b.st = st;
    if (threadIdx.x == 0) (void)xb_add(&bar[XB_XCNT(b.x)], 1u);
    return b;
}
__device__ __forceinline__ void xcd_barrier_complete(unsigned* bar, unsigned x, unsigned& nloc, unsigned& nx) {
    const unsigned G = gridDim.x * gridDim.y * gridDim.z;
    unsigned sum, cnt, mine, sp = 0u;
    for (;;) {
        sum = 0u; cnt = 0u; mine = 0u;
#pragma unroll
        for (unsigned j = 0; j < 16; ++j) { const unsigned c = xb_ld(&bar[XB_XCNT(j)]); sum += c; cnt += (c > 0u) ? 1u : 0u; mine = (j == x) ? c : mine; }
        if (sum == G) break;
        __builtin_amdgcn_s_sleep(1);
        if ((++sp & 255u) == 0u) { if (xb_ld(&bar[XB_TMO])) break; if (sp > XB_SPIN_CAP) { atomicAdd(&bar[XB_TMO], 1u); break; } }
    }
    nloc = mine > 0u ? mine : 1u; nx = cnt > 0u ? cnt : 1u;
}

__device__ __forceinline__ void xcd_barrier(const XcdBarrier& b) {
    asm volatile("s_waitcnt vmcnt(0)" ::: "memory");
    __syncthreads();
    if (threadIdx.x == 0) {
        unsigned* bar = b.bar;
        __builtin_amdgcn_s_waitcnt(0);
        unsigned nloc = b.st[0], nx = b.st[1];
        if (nloc == 0u) { xcd_barrier_complete(bar, b.x, nloc, nx); b.st[0] = nloc; b.st[1] = nx; }
        const unsigned old = xb_add(&bar[XB_XSUB(b.x)], 1u);
        const unsigned gen = old / nloc;
        if (old + 1u == (gen + 1u) * nloc) {
            __builtin_amdgcn_fence(__ATOMIC_RELEASE, "agent");
            asm volatile("s_waitcnt vmcnt(0)" ::: "memory");
            const unsigned og = xb_add(&bar[XB_TOP], 1u);
            const unsigned tg = og / nx;
            if (og + 1u == (tg + 1u) * nx) xb_add(&bar[XB_TOPGEN], 1u);
            else XB_SPIN(xb_ld(&bar[XB_TOPGEN]) == tg, bar);
            __builtin_amdgcn_fence(__ATOMIC_ACQUIRE, "agent");
            xb_add(&bar[XB_XGEN(b.x)], 1u);
            asm volatile("s_waitcnt vmcnt(0)" ::: "memory");
        } else {
            XB_SPIN(xb_ld(&bar[XB_XGEN(b.x)]) == gen, bar);
            __builtin_amdgcn_fence(__ATOMIC_ACQUIRE, "agent");
            asm volatile("s_waitcnt vmcnt(0)" ::: "memory");
        }
    }
    __syncthreads();
}
constexpr int NWAVES = 8, NTHR = 512;
constexpr int DM = 1024, NBATCH = 4, SEQ = 4096, CL = 256;
constexpr int MLAT = NBATCH * SEQ, MCTX = NBATCH * CL, MALL = MLAT + MCTX;
constexpr int AB_IN = 3584, SWA_IN = 1536, PQD = 2048, MODW = 6144;
constexpr size_t MiB = 1u << 20;
#ifndef U_FP4
#define U_FP4 1
#endif
#ifndef V_FP4
#define V_FP4 1
#endif
constexpr int U_ROWB = U_FP4 ? 512 : 768, V_ROWB = V_FP4 ? 512 : 768;
constexpr size_t WS_CTL = 0, CTL_ZERO_BYTES = 1 * MiB;
constexpr size_t WS_MOD = 1 * MiB;
constexpr size_t WS_ROPE = 1 * MiB + 512 * 1024;
constexpr size_t WS_SU = 1 * MiB + 640 * 1024, WS_SV = 1 * MiB + 768 * 1024;
constexpr size_t WS_SUBK = 2 * MiB;
constexpr size_t WS_WIN0 = 4 * MiB, WS_WOUT0 = 11 * MiB, WS_WQ0 = 13 * MiB, WS_WIN1 = 17 * MiB, WS_WOUT1 = 20 * MiB, WS_WQ1 = 22 * MiB;
constexpr size_t WS_U = 32 * MiB, WS_V = 96 * MiB;
constexpr size_t WS_XN = 160 * MiB;
constexpr size_t WS_XS = 194 * MiB;
constexpr size_t WS_P = 262 * MiB;
constexpr size_t WS_Q2 = 262 * MiB;
constexpr size_t WS_IDX = 330 * MiB, WS_GATE = 339 * MiB;
constexpr size_t WS_TAV = 381 * MiB, WS_TBK = 398 * MiB, WS_TBV = 415 * MiB;
constexpr size_t WS_KV = 432 * MiB;
constexpr size_t WS_ST = 466 * MiB;
constexpr size_t WS_END = 483 * MiB;
constexpr int CW_BAR = 4096;

typedef unsigned v2u __attribute__((ext_vector_type(2)));
typedef __bf16 bf16x2_t __attribute__((ext_vector_type(2)));
__device__ __forceinline__ float bflo(unsigned u) { return __uint_as_float(u << 16); }
__device__ __forceinline__ float bfhi(unsigned u) { return __uint_as_float(u & 0xffff0000u); }
__device__ __forceinline__ float bf1(bf16 u) { return __uint_as_float((unsigned)u << 16); }
__device__ __forceinline__ v4u ld16(const GAS bf16* p) { return *(const GAS v4u*)p; }
__device__ __forceinline__ bf16x8 ldfrag(const GAS bf16* p) { return __builtin_bit_cast(bf16x8, *(const GAS v4u*)p); }
__device__ __forceinline__ f32x4 mfma16(bf16x8 a, bf16x8 b, f32x4 c) { return __builtin_amdgcn_mfma_f32_16x16x32_bf16(a, b, c, 0, 0, 0); }
__device__ __forceinline__ float wave_sum(float v) {
#pragma unroll
    for (int o = 1; o < 64; o <<= 1) v += __shfl_xor(v, o);
    return v;
}
__device__ __forceinline__ float fexp2(float x) { return __builtin_amdgcn_exp2f(x); }
__device__ __forceinline__ float fexp(float x) { return __builtin_amdgcn_exp2f(x * 1.4426950408889634f); }
__device__ __forceinline__ bf16x8 pack8(const f32x4& a, const f32x4& b) {
    v4u w; w.x = pk2(a[0], a[1]); w.y = pk2(a[2], a[3]); w.z = pk2(b[0], b[1]); w.w = pk2(b[2], b[3]);
    return __builtin_bit_cast(bf16x8, w);
}
__device__ __forceinline__ float dot2bf(unsigned a, unsigned b, float acc) {
    return __builtin_amdgcn_fdot2_f32_bf16(__builtin_bit_cast(bf16x2_t, a), __builtin_bit_cast(bf16x2_t, b), acc, false);
}
__device__ __forceinline__ float gelu_erf(float v) {
    const float av = fabsf(v), d = av * 0.2316418882f + 1.0f;
    const float t = __builtin_amdgcn_rcpf(d);
    float q = t * 0.5307027145f + (-0.7265760135f); q = q * t + 0.7107068705f; q = q * t + (-0.142248368f); q = q * t + 0.127414796f; q = q * t;
    const float e = __builtin_amdgcn_exp2f((v * v) * (-0.72134752044f));
    const float m = v * (q * e), r = v - m;
    return v < 0.f ? m : r;
}

struct Ctx {
    LAS unsigned char* lds;
    int tid, lane, wave, gw, ngw, G;
    const GAS float *x, *c, *ctx, *c_ctx, *mod_w, *mod_b, *norm1_g, *norm2_g, *ab_w_in, *ab_w_out, *na_q_norm, *na_k_norm, *na_rpb, *ret_log_decay,
                *swa_w_in, *swa_w_out, *swa_q_norm, *swa_k_norm, *swa_sink, *peer_w_q, *peer_sub_keys, *peer_u, *peer_v;
    GAS float* out;
    GAS float* MOD; GAS float* ROPE; GAS bf16* SUBK; GAS bf16 *WIN0, *WOUT0, *WQ0, *WIN1, *WOUT1, *WQ1; GAS unsigned char *U8, *V8; GAS float *SU, *SV; GAS bf16* XN; GAS bf16* XS; GAS bf16* P; GAS bf16* Q2;
    GAS int* IDX; GAS float* GATE; GAS bf16 *TAV, *TBK, *TBV; GAS float* KV; GAS bf16* ST;
};

__device__ __forceinline__ void p0_transpose_item(const GAS float* W, int K, int N, GAS bf16* WT, LAS float* scr, int item, int lane) {
    const int nblk = N / 32, kb = item / nblk, nb = item % nblk, k0 = 64 * kb, n0 = 32 * nb;
#pragma unroll 8
    for (int i = 0; i < 32; ++i) { const int kk = 2 * i + (lane >> 5); scr[kk * 33 + (lane & 31)] = W[(size_t)(k0 + kk) * N + n0 + (lane & 31)]; }
    LDS_WAIT(); asm volatile("" ::: "memory");
    const int c = lane & 7;
#pragma unroll
    for (int j = 0; j < 4; ++j) { const int n = (lane >> 3) + 8 * j; const LAS float* s = scr + (8 * c) * 33 + n;
        v4u o; o.x = pk2(s[0 * 33], s[1 * 33]); o.y = pk2(s[2 * 33], s[3 * 33]); o.z = pk2(s[4 * 33], s[5 * 33]); o.w = pk2(s[6 * 33], s[7 * 33]);
        *(GAS v4u*)(WT + (size_t)(n0 + n) * K + k0 + 8 * c) = o; }
    LDS_WAIT(); asm volatile("" ::: "memory");
}
__device__ __forceinline__ void p0_convert(const Ctx& F, const GAS float* src, GAS bf16* dst, size_t n8) {
    const size_t gt = (size_t)F.gw * 64 + F.lane, NT = (size_t)F.ngw * 64;
    for (size_t i = gt; i < n8; i += NT) {
        const f32x4 a = *(const GAS f32x4*)(src + i * 8), b = *(const GAS f32x4*)(src + i * 8 + 4);
        v4u o; o.x = pk2(a[0], a[1]); o.y = pk2(a[2], a[3]); o.z = pk2(b[0], b[1]); o.w = pk2(b[2], b[3]);
        *(GAS v4u*)(dst + i * 8) = o;
    }
}

#ifndef FP6_PACK_INTERLEAVED
#define FP6_PACK_INTERLEAVED 1
#endif
typedef float f32x16v __attribute__((ext_vector_type(16)));
typedef float f32x32v __attribute__((ext_vector_type(32)));
typedef unsigned u32x6v __attribute__((ext_vector_type(6)));
__device__ __forceinline__ void convert_fp6_rows(const Ctx& F, int rbeg, int rend) {
    const int q = F.lane & 31, hf = F.lane >> 5;
    for (int R0 = rbeg + F.wave * 2; R0 < rend; R0 += NWAVES * 2) {
        const int R = R0 + hf;
        if (R >= rend) continue;
        const bool isv = R >= 32768; const int r = R & 32767;
        const GAS float* xr = (isv ? F.peer_v : F.peer_u) + (size_t)r * 1024 + 32 * q;
        f32x16v a, b; float am = 0.f;
#pragma unroll
        for (int j = 0; j < 4; ++j) { const f32x4 v = *(const GAS f32x4*)(xr + 4 * j); a[4 * j] = v[0]; a[4 * j + 1] = v[1]; a[4 * j + 2] = v[2]; a[4 * j + 3] = v[3];
            am = fmaxf(fmaxf(fmaxf(fabsf(v[0]), fabsf(v[1])), fmaxf(fabsf(v[2]), fabsf(v[3]))), am); }
#pragma unroll
        for (int j = 0; j < 4; ++j) { const f32x4 v = *(const GAS f32x4*)(xr + 16 + 4 * j); b[4 * j] = v[0]; b[4 * j + 1] = v[1]; b[4 * j + 2] = v[2]; b[4 * j + 3] = v[3];
            am = fmaxf(fmaxf(fmaxf(fabsf(v[0]), fabsf(v[1])), fmaxf(fabsf(v[2]), fabsf(v[3]))), am); }
#pragma unroll
        for (int o = 1; o < 32; o <<= 1) am = fmaxf(am, __shfl_xor(am, o));
        const bool fp4 = isv ? (V_FP4 != 0) : (U_FP4 != 0);
        const float sc = am > 0.f ? am * (fp4 ? (1.0f / 6.0f) : (1.0f / 7.5f)) : 1.0f, inv = 1.0f / sc;
        a = a * inv; b = b * inv;
        if (fp4) {
            v4u o;
#pragma unroll
            for (int d = 0; d < 4; ++d) { unsigned pk = 0;
#define X_(e) ((e) < 16 ? a[(e) & 15] : b[(e) & 15])
                pk = __builtin_amdgcn_cvt_scalef32_pk_fp4_f32(pk, X_(8 * d + 0), X_(8 * d + 1), 1.0f, 0);
                pk = __builtin_amdgcn_cvt_scalef32_pk_fp4_f32(pk, X_(8 * d + 2), X_(8 * d + 3), 1.0f, 1);
                pk = __builtin_amdgcn_cvt_scalef32_pk_fp4_f32(pk, X_(8 * d + 4), X_(8 * d + 5), 1.0f, 2);
                pk = __builtin_amdgcn_cvt_scalef32_pk_fp4_f32(pk, X_(8 * d + 6), X_(8 * d + 7), 1.0f, 3);
#undef X_
                o[d] = pk; }
            *(GAS v4u*)((isv ? F.V8 : F.U8) + (size_t)r * 512 + 16 * q) = o;
        } else {
        { f32x16v a2, b2;
#pragma unroll
          for (int i = 0; i < 8; ++i) { a2[i] = a[2 * i]; b2[i] = a[2 * i + 1]; a2[8 + i] = b[2 * i]; b2[8 + i] = b[2 * i + 1]; }
          a = a2; b = b2; }
        const u32x6v pk = __builtin_amdgcn_cvt_scalef32_2xpk16_fp6_f32(a, b, 1.0f);
        GAS unsigned* dp = (GAS unsigned*)((isv ? F.V8 : F.U8) + (size_t)r * 768 + 24 * q);
        *(GAS v2u*)dp = (v2u){pk[0], pk[1]}; *(GAS v2u*)(dp + 2) = (v2u){pk[2], pk[3]}; *(GAS v2u*)(dp + 4) = (v2u){pk[4], pk[5]};
        }
        if (q == 0) { if (isv) F.SV[r] = sc; else F.SU[r] = sc; }
    }
}
__device__ __forceinline__ int idle_slot(int nwg, int G, int c, int& nslots) {
    const int mx = (nwg + G - 1) / G, full = nwg - (mx - 1) * G;
    nslots = G - full;
    if (nslots == 0) { nslots = G; return c; }
    return c >= full ? c - full : -1;
}
__device__ __forceinline__ void side_transposes(const Ctx& F, int slot, int nslots) {
    LAS float* scr = (LAS float*)(F.lds + F.wave * 16384);
    constexpr int I_O = 16 * 32, I_Q = 16 * (PQD / 32), I_IN1 = 16 * (SWA_IN / 32);
    constexpr int NITEMS = I_O + I_Q + I_IN1 + I_O + I_Q;
    for (int it = slot * NWAVES + F.wave; it < NITEMS; it += nslots * NWAVES) {
        int r = it;
        if (r < I_O) { p0_transpose_item(F.ab_w_out, DM, DM, F.WOUT0, scr, r, F.lane); continue; } r -= I_O;
        if (r < I_Q) { p0_transpose_item(F.peer_w_q, DM, PQD, F.WQ0, scr, r, F.lane); continue; } r -= I_Q;
        if (r < I_IN1) { p0_transpose_item(F.swa_w_in, DM, SWA_IN, F.WIN1, scr, r, F.lane); continue; } r -= I_IN1;
        if (r < I_O) { p0_transpose_item(F.swa_w_out, DM, DM, F.WOUT1, scr, r, F.lane); continue; } r -= I_O;
        p0_transpose_item(F.peer_w_q + (size_t)DM * PQD, DM, PQD, F.WQ1, scr, r, F.lane);
    }
}
__device__ __forceinline__ void side_convert(const Ctx& F, int part) {
    int n7, n9; const int s7 = idle_slot((MALL / 256) * (DM / 256), F.G, (int)blockIdx.x, n7), s9 = idle_slot((MALL / 256) * (PQD / 256), F.G, (int)blockIdx.x, n9);
    const int slot = part == 0 ? s7 : (s9 < 0 ? -1 : n7 + s9);
    if (slot < 0) return;
    const int per = (65536 + n7 + n9 - 1) / (n7 + n9);
    const int rbeg = min(slot * per, 65536), rend = min(rbeg + per, 65536);
    convert_fp6_rows(F, rbeg, rend);
}
__device__ __forceinline__ void p0_prologue(const Ctx& F) {
    if (blockIdx.x < 192) {
        const int l = blockIdx.x / 96, cb = blockIdx.x % 96, col = cb * 64 + F.lane;
        LAS float* s = (LAS float*)F.lds;
        LAS float* part = (LAS float*)(F.lds + 20480);
        for (int i = F.tid; i < 5120; i += NTHR) { const int r = i >> 10, k = i & 1023; const float cv = r < 4 ? F.c[r * 1024 + k] : F.c_ctx[k]; s[i] = cv / (1.f + __expf(-cv)); }
        __syncthreads();
        float acc[5] = {0.f, 0.f, 0.f, 0.f, 0.f};
        const GAS float* wp = F.mod_w + ((size_t)l * 1024 + F.wave * 128) * MODW + col;
#pragma unroll 32
        for (int k = 0; k < 128; ++k) { const float wv = wp[(size_t)k * MODW];
#pragma unroll
            for (int r = 0; r < 5; ++r) acc[r] += s[r * 1024 + F.wave * 128 + k] * wv; }
#pragma unroll
        for (int r = 0; r < 5; ++r) part[(F.wave * 5 + r) * 64 + F.lane] = acc[r];
        __syncthreads();
        if (F.wave < 5) { float t = F.mod_b[l * MODW + col];
#pragma unroll
            for (int w = 0; w < 8; ++w) t += part[(w * 5 + F.wave) * 64 + F.lane];
            F.MOD[(size_t)(l * 5 + F.wave) * MODW + col] = t; }
        __syncthreads();
    }
    { const int gt = F.gw * 64 + F.lane;
      if (gt < 1024) { const int pos = gt >> 4, f = gt & 15; const float invf = fexp2(-(float)f * (13.287712379549449f / 16.f)); const float rev = (float)pos * invf * 0.15915494309189535f;
          F.ROPE[gt * 2] = __builtin_amdgcn_cosf(rev); F.ROPE[gt * 2 + 1] = __builtin_amdgcn_sinf(rev); } }
    { LAS float* scr = (LAS float*)(F.lds + F.wave * 16384);
      constexpr int I_IN0 = 16 * (AB_IN / 32);
      for (int it = F.gw; it < I_IN0; it += F.ngw) p0_transpose_item(F.ab_w_in, DM, AB_IN, F.WIN0, scr, it, F.lane); }
    p0_convert(F, F.peer_sub_keys, F.SUBK, (size_t)2 * 8 * 2 * 128 * 128 / 8);
}

template <bool SRCB>
__device__ __forceinline__ void mod_phase(const Ctx& F, const GAS float* src_lat, const GAS float* src_ctx, int M, const GAS float* normg, const GAS float* mod_l, int sh, int sc) {
    for (int m = F.gw; m < M; m += F.ngw) {
        const int cond = m < MLAT ? (m >> 12) : 4;
        const GAS float* shp = mod_l + (size_t)cond * MODW + sh * 1024; const GAS float* scp = mod_l + (size_t)cond * MODW + sc * 1024;
        f32x4 v[4]; float s = 0.f;
#pragma unroll
        for (int j = 0; j < 4; ++j) {
            if (SRCB) { const v2u w = *(const GAS v2u*)(F.XS + (size_t)m * DM + 4 * F.lane + 256 * j); v[j] = (f32x4){bflo(w.x), bfhi(w.x), bflo(w.y), bfhi(w.y)}; }
            else { const GAS float* xr = m < MLAT ? src_lat + (size_t)m * DM : src_ctx + (size_t)(m - MLAT) * DM; v[j] = *(const GAS f32x4*)(xr + 4 * F.lane + 256 * j); }
            s += (v[j][0] * v[j][0] + v[j][1] * v[j][1]) + (v[j][2] * v[j][2] + v[j][3] * v[j][3]); }
        const float r = 1.0f / sqrtf(wave_sum(s) * (1.f / DM) + 1e-6f);
        GAS bf16* orow = F.XN + (size_t)m * DM;
#pragma unroll
        for (int j = 0; j < 4; ++j) { const int k = 4 * F.lane + 256 * j;
            const f32x4 g = *(const GAS f32x4*)(normg + k), a = *(const GAS f32x4*)(scp + k), b = *(const GAS f32x4*)(shp + k);
            f32x4 o;
#pragma unroll
            for (int e = 0; e < 4; ++e) o[e] = v[j][e] * r * g[e] * (1.f + a[e]) + b[e];
            v2u w; w.x = pk2(o[0], o[1]); w.y = pk2(o[2], o[3]); *(GAS v2u*)(orow + k) = w; }
    }
}

struct PostSlot { int col; const GAS float* nw; int rope; float scale; GAS bf16* tdst; int nheads; int head; int write_nat; };
__device__ __forceinline__ void post_item(const Ctx& F, GAS bf16* P, int ld, int tt, const PostSlot& S, LAS unsigned char* wl) {
    const int lane = F.lane, c = lane & 7, rsub = lane >> 3;
    const bool latent = tt < 256;
    const int m0 = tt * 64;
    const int b = latent ? (tt >> 6) : ((tt - 256) >> 2);
    const int t0 = latent ? ((tt & 63) * 64) : (((tt - 256) & 3) * 64);
    f32x4 nwa = {1.f, 1.f, 1.f, 1.f}, nwb = {1.f, 1.f, 1.f, 1.f};
    if (S.nw) { nwa = *(const GAS f32x4*)(S.nw + 8 * c); nwb = *(const GAS f32x4*)(S.nw + 8 * c + 4); }
#pragma unroll
    for (int it = 0; it < 8; ++it) {
        const int row = it * 8 + rsub;
        GAS bf16* pp = P + (size_t)(m0 + row) * ld + S.col + 8 * c;
        const v4u raw = *(const GAS v4u*)pp;
        float v[8] = {bflo(raw.x), bfhi(raw.x), bflo(raw.y), bfhi(raw.y), bflo(raw.z), bfhi(raw.z), bflo(raw.w), bfhi(raw.w)};
        if (S.nw) {
            float ss = 0.f;
#pragma unroll
            for (int e = 0; e < 8; ++e) ss += v[e] * v[e];
            ss += __shfl_xor(ss, 1); ss += __shfl_xor(ss, 2); ss += __shfl_xor(ss, 4);
            const float r = 1.0f / sqrtf(ss * (1.f / 64.f) + 1e-6f);
#pragma unroll
            for (int e = 0; e < 4; ++e) { v[e] *= r * nwa[e]; v[4 + e] *= r * nwb[e]; }
        }
        if (S.rope && latent) {
            const int t = t0 + row, pos = ((c & 3) < 2) ? (t >> 6) : (t & 63), f0 = (c & 1) * 8;
            const GAS float* rp = F.ROPE + (size_t)(pos * 16 + f0) * 2;
#pragma unroll
            for (int e = 0; e < 8; ++e) {
                const float other = __shfl_xor(v[e], 4);
                const float cs = rp[2 * e], sn = rp[2 * e + 1];
                v[e] = (c < 4) ? (v[e] * cs - other * sn) : (other * sn + v[e] * cs);
            }
        }
        v4u o; o.x = pk2(v[0] * S.scale, v[1] * S.scale); o.y = pk2(v[2] * S.scale, v[3] * S.scale); o.z = pk2(v[4] * S.scale, v[5] * S.scale); o.w = pk2(v[6] * S.scale, v[7] * S.scale);
        if (S.write_nat) *(GAS v4u*)pp = o;
        if (S.tdst) *(LAS v4u*)(wl + row * 144 + 16 * c) = o;
    }
    if (S.tdst) {
        LDS_WAIT(); asm volatile("" ::: "memory");
        const int tlen = latent ? SEQ : CL;
        GAS bf16* dst = S.tdst + (latent ? (size_t)0 : (size_t)NBATCH * S.nheads * 64 * SEQ) + ((size_t)(b * S.nheads + S.head) * 64 + lane) * tlen + t0;
#pragma unroll
        for (int q = 0; q < 8; ++q) {
            unsigned w[4];
#pragma unroll
            for (int e = 0; e < 4; ++e) {
                const unsigned lo = *(LAS const unsigned short*)(wl + (8 * q + 2 * e) * 144 + 2 * lane);
                const unsigned hi = *(LAS const unsigned short*)(wl + (8 * q + 2 * e + 1) * 144 + 2 * lane);
                w[e] = lo | (hi << 16);
            }
            v4u o; o.x = w[0]; o.y = w[1]; o.z = w[2]; o.w = w[3];
            *(GAS v4u*)(dst + 8 * q) = o;
        }
        LDS_WAIT(); asm volatile("" ::: "memory");
    }
}
#define NEG_BIG (-1.0e30f)
constexpr int SW_KP = 144, SW_CK = 0, SW_CVP = 528, SW_CV = 36864, SW_LK = 70656, SW_LVP = 592, SW_LV = 112128, SW_END = 150016;
__device__ __forceinline__ int kswz(int row, int c8) { const int t = row & 31; return ((row & ~31) + 16 * ((t >> 2) & 1) + 4 * (t >> 3) + (t & 3)) * 144 + 16 * c8; }
__device__ __forceinline__ bf16x8 ldsfrag(LAS const unsigned char* p) { return __builtin_bit_cast(bf16x8, *(LAS const v4u*)p); }

constexpr int NA_RPB = 70656;
template <bool CTXQ>
__device__ __forceinline__ void na_unit2(const Ctx& F, int b, int h, int r, int cg, float Bl2) {
    const int lane = F.lane, qi = lane & 15, g = lane >> 4;
    const GAS bf16* P = F.P;
    LAS const unsigned char* L = F.lds;
    const int c = cg * 16 + qi;
    const size_t qrow = CTXQ ? (size_t)(MLAT + b * CL + r * 16 + qi) : (size_t)(b * SEQ + r * 64 + c);
    const GAS bf16* qp = P + qrow * AB_IN + h * 64 + 8 * g;
    bf16x8 bq[2]; bq[0] = ldfrag(qp); bq[1] = ldfrag(qp + 32);
    const int arow = 8 * (qi >> 2) + (qi & 3);
    const int kz0 = 16 * g, kz1 = kz0 + 64;
    float l = 0.f;
    f32x4 o[4];
#pragma unroll
    for (int db = 0; db < 4; ++db) o[db] = (f32x4){0.f, 0.f, 0.f, 0.f};
    if (!CTXQ) {
        const int kr0 = min(max(r - 4, 0), 56), kc0 = cg == 0 ? 0 : (cg == 1 ? 8 : (cg == 2 ? 24 : 32)), start = min(max(c - 8, 0), 48);
        LAS const float* rpb = (LAS const float*)(L + NA_RPB);
        const GAS bf16* vx = F.TAV + ((size_t)(b * 8 + h) * 64 + qi) * SEQ + 8 * g;
#pragma unroll 4
        for (int y = 0; y < 8; ++y) {
            const int T0 = (kr0 + y) * 64 + kc0;
            LAS const float* rpr = rpb + ((kr0 + y) - r + 7) * 31;
            f32x4 st[2];
#pragma unroll
            for (int hh = 0; hh < 2; ++hh) {
                const GAS bf16* kp = P + (size_t)(b * SEQ + T0 + arow + 4 * hh) * AB_IN + 512 + h * 64 + 8 * g;
                f32x4 a = {0.f, 0.f, 0.f, 0.f};
                a = mfma16(ldfrag(kp), bq[0], a); a = mfma16(ldfrag(kp + 32), bq[1], a);
#pragma unroll
                for (int rr = 0; rr < 4; ++rr) {
                    const int kc = kc0 + 8 * g + 4 * hh + rr;
                    const bool valid = (kc >= start) && (kc < start + 16);
                    const int bi = min(max(kc - c + 15, 0), 30);
                    const float p = fexp2((a[rr] + rpr[bi]) * 1.4426950408889634f - Bl2);
                    a[rr] = valid ? p : 0.f; l += a[rr];
                }
                st[hh] = a;
            }
            const bf16x8 bp = pack8(st[0], st[1]);
#pragma unroll
            for (int db = 0; db < 4; ++db) o[db] = mfma16(ldfrag(vx + (size_t)(16 * db) * SEQ + T0), bp, o[db]);
        }
    }
#pragma unroll 2
    for (int y = 0; y < 8; ++y) {
        f32x4 st[2];
#pragma unroll
        for (int hh = 0; hh < 2; ++hh) {
            LAS const unsigned char* kp = L + SW_CK + (32 * y + 16 * hh + qi) * SW_KP;
            f32x4 a = {0.f, 0.f, 0.f, 0.f};
            a = mfma16(ldsfrag(kp + kz0), bq[0], a); a = mfma16(ldsfrag(kp + kz1), bq[1], a);
#pragma unroll
            for (int rr = 0; rr < 4; ++rr) { const float p = fexp2(a[rr] * 1.4426950408889634f - Bl2); a[rr] = p; l += p; }
            st[hh] = a;
        }
        const bf16x8 bp = pack8(st[0], st[1]);
#pragma unroll
        for (int db = 0; db < 4; ++db) o[db] = mfma16(ldsfrag(L + SW_CV + (16 * db + qi) * SW_CVP + (32 * y + 8 * g) * 2), bp, o[db]);
    }
    l += __shfl_xor(l, 16); l += __shfl_xor(l, 32);
    const float inv = 1.0f / l;
    GAS bf16* op = F.XN + qrow * DM + h * 64 + 4 * g;
#pragma unroll
    for (int db = 0; db < 4; ++db) { v2u w; w.x = pk2(o[db][0] * inv, o[db][1] * inv); w.y = pk2(o[db][2] * inv, o[db][3] * inv); *(GAS v2u*)(op + 16 * db) = w; }
}
__device__ __forceinline__ void swa_phase(const Ctx& F) {
    const int lane = F.lane, qi = lane & 15, g = lane >> 4, tid = F.tid;
    const GAS bf16* P = F.P;
    LAS unsigned char* L = F.lds;
    float mq = fabsf(F.swa_q_norm[lane]), mk = fabsf(F.swa_k_norm[lane]);
#pragma unroll
    for (int o = 1; o < 64; o <<= 1) { mq = fmaxf(mq, __shfl_xor(mq, o)); mk = fmaxf(mk, __shfl_xor(mk, o)); }
    const float Bl2 = 8.1f * mq * mk * 1.4426950408889634f;
    const int arow = 8 * (qi >> 2) + (qi & 3);
    const int vcu = F.gw >> 3;
    for (int su = vcu; su < 256; su += F.G) {
        const int b = su >> 6, kvh = (su >> 4) & 3, qb0 = (su & 15) * 8;
        const int hq = kvh * 4 + (F.wave >> 1), sb = F.wave & 1;
        __syncthreads();
#pragma unroll
        for (int j = 0; j < 4; ++j) {
            const int cid = tid + 512 * j;
            { const int row = cid >> 3, c8 = cid & 7;
              *(LAS v4u*)(L + SW_CK + kswz(row, c8)) = ld16(P + (size_t)(MLAT + b * CL + row) * SWA_IN + 1024 + kvh * 64 + 8 * c8); }
            { const int d = cid >> 5, c = cid & 31;
              *(LAS v4u*)(L + SW_CV + d * SW_CVP + 16 * c) = ld16(F.TAV + (size_t)NBATCH * 4 * 64 * SEQ + ((size_t)(b * 4 + kvh) * 64 + d) * CL + 8 * c); }
        }
        const float sinkp = fexp2(F.swa_sink[hq] * 1.4426950408889634f - Bl2);
        v4u kreg[5], vreg[5];
#define SW_PREFETCH(T0) do { _Pragma("unroll") for (int j = 0; j < 5; ++j) { const int cid = tid + 512 * j; if (cid < 2304) { \
            { const int row = cid >> 3, c8 = cid & 7; const int s_ = min(max((T0) - 128 + row, 0), SEQ - 1); kreg[j] = ld16(P + (size_t)(b * SEQ + s_) * SWA_IN + 1024 + kvh * 64 + 8 * c8); } \
            { const int d = cid / 36, c = cid - d * 36; const int tok = min(max((T0) - 128 + 8 * c, 0), SEQ - 8); vreg[j] = ld16(F.TAV + ((size_t)(b * 4 + kvh) * 64 + d) * SEQ + tok); } } } } while (0)
        SW_PREFETCH(32 * qb0);
#pragma unroll 1
        for (int iq = 0; iq < 8; ++iq) {
            const int t0 = 32 * (qb0 + iq);
            if (iq > 0) __syncthreads();
#pragma unroll
            for (int j = 0; j < 5; ++j) {
                const int cid = tid + 512 * j;
                if (cid < 2304) {
                    { const int row = cid >> 3, c8 = cid & 7; *(LAS v4u*)(L + SW_LK + kswz(row, c8)) = kreg[j]; }
                    { const int d = cid / 36, c = cid - d * 36; *(LAS v4u*)(L + SW_LV + d * SW_LVP + 16 * c) = vreg[j]; }
                }
            }
            if (iq + 1 < 8) SW_PREFETCH(t0 + 32);
            const int t = t0 + 16 * sb + qi;
            const GAS bf16* qp = P + (size_t)(b * SEQ + t) * SWA_IN + hq * 64 + 8 * g;
            bf16x8 bq[2]; bq[0] = ldfrag(qp); bq[1] = ldfrag(qp + 32);
            __syncthreads();
            float l = 0.f;
            f32x4 o[4];
#pragma unroll
            for (int db = 0; db < 4; ++db) o[db] = (f32x4){0.f, 0.f, 0.f, 0.f};
            f32x4 Sraw[2][2]; bf16x8 Ppk[2];
            const int kc0 = 16 * g, kc1 = kc0 + 64;
#define SW_A(y) do { _Pragma("unroll") for (int hh = 0; hh < 2; ++hh) { \
                LAS const unsigned char* kp = ((y) < 9) ? (L + SW_LK + (32 * (y) + 16 * hh + qi) * SW_KP) : (L + SW_CK + (32 * ((y) - 9) + 16 * hh + qi) * SW_KP); \
                f32x4 a = {0.f, 0.f, 0.f, 0.f}; a = mfma16(ldsfrag(kp + kc0), bq[0], a); a = mfma16(ldsfrag(kp + kc1), bq[1], a); Sraw[(y) & 1][hh] = a; } } while (0)
#define SW_B(y) do { f32x4 st[2]; _Pragma("unroll") for (int hh = 0; hh < 2; ++hh) { f32x4 a = Sraw[(y) & 1][hh]; \
                _Pragma("unroll") for (int rr = 0; rr < 4; ++rr) { float p = fexp2(a[rr] * 1.4426950408889634f - Bl2); \
                    if ((y) < 9) { const int s_ = t0 - 128 + 32 * (y) + 8 * g + 4 * hh + rr; const int d = t - s_; \
                        const bool valid = (s_ >= 0) && (s_ < SEQ) && (d <= 128) && (d >= -128); p = valid ? p : 0.f; } \
                    a[rr] = p; l += p; } st[hh] = a; } Ppk[(y) & 1] = pack8(st[0], st[1]); } while (0)
#define SW_C(y) do { _Pragma("unroll") for (int db = 0; db < 4; ++db) { \
                LAS const unsigned char* vp = ((y) < 9) ? (L + SW_LV + (16 * db + qi) * SW_LVP + (32 * (y) + 8 * g) * 2) : (L + SW_CV + (16 * db + qi) * SW_CVP + (32 * ((y) - 9) + 8 * g) * 2); \
                o[db] = mfma16(ldsfrag(vp), Ppk[(y) & 1], o[db]); } } while (0)
            SW_A(0);
            SW_A(1); SW_B(0);
#pragma unroll
            for (int y = 1; y < 17; ++y) {
                if (y + 1 < 17) SW_A(y + 1);
                SW_C(y - 1);
                SW_B(y);
            }
            SW_C(16);
#undef SW_A
#undef SW_B
#undef SW_C
            l += __shfl_xor(l, 16); l += __shfl_xor(l, 32);
            l += sinkp;
            const float inv = 1.0f / l;
            GAS bf16* op = F.XN + (size_t)(b * SEQ + t) * DM + hq * 64 + 4 * g;
#pragma unroll
            for (int db = 0; db < 4; ++db) { v2u w; w.x = pk2(o[db][0] * inv, o[db][1] * inv); w.y = pk2(o[db][2] * inv, o[db][3] * inv); *(GAS v2u*)(op + 16 * db) = w; }
        }
#undef SW_PREFETCH
    }
    __syncthreads();
}

__device__ __forceinline__ void na_phase(const Ctx& F) {
    const int lane = F.lane, tid = F.tid;
    const GAS bf16* P = F.P;
    LAS unsigned char* L = F.lds;
    float mq = fabsf(F.na_q_norm[lane]), mk = fabsf(F.na_k_norm[lane]);
#pragma unroll
    for (int o = 1; o < 64; o <<= 1) { mq = fmaxf(mq, __shfl_xor(mq, o)); mk = fmaxf(mk, __shfl_xor(mk, o)); }
    const int vcu = F.gw >> 3;
    for (int su = vcu; su < 256; su += F.G) {
        const int bh = su >> 3, e8 = su & 7, b = bh >> 3, h = bh & 7;
        __syncthreads();
#pragma unroll
        for (int j = 0; j < 4; ++j) {
            const int cid = tid + 512 * j;
            { const int row = cid >> 3, c8 = cid & 7;
              *(LAS v4u*)(L + SW_CK + kswz(row, c8)) = ld16(P + (size_t)(MLAT + b * CL + row) * AB_IN + 512 + h * 64 + 8 * c8); }
            { const int d = cid >> 5, c = cid & 31;
              *(LAS v4u*)(L + SW_CV + d * SW_CVP + 16 * c) = ld16(F.TAV + (size_t)NBATCH * 8 * 64 * SEQ + ((size_t)(b * 8 + h) * 64 + d) * CL + 8 * c); }
        }
        float mb = 0.f;
        if (tid < 465) { const float v = F.na_rpb[h * 465 + tid]; ((LAS float*)(L + NA_RPB))[tid] = v; }
        for (int i = lane; i < 465; i += 64) mb = fmaxf(mb, fabsf(F.na_rpb[h * 465 + i]));
#pragma unroll
        for (int o = 1; o < 64; o <<= 1) mb = fmaxf(mb, __shfl_xor(mb, o));
        const float Bl2 = (8.1f * mq * mk + mb) * 1.4426950408889634f;
        __syncthreads();
#pragma unroll 1
        for (int k = 0; k < 4; ++k) { const int i = F.wave + 8 * k; na_unit2<false>(F, b, h, e8 * 8 + (i >> 2), i & 3, Bl2); }
        if (F.wave < 2) na_unit2<true>(F, b, h, e8 * 2 + F.wave, 0, Bl2);
    }
    __syncthreads();
}

__device__ __forceinline__ int ret_pb(int pf) { return pf < 2 ? 32 + pf : pf - 2; }
__device__ __forceinline__ void ret_r1_unit(const Ctx& F, int bh, int pf, int dir) {
    const int lane = F.lane, qi = lane & 15, g = lane >> 4;
    const int h = bh & 7;
    const float lg2 = -__expf(F.ret_log_decay[dir * 8 + h]) * 1.4426950408889634f;
    const bool isctx = pf < 2;
    const int tlen = isctx ? CL : SEQ;
    const size_t boff = (isctx ? (size_t)NBATCH * 8 * 64 * SEQ : (size_t)0) + (size_t)bh * 64 * tlen + (isctx ? pf * 128 : (pf - 2) * 128);
    const GAS bf16* kt = F.TBK + boff + (size_t)qi * tlen + 8 * g;
    const GAS bf16* vt = F.TBV + boff + (size_t)qi * tlen + 8 * g;
    f32x4 acc[4][4];
#pragma unroll
    for (int db = 0; db < 4; ++db)
#pragma unroll
        for (int kb = 0; kb < 4; ++kb) acc[db][kb] = (f32x4){0.f, 0.f, 0.f, 0.f};
#pragma unroll 1
    for (int js = 0; js < 4; ++js) {
        float w[8];
#pragma unroll
        for (int jj = 0; jj < 8; ++jj) { const int j = 32 * js + 8 * g + jj; w[jj] = fexp2(lg2 * (float)(dir == 0 ? 127 - j : j)); }
        bf16x8 bk[4];
#pragma unroll
        for (int kb = 0; kb < 4; ++kb) {
            const v4u raw = ld16(kt + (size_t)(16 * kb) * tlen + 32 * js);
            v4u o; o.x = pk2(bflo(raw.x) * w[0], bfhi(raw.x) * w[1]); o.y = pk2(bflo(raw.y) * w[2], bfhi(raw.y) * w[3]);
            o.z = pk2(bflo(raw.z) * w[4], bfhi(raw.z) * w[5]); o.w = pk2(bflo(raw.w) * w[6], bfhi(raw.w) * w[7]);
            bk[kb] = __builtin_bit_cast(bf16x8, o);
        }
#pragma unroll
        for (int db = 0; db < 4; ++db) {
            const bf16x8 a = ldfrag(vt + (size_t)(16 * db) * tlen + 32 * js);
#pragma unroll
            for (int kb = 0; kb < 4; ++kb) acc[db][kb] = mfma16(a, bk[kb], acc[db][kb]);
        }
    }
    const int idx = dir == 0 ? pf : ret_pb(pf);
    GAS float* out = F.KV + ((size_t)(bh * 2 + dir) * 34 + idx) * 4096;
#pragma unroll
    for (int db = 0; db < 4; ++db)
#pragma unroll
        for (int kb = 0; kb < 4; ++kb)
#pragma unroll
            for (int rr = 0; rr < 4; ++rr) out[(16 * db + 4 * g + rr) * 64 + 16 * kb + qi] = acc[db][kb][rr];
}
__device__ __forceinline__ void ret_r2(const Ctx& F) {
    const int NT = F.ngw * 64;
    for (int it = F.gw * 64 + F.lane; it < 64 * 4096; it += NT) {
        const int unit = it >> 12, e = it & 4095;
        const int dir = unit & 1, h = (unit >> 1) & 7;
        const float gC = fexp2(-__expf(F.ret_log_decay[dir * 8 + h]) * 1.4426950408889634f * 128.f);
        const GAS float* kv = F.KV + (size_t)unit * 34 * 4096 + e;
        GAS bf16* st = F.ST + (size_t)unit * 34 * 4096 + e;
        float kvv[34];
#pragma unroll
        for (int p = 0; p < 34; ++p) kvv[p] = kv[(size_t)p * 4096];
        float S = 0.f;
        if (dir == 0) {
#pragma unroll
            for (int p = 0; p < 34; ++p) { st[(size_t)p * 4096] = (bf16)f2bf(S); S = S * gC + kvv[p]; }
        } else {
#pragma unroll
            for (int p = 33; p >= 0; --p) { st[(size_t)p * 4096] = (bf16)f2bf(S); S = S * gC + kvv[p]; }
        }
    }
}
constexpr int R3_KP = 144, R3_K = 0, R3_VP = 272, R3_V = 18432, R3_SP = 144, R3_SF = 35840, R3_SB = 45056, R3_END = 54272;
__device__ __forceinline__ void ret_r3_phase(const Ctx& F) {
    const int lane = F.lane, qi = lane & 15, g = lane >> 4, tid = F.tid, ib = F.wave;
    const GAS bf16* P = F.P;
    LAS unsigned char* L = F.lds;
    const int arow = 8 * (qi >> 2) + (qi & 3);
    const int kc0 = 16 * g, kc1 = kc0 + 64;
    const int vcu = F.gw >> 3;
    for (int grp = vcu; grp < 32 * 34; grp += F.G) {
        const int bh = grp / 34, pf = grp - bh * 34;
        const int b = bh >> 3, h = bh & 7;
        const bool isctx = pf < 2;
        const size_t row0 = isctx ? (size_t)(MLAT + b * CL + pf * 128) : (size_t)(b * SEQ + (pf - 2) * 128);
        const int tlen = isctx ? CL : SEQ;
        const GAS bf16* vt = F.TBV + (isctx ? (size_t)NBATCH * 8 * 64 * SEQ : (size_t)0) + (size_t)bh * 64 * tlen + (isctx ? pf * 128 : (pf - 2) * 128);
        const GAS bf16* sfp = F.ST + ((size_t)(bh * 2 + 0) * 34 + pf) * 4096;
        const GAS bf16* sbp = F.ST + ((size_t)(bh * 2 + 1) * 34 + ret_pb(pf)) * 4096;
        __syncthreads();
#pragma unroll
        for (int j = 0; j < 2; ++j) {
            const int cid = tid + 512 * j;
            { const int row = cid >> 3, c8 = cid & 7; *(LAS v4u*)(L + R3_K + kswz(row, c8)) = ld16(P + (row0 + row) * AB_IN + 2048 + h * 64 + 8 * c8); }
            { const int d = cid >> 4, c = cid & 15; *(LAS v4u*)(L + R3_V + d * R3_VP + 16 * c) = ld16(vt + (size_t)d * tlen + 8 * c); }
        }
        { const int d = tid >> 3, c8 = tid & 7;
          *(LAS v4u*)(L + R3_SF + d * R3_SP + 16 * c8) = ld16(sfp + d * 64 + 8 * c8);
          *(LAS v4u*)(L + R3_SB + d * R3_SP + 16 * c8) = ld16(sbp + d * 64 + 8 * c8); }
        const int i = 16 * ib + qi;
        const float lgf = -__expf(F.ret_log_decay[h]) * 1.4426950408889634f, lgb = -__expf(F.ret_log_decay[8 + h]) * 1.4426950408889634f;
        const GAS bf16* qp = P + (row0 + i) * AB_IN + 1536 + h * 64 + 8 * g;
        bf16x8 bq[2]; bq[0] = ldfrag(qp); bq[1] = ldfrag(qp + 32);
        __syncthreads();
        f32x4 o[4];
#pragma unroll
        for (int db = 0; db < 4; ++db) o[db] = (f32x4){0.f, 0.f, 0.f, 0.f};
#pragma unroll
        for (int y = 0; y < 4; ++y) {
            f32x4 st[2];
#pragma unroll
            for (int hh = 0; hh < 2; ++hh) {
                LAS const unsigned char* kp = L + R3_K + (32 * y + 16 * hh + qi) * R3_KP;
                f32x4 a = {0.f, 0.f, 0.f, 0.f};
                a = mfma16(ldsfrag(kp + kc0), bq[0], a); a = mfma16(ldsfrag(kp + kc1), bq[1], a);
#pragma unroll
                for (int rr = 0; rr < 4; ++rr) {
                    const int j = 32 * y + 8 * g + 4 * hh + rr; const int d = i - j;
                    const float w = d > 0 ? fexp2(lgf * (float)d) : (d < 0 ? fexp2(lgb * (float)(-d)) : 1.0f);
                    a[rr] *= w;
                }
                st[hh] = a;
            }
            const bf16x8 bp = pack8(st[0], st[1]);
#pragma unroll
            for (int db = 0; db < 4; ++db) o[db] = mfma16(ldsfrag(L + R3_V + (16 * db + qi) * R3_VP + (32 * y + 8 * g) * 2), bp, o[db]);
        }
        {
            const float df = fexp2(lgf * (float)(i + 1)), dbk = fexp2(lgb * (float)(128 - i));
#pragma unroll
            for (int db = 0; db < 4; ++db) {
                LAS const unsigned char* sf = L + R3_SF + (16 * db + qi) * R3_SP + 16 * g;
                LAS const unsigned char* sb = L + R3_SB + (16 * db + qi) * R3_SP + 16 * g;
                f32x4 xf = {0.f, 0.f, 0.f, 0.f}, xb = {0.f, 0.f, 0.f, 0.f};
                xf = mfma16(ldsfrag(sf), bq[0], xf); xf = mfma16(ldsfrag(sf + 64), bq[1], xf);
                xb = mfma16(ldsfrag(sb), bq[0], xb); xb = mfma16(ldsfrag(sb + 64), bq[1], xb);
                o[db] = o[db] + xf * df + xb * dbk;
            }
        }
        float s = 0.f;
#pragma unroll
        for (int db = 0; db < 4; ++db) s += (o[db][0] + o[db][1]) + (o[db][2] + o[db][3]);
        s += __shfl_xor(s, 16); s += __shfl_xor(s, 32);
        const float mu = s * (1.f / 64.f);
        float q = 0.f;
#pragma unroll
        for (int db = 0; db < 4; ++db)
#pragma unroll
            for (int rr = 0; rr < 4; ++rr) { const float d = o[db][rr] - mu; o[db][rr] = d; q += d * d; }
        q += __shfl_xor(q, 16); q += __shfl_xor(q, 32);
        const float rstd = 1.0f / sqrtf(q * (1.f / 64.f) + 1e-5f);
        const GAS bf16* gp = P + (row0 + i) * AB_IN + 3072 + h * 64 + 4 * g;
        GAS bf16* op = F.XN + (row0 + i) * DM + 512 + h * 64 + 4 * g;
#pragma unroll
        for (int db = 0; db < 4; ++db) {
            const v2u gr = *(const GAS v2u*)(gp + 16 * db);
            const float gv[4] = {bflo(gr.x), bfhi(gr.x), bflo(gr.y), bfhi(gr.y)};
            float r[4];
#pragma unroll
            for (int rr = 0; rr < 4; ++rr) r[rr] = o[db][rr] * rstd * (gv[rr] / (1.f + fexp(-gv[rr])));
            v2u w; w.x = pk2(r[0], r[1]); w.y = pk2(r[2], r[3]); *(GAS v2u*)(op + 16 * db) = w;
        }
    }
    __syncthreads();
}
__device__ __constant__ unsigned char CAND_TAB[52] = {
    0x00,0x01,0x02,0x03,0x04,0x05,0x06,0x07,0x08,0x09,0x0a,0x0b,0x0c,0x0d,0x0e,0x0f,
    0x10,0x11,0x12,0x13,0x14,0x15,0x16,0x17,
    0x20,0x21,0x22,0x23,0x24,
    0x30,0x31,0x32,0x33,
    0x40,0x41,0x42, 0x50,0x51, 0x60,0x61, 0x70,0x71,
    0x80,0x90,0xa0,0xb0,0xc0,0xd0,0xe0,0xf0,
    0x00,0x00 };
#define SORT_NEG (-3.0e38f)
template <int LOGN>
__device__ __forceinline__ void bitonic_sort_desc(float (&v)[1 << LOGN]) {
    constexpr int N = 1 << LOGN;
#pragma unroll
    for (int kk = 1; kk <= LOGN; ++kk) {
#pragma unroll
        for (int jj = kk - 1; jj >= 0; --jj) {
#pragma unroll
            for (int i = 0; i < N; ++i) {
                const int k = 1 << kk, j = 1 << jj, l = i ^ j;
                if (l > i) {
                    const bool desc = ((i & k) == 0);
                    const float a = v[i], b = v[l];
                    const float hi = fmaxf(a, b), lo = fminf(a, b);
                    v[i] = desc ? hi : lo; v[l] = desc ? lo : hi;
                }
            }
        }
    }
}
__device__ __forceinline__ void merge_top16(float (&v)[16], int mask) {
    float c[16];
#pragma unroll
    for (int i = 0; i < 16; ++i) c[i] = fmaxf(v[i], __shfl_xor(v[15 - i], mask));
#pragma unroll
    for (int jj = 3; jj >= 0; --jj) {
#pragma unroll
        for (int i = 0; i < 16; ++i) { const int j = 1 << jj, l = i ^ j;
            if (l > i) { const float a = c[i], b = c[l]; c[i] = fmaxf(a, b); c[l] = fminf(a, b); } }
    }
#pragma unroll
    for (int i = 0; i < 16; ++i) v[i] = c[i];
}
__device__ __forceinline__ void merge_top16_local(float (&a)[16], const float (&b)[16]) {
    float c[16];
#pragma unroll
    for (int i = 0; i < 16; ++i) c[i] = fmaxf(a[i], b[15 - i]);
#pragma unroll
    for (int jj = 3; jj >= 0; --jj) {
#pragma unroll
        for (int i = 0; i < 16; ++i) { const int j = 1 << jj, l = i ^ j;
            if (l > i) { const float x = c[i], y = c[l]; c[i] = fmaxf(x, y); c[l] = fminf(x, y); } }
    }
#pragma unroll
    for (int i = 0; i < 16; ++i) a[i] = c[i];
}
constexpr int SC_KP = 272, SC_KEYS = 0, SC_PSTRIDE = 128 * SC_KP, SC_WL = 73728;
__device__ __forceinline__ void peer_score_unit(const Ctx& F, int tb, int h, LAS unsigned* wl, bf16x8 (&bq0)[4], int tbn) {
    const int lane = F.lane, qi = lane & 15, g = lane >> 4;
    const size_t m = (size_t)tb * 16 + qi;
    bf16x8 bq1[4];
#pragma unroll 1
    for (int p = 0; p < 2; ++p) {
        bf16x8 bq[4];
        const GAS bf16* qp = F.Q2 + m * PQD + h * 256 + p * 128 + 8 * g;
#pragma unroll
        for (int ks = 0; ks < 4; ++ks) bq[ks] = ldfrag(qp + 32 * ks);
        LAS const unsigned char* kp = F.lds + SC_KEYS + p * SC_PSTRIDE + qi * SC_KP + 16 * g;
        float va[16], vb[16];
#pragma unroll
        for (int kb = 0; kb < 8; ++kb) {
            f32x4 a = {0.f, 0.f, 0.f, 0.f};
#pragma unroll
            for (int ks = 0; ks < 4; ++ks) a = mfma16(ldsfrag(kp + (16 * kb) * SC_KP + 64 * ks), bq[ks], a);
#pragma unroll
            for (int rr = 0; rr < 4; ++rr) {
                const float pv = __uint_as_float((__float_as_uint(a[rr]) & ~127u) | (unsigned)(16 * kb + 4 * g + rr));
                if (kb < 4) va[4 * kb + rr] = pv; else vb[4 * (kb - 4) + rr] = pv;
            }
        }
        bitonic_sort_desc<4>(va); bitonic_sort_desc<4>(vb);
        merge_top16_local(va, vb);
        merge_top16(va, 16); merge_top16(va, 32);
        if (g == 0) {
#pragma unroll
            for (int i = 0; i < 16; ++i) wl[(qi * 2 + p) * 16 + i] = __float_as_uint(va[i]);
        }
    }
    LDS_WAIT(); asm volatile("" ::: "memory");
    LAS const unsigned char* tab = (LAS const unsigned char*)(wl + 512);
    float cd[16];
#pragma unroll
    for (int k = 0; k < 13; ++k) {
        const int code = g * 13 + k;
        const unsigned ij = tab[code];
        const unsigned a = wl[(qi * 2 + 0) * 16 + (ij >> 4)], b = wl[(qi * 2 + 1) * 16 + (ij & 15)];
        const float s = __uint_as_float(a & ~127u) + __uint_as_float(b & ~127u);
        cd[k] = code < 50 ? __uint_as_float((__float_as_uint(s) & ~63u) | (unsigned)code) : SORT_NEG;
    }
    cd[13] = SORT_NEG; cd[14] = SORT_NEG; cd[15] = SORT_NEG;
    bitonic_sort_desc<4>(cd);
    merge_top16(cd, 16); merge_top16(cd, 32);
    float e[16]; float sum = 0.f;
    const float mx = __uint_as_float(__float_as_uint(cd[0]) & ~63u);
#pragma unroll
    for (int k = 0; k < 16; ++k) { e[k] = fexp(__uint_as_float(__float_as_uint(cd[k]) & ~63u) - mx); sum += e[k]; }
    const float inv = 1.0f / sum;
    typedef int i32x4 __attribute__((ext_vector_type(4)));
    i32x4 oi; f32x4 og;
#pragma unroll
    for (int k = 0; k < 4; ++k) {
        const float cv = g == 0 ? cd[k] : (g == 1 ? cd[4 + k] : (g == 2 ? cd[8 + k] : cd[12 + k]));
        const float ev = g == 0 ? e[k] : (g == 1 ? e[4 + k] : (g == 2 ? e[8 + k] : e[12 + k]));
        const unsigned code = __float_as_uint(cv) & 63u;
        const unsigned ij = tab[code];
        const unsigned a = wl[(qi * 2 + 0) * 16 + (ij >> 4)] & 127u, b = wl[(qi * 2 + 1) * 16 + (ij & 15)] & 127u;
        oi[k] = (int)(a * 128u + b);
        og[k] = ev * inv;
    }
    *(GAS i32x4*)(F.IDX + m * 128 + h * 16 + 4 * g) = oi;
    *(GAS f32x4*)(F.GATE + m * 128 + h * 16 + 4 * g) = og;
    LDS_WAIT(); asm volatile("" ::: "memory");
}
__device__ __forceinline__ void peer_score_phase(const Ctx& F, int l, int Mp) {
    const int vcu = F.gw >> 3, tid = F.tid;
    LAS unsigned* wl = (LAS unsigned*)(F.lds + SC_WL + F.wave * (SC2 ? 8192 : 4096));
    if (F.lane < 52) ((LAS unsigned char*)(wl + 512))[F.lane] = CAND_TAB[F.lane];
    const int nj = (F.G >= 8) ? F.G / 8 : 1;
    const int nb = Mp / 16;
    for (int hh = vcu & 7; hh < 8; hh += (F.G >= 8 ? 8 : F.G)) {
        __syncthreads();
        const GAS bf16* src = F.SUBK + (size_t)((l * 8 + hh) * 2) * 128 * 128;
#pragma unroll
        for (int j = 0; j < 8; ++j) { const int cid = tid + 512 * j; const int row = cid >> 4, c16 = cid & 15;
            *(LAS v4u*)(F.lds + SC_KEYS + row * SC_KP + 16 * c16) = ld16(src + (size_t)row * 128 + 8 * c16); }
        __syncthreads();
        { const int tb0 = (vcu >> 3) % nj + nj * F.wave, qi = F.lane & 15, g = F.lane >> 4;
          bf16x8 bq0[4];
          if (SCPF && tb0 < nb) {
#pragma unroll
              for (int ks = 0; ks < 4; ++ks) bq0[ks] = ldfrag(F.Q2 + ((size_t)tb0 * 16 + qi) * PQD + hh * 256 + 8 * g + 32 * ks);
          }
          for (int tb = tb0; tb < nb; tb += nj * NWAVES) { const int tbn = tb + nj * NWAVES; peer_score_unit(F, tb, hh, wl, bq0, tbn < nb ? tbn : -1); }
        }
    }
    __syncthreads();
}

typedef float f32x2 __attribute__((ext_vector_type(2)));
#define DPP_XOR1(x) __builtin_bit_cast(float, __builtin_amdgcn_update_dpp(0, __builtin_bit_cast(int, (x)), 0xB1, 0xf, 0xf, false))
#define DPP_XOR2(x) __builtin_bit_cast(float, __builtin_amdgcn_update_dpp(0, __builtin_bit_cast(int, (x)), 0x4E, 0xf, 0xf, false))
#define DPP_ROR4(x) __builtin_bit_cast(float, __builtin_amdgcn_update_dpp(0, __builtin_bit_cast(int, (x)), 0x124, 0xf, 0xf, false))
#define DPP_ROR8(x) __builtin_bit_cast(float, __builtin_amdgcn_update_dpp(0, __builtin_bit_cast(int, (x)), 0x128, 0xf, 0xf, false))
__device__ __forceinline__ float xsum16(float x) { auto rr = __builtin_amdgcn_permlane16_swap(__float_as_uint(x), __float_as_uint(x), false, false); return __uint_as_float(rr[0]) + __uint_as_float(rr[1]); }
__device__ __forceinline__ float xsum32(float x) { auto rr = __builtin_amdgcn_permlane32_swap(__float_as_uint(x), __float_as_uint(x), false, false); return __uint_as_float(rr[0]) + __uint_as_float(rr[1]); }
__device__ __forceinline__ float reduce16pairs(const float (&p)[16], int lane) {
    const bool o1 = lane & 1, o2 = lane & 2;
    float a[8];
#pragma unroll
    for (int k = 0; k < 8; ++k) { const float keep = o1 ? p[2 * k + 1] : p[2 * k], send = o1 ? p[2 * k] : p[2 * k + 1]; a[k] = keep + DPP_XOR1(send); }
    float b[4];
#pragma unroll
    for (int k = 0; k < 4; ++k) { const float keep = o2 ? a[2 * k + 1] : a[2 * k], send = o2 ? a[2 * k] : a[2 * k + 1]; b[k] = keep + DPP_XOR2(send); }
#pragma unroll
    for (int k = 0; k < 4; ++k) { b[k] += DPP_ROR4(b[k]); b[k] += DPP_ROR8(b[k]); b[k] = xsum16(b[k]); }
    const int j = (lane >> 2) & 3;
    return j == 0 ? b[0] : (j == 1 ? b[1] : (j == 2 ? b[2] : b[3]));
}
typedef unsigned u32x16v __attribute__((ext_vector_type(16)));
__device__ __forceinline__ u32x6v ld24(const GAS unsigned char* p) {
    const v2u a = *(const GAS v2u*)p, b = *(const GAS v2u*)(p + 8), c = *(const GAS v2u*)(p + 16);
    return (u32x6v){a.x, a.y, b.x, b.y, c.x, c.y};
}
template <bool FP4> struct RowBuf { typedef u32x6v T; };
template <> struct RowBuf<true> { typedef v4u T; };
__device__ __forceinline__ void row_ld(v4u& r, const GAS unsigned char* T, unsigned row, unsigned q) { r = *(const GAS v4u*)(T + (row * 512u + 16u * q)); }
__device__ __forceinline__ void row_ld(u32x6v& r, const GAS unsigned char* T, unsigned row, unsigned q) { r = ld24(T + (row * 768u + 24u * q)); }
__device__ __forceinline__ u32x16v row_unpack(const v4u& r) {
    u32x16v f;
#pragma unroll
    for (int d = 0; d < 4; ++d) {
        f[4 * d + 0] = __builtin_bit_cast(unsigned, __builtin_amdgcn_cvt_scalef32_pk_bf16_fp4(r[d], 1.0f, 0));
        f[4 * d + 1] = __builtin_bit_cast(unsigned, __builtin_amdgcn_cvt_scalef32_pk_bf16_fp4(r[d], 1.0f, 1));
        f[4 * d + 2] = __builtin_bit_cast(unsigned, __builtin_amdgcn_cvt_scalef32_pk_bf16_fp4(r[d], 1.0f, 2));
        f[4 * d + 3] = __builtin_bit_cast(unsigned, __builtin_amdgcn_cvt_scalef32_pk_bf16_fp4(r[d], 1.0f, 3));
    }
    return f;
}
__device__ __forceinline__ u32x16v row_unpack(const u32x6v& r) { return __builtin_bit_cast(u32x16v, __builtin_amdgcn_cvt_scalef32_pk32_bf16_fp6(r, 1.0f)); }
template <int S, bool FP4>
__device__ __forceinline__ void pg_load(typename RowBuf<FP4>::T (&r)[8], const GAS unsigned char* T, int i0, int i1, bool up, unsigned q) {
    constexpr int bt = S >> 2, c = (S >> 1) & 1, sub = S & 1;
    const int idv = bt ? i1 : i0;
    constexpr int j0 = c * 16 + sub * 8;
    row_ld(r[0], T, (unsigned)__builtin_amdgcn_ds_swizzle(idv, (j0 + 0) << 5), q); row_ld(r[1], T, (unsigned)__builtin_amdgcn_ds_swizzle(idv, (j0 + 1) << 5), q);
    row_ld(r[2], T, (unsigned)__builtin_amdgcn_ds_swizzle(idv, (j0 + 2) << 5), q); row_ld(r[3], T, (unsigned)__builtin_amdgcn_ds_swizzle(idv, (j0 + 3) << 5), q);
    row_ld(r[4], T, (unsigned)__builtin_amdgcn_ds_swizzle(idv, (j0 + 4) << 5), q); row_ld(r[5], T, (unsigned)__builtin_amdgcn_ds_swizzle(idv, (j0 + 5) << 5), q);
    row_ld(r[6], T, (unsigned)__builtin_amdgcn_ds_swizzle(idv, (j0 + 6) << 5), q); row_ld(r[7], T, (unsigned)__builtin_amdgcn_ds_swizzle(idv, (j0 + 7) << 5), q);
#pragma unroll
    for (int k = 0; k < 8; ++k) {
    }
}
template <int S, bool FP4, bool LDO = false>
__device__ __forceinline__ void pg_dot(const typename RowBuf<FP4>::T (&r)[8], const unsigned (&h)[16], const f32x2 (&hf)[16], float (&p)[16]) {
    constexpr int sub = S & 1;
#pragma unroll
    for (int k = 0; k < 8; ++k) {
        if (LDO) { p[sub * 8 + k] = __uint_as_float((r[k][0] ^ r[k][1] ^ r[k][2] ^ r[k][3]) & 0x3fffffffu); }
        else if (FP4) {
            f32x2 s0 = {0.f, 0.f}, s1 = {0.f, 0.f};
#pragma unroll
            for (int d = 0; d < 4; ++d) {
                s0 += __builtin_amdgcn_cvt_scalef32_pk_f32_fp4(r[k][d], 1.0f, 0) * hf[4 * d + 0];
                s1 += __builtin_amdgcn_cvt_scalef32_pk_f32_fp4(r[k][d], 1.0f, 1) * hf[4 * d + 1];
                s0 += __builtin_amdgcn_cvt_scalef32_pk_f32_fp4(r[k][d], 1.0f, 2) * hf[4 * d + 2];
                s1 += __builtin_amdgcn_cvt_scalef32_pk_f32_fp4(r[k][d], 1.0f, 3) * hf[4 * d + 3];
            }
            const f32x2 t = s0 + s1;
            p[sub * 8 + k] = t.x + t.y;
        } else {
            const u32x16v f = row_unpack(r[k]);
            float s0 = 0.f, s1 = 0.f;
#pragma unroll
            for (int e = 0; e < 16; e += 2) { s0 = dot2bf(f[e], h[e], s0); s1 = dot2bf(f[e + 1], h[e + 1], s1); }
            p[sub * 8 + k] = s0 + s1;
        }
    }
}
template <int S, bool FP4, bool LDO = false>
__device__ __forceinline__ void pg_axpy(const typename RowBuf<FP4>::T (&r)[8], float wgt0, float wgt1, bool up, float (&acc)[32]) {
    constexpr int bt = S >> 2, c = (S >> 1) & 1, sub = S & 1;
    const float wgt = bt ? wgt1 : wgt0;
#pragma unroll
    for (int k = 0; k < 8; ++k) {
        if (LDO) { acc[(S * 8 + k) & 31] += __uint_as_float((r[k][0] ^ r[k][1] ^ r[k][2] ^ r[k][3]) & 0x3fffffffu); continue; }
        const float wA = __uint_as_float(__builtin_amdgcn_readlane(__float_as_uint(wgt), c * 16 + sub * 8 + k));
        const float wB = __uint_as_float(__builtin_amdgcn_readlane(__float_as_uint(wgt), 32 + c * 16 + sub * 8 + k));
        const float w = up ? wB : wA;
        if (FP4) {
            const f32x2 w2 = (f32x2){w, w};
#pragma unroll
            for (int d = 0; d < 4; ++d) {
                { const f32x2 f = __builtin_amdgcn_cvt_scalef32_pk_f32_fp4(r[k][d], 1.0f, 0); const f32x2 a = (f32x2){acc[8 * d + 0], acc[8 * d + 1]} + w2 * f; acc[8 * d + 0] = a.x; acc[8 * d + 1] = a.y; }
                { const f32x2 f = __builtin_amdgcn_cvt_scalef32_pk_f32_fp4(r[k][d], 1.0f, 1); const f32x2 a = (f32x2){acc[8 * d + 2], acc[8 * d + 3]} + w2 * f; acc[8 * d + 2] = a.x; acc[8 * d + 3] = a.y; }
                { const f32x2 f = __builtin_amdgcn_cvt_scalef32_pk_f32_fp4(r[k][d], 1.0f, 2); const f32x2 a = (f32x2){acc[8 * d + 4], acc[8 * d + 5]} + w2 * f; acc[8 * d + 4] = a.x; acc[8 * d + 5] = a.y; }
                { const f32x2 f = __builtin_amdgcn_cvt_scalef32_pk_f32_fp4(r[k][d], 1.0f, 3); const f32x2 a = (f32x2){acc[8 * d + 6], acc[8 * d + 7]} + w2 * f; acc[8 * d + 6] = a.x; acc[8 * d + 7] = a.y; }
            }
        } else {
            const unsigned wlo = f2bf(w), whi = wlo << 16;
            const u32x16v f = row_unpack(r[k]);
#pragma unroll
            for (int e = 0; e < 16; ++e) { acc[2 * e] = dot2bf(f[e], wlo, acc[2 * e]); acc[2 * e + 1] = dot2bf(f[e], whi, acc[2 * e + 1]); }
        }
    }
}
typedef _Float16 h2v __attribute__((ext_vector_type(2)));
template <int S, int PH = 0>
__device__ __forceinline__ void pg_axpy_h(const v4u (&r)[8], float wgt0, float wgt1, bool up, h2v (&acc)[16]) {
    constexpr int bt = S >> 2, c = (S >> 1) & 1, sub = S & 1, j0 = c * 16 + sub * 8;
    const int wp = __float_as_int(bt ? wgt1 : wgt0);
    const int wsw[8] = {__builtin_amdgcn_ds_swizzle(wp, (j0 + 0) << 5), __builtin_amdgcn_ds_swizzle(wp, (j0 + 1) << 5), __builtin_amdgcn_ds_swizzle(wp, (j0 + 2) << 5), __builtin_amdgcn_ds_swizzle(wp, (j0 + 3) << 5),
                        __builtin_amdgcn_ds_swizzle(wp, (j0 + 4) << 5), __builtin_amdgcn_ds_swizzle(wp, (j0 + 5) << 5), __builtin_amdgcn_ds_swizzle(wp, (j0 + 6) << 5), __builtin_amdgcn_ds_swizzle(wp, (j0 + 7) << 5)};
#pragma unroll
    for (int k = 0; k < 8; ++k) {
        const h2v wh = __builtin_bit_cast(h2v, wsw[k]);
        int f[16];
        if (PH & 2) {
#pragma unroll
            for (int e = 0; e < 16; ++e) f[e] = (int)(r[k][e & 3] & 0x3c003c00u) + e;
        } else
#pragma unroll
        for (int d = 0; d < 4; ++d) {
            f[4 * d + 0] = __builtin_bit_cast(int, __builtin_amdgcn_cvt_scalef32_pk_f16_fp4(r[k][d], 1.0f, 0));
            f[4 * d + 1] = __builtin_bit_cast(int, __builtin_amdgcn_cvt_scalef32_pk_f16_fp4(r[k][d], 1.0f, 1));
            f[4 * d + 2] = __builtin_bit_cast(int, __builtin_amdgcn_cvt_scalef32_pk_f16_fp4(r[k][d], 1.0f, 2));
            f[4 * d + 3] = __builtin_bit_cast(int, __builtin_amdgcn_cvt_scalef32_pk_f16_fp4(r[k][d], 1.0f, 3));
        }
        asm volatile("" : "+v"(f[0]), "+v"(f[1]), "+v"(f[2]), "+v"(f[3]), "+v"(f[4]), "+v"(f[5]), "+v"(f[6]), "+v"(f[7]), "+v"(f[8]), "+v"(f[9]), "+v"(f[10]), "+v"(f[11]), "+v"(f[12]), "+v"(f[13]), "+v"(f[14]), "+v"(f[15]));
        if (PH & 1) {
#pragma unroll
            for (int e = 0; e < 16; ++e) asm volatile("" :: "v"(f[e]));
            acc[k] = __builtin_bit_cast(h2v, f[k] ^ __builtin_bit_cast(int, wh));
        } else
#pragma unroll
        for (int e = 0; e < 16; ++e) acc[e] = __builtin_elementwise_fma(wh, __builtin_bit_cast(h2v, f[e]), acc[e]);
    }
}
template <bool LDO = false>
__device__ __forceinline__ void peer_gather_u(const Ctx& F, int l, size_t m, float& wgt0, float& wgt1, int rm = -1) {
    const int lane = F.lane, q = lane & 31;
    const bool up = lane >= 32;
    const GAS int* ip = F.IDX + m * 128; const GAS float* gp = F.GATE + m * 128;
    const int i0 = ip[lane] & rm, i1 = ip[64 + lane] & rm;
    const float ga0 = gp[lane], ga1 = gp[64 + lane];
    const GAS unsigned char* U = F.U8 + (size_t)l * 16384 * U_ROWB;
    typename RowBuf<U_FP4 != 0>::T ra[8], rb[8];
    pg_load<0, U_FP4 != 0>(ra, U, i0, i1, up, (unsigned)q);
    unsigned h[16];
    { const GAS bf16* hp = F.XN + m * DM + 32 * q;
#pragma unroll
      for (int j = 0; j < 4; ++j) { const v4u w = ld16(hp + 8 * j); h[4 * j] = w.x; h[4 * j + 1] = w.y; h[4 * j + 2] = w.z; h[4 * j + 3] = w.w; } }
    f32x2 hf[16];
#pragma unroll
    for (int i = 0; i < 16; ++i) hf[i] = (f32x2){bflo(h[i]), bfhi(h[i])};
    const GAS float* SU = F.SU + l * 16384; const GAS float* SV = F.SV + l * 16384;
    const float su0 = SU[i0], sv0 = SV[i0], su1 = SU[i1], sv1 = SV[i1];
    const int cl = (lane >> 4) & 1;
    float p[16]; float act0 = 0.f, act1 = 0.f, tot;
    pg_load<1, U_FP4 != 0>(rb, U, i0, i1, up, (unsigned)q); pg_dot<0, U_FP4 != 0, LDO>(ra, h, hf, p);
    pg_load<2, U_FP4 != 0>(ra, U, i0, i1, up, (unsigned)q); pg_dot<1, U_FP4 != 0, LDO>(rb, h, hf, p); tot = reduce16pairs(p, lane); act0 = (cl == 0) ? tot : act0;
    pg_load<3, U_FP4 != 0>(rb, U, i0, i1, up, (unsigned)q); pg_dot<2, U_FP4 != 0, LDO>(ra, h, hf, p);
    pg_load<4, U_FP4 != 0>(ra, U, i0, i1, up, (unsigned)q); pg_dot<3, U_FP4 != 0, LDO>(rb, h, hf, p); tot = reduce16pairs(p, lane); act0 = (cl == 1) ? tot : act0;
    pg_load<5, U_FP4 != 0>(rb, U, i0, i1, up, (unsigned)q); pg_dot<4, U_FP4 != 0, LDO>(ra, h, hf, p);
    pg_load<6, U_FP4 != 0>(ra, U, i0, i1, up, (unsigned)q); pg_dot<5, U_FP4 != 0, LDO>(rb, h, hf, p); tot = reduce16pairs(p, lane); act1 = (cl == 0) ? tot : act1;
    pg_load<7, U_FP4 != 0>(rb, U, i0, i1, up, (unsigned)q); pg_dot<6, U_FP4 != 0, LDO>(ra, h, hf, p);
    pg_dot<7, U_FP4 != 0, LDO>(rb, h, hf, p); tot = reduce16pairs(p, lane); act1 = (cl == 1) ? tot : act1;
    wgt0 = gelu_erf(act0 * su0) * ga0 * sv0;
    wgt1 = gelu_erf(act1 * su1) * ga1 * sv1;
}
template <bool XNOUT>
__device__ __forceinline__ void peer_v_finish_tot(const Ctx& F, size_t m, float (&tot)[16], const GAS float* g2, GAS float* dst_row, const GAS float* ng, const GAS float* nsh, const GAS float* nsc, bool ns, float osc);
template <bool XNOUT>
__device__ __forceinline__ void peer_v_finish(const Ctx& F, size_t m, float (&acc)[32], const GAS float* g2, GAS float* dst_row, const GAS float* ng, const GAS float* nsh, const GAS float* nsc, bool ns = false, float osc = 1.f) {
    float tot[16];
#pragma unroll
    for (int i = 0; i < 16; ++i) {
        auto rr = __builtin_amdgcn_permlane32_swap(__float_as_uint(acc[i]), __float_as_uint(acc[i + 16]), false, false);
        tot[i] = __uint_as_float(rr[0]) + __uint_as_float(rr[1]);
    }
    peer_v_finish_tot<XNOUT>(F, m, tot, g2, dst_row, ng, nsh, nsc, ns, osc);
}
template <bool XNOUT>
__device__ __forceinline__ void peer_v_finish_tot(const Ctx& F, size_t m, float (&tot)[16], const GAS float* g2, GAS float* dst_row, const GAS float* ng, const GAS float* nsh, const GAS float* nsc, bool ns, float osc) {
    const int lane = F.lane, q = lane & 31;
    const bool up = lane >= 32;
    const int k0 = 32 * q + (up ? 16 : 0);
    const GAS bf16* src = F.XS + m * DM + k0;
    const GAS float* gg = g2 + k0;
    float xin[16];
    { const v4u a = ld16(src), b = ld16(src + 8);
      xin[0] = bflo(a.x); xin[1] = bfhi(a.x); xin[2] = bflo(a.y); xin[3] = bfhi(a.y); xin[4] = bflo(a.z); xin[5] = bfhi(a.z); xin[6] = bflo(a.w); xin[7] = bfhi(a.w);
      xin[8] = bflo(b.x); xin[9] = bfhi(b.x); xin[10] = bflo(b.y); xin[11] = bfhi(b.y); xin[12] = bflo(b.z); xin[13] = bfhi(b.z); xin[14] = bflo(b.w); xin[15] = bfhi(b.w); }
    float ss = 0.f;
#pragma unroll
    for (int j = 0; j < 4; ++j) {
        const f32x4 ga = *(const GAS f32x4*)(gg + 4 * j);
#pragma unroll
        for (int e = 0; e < 4; ++e) { const float o = xin[4 * j + e] + ga[e] * tot[4 * j + e]; tot[4 * j + e] = o; ss += o * o; }
    }
    if (ns && ss != 1.2345e-30f) return;
    if (XNOUT) {
        GAS bf16* dp = F.XS + m * DM + k0;
        v4u w0, w1;
        w0.x = pk2(tot[0], tot[1]); w0.y = pk2(tot[2], tot[3]); w0.z = pk2(tot[4], tot[5]); w0.w = pk2(tot[6], tot[7]);
        w1.x = pk2(tot[8], tot[9]); w1.y = pk2(tot[10], tot[11]); w1.z = pk2(tot[12], tot[13]); w1.w = pk2(tot[14], tot[15]);
        *(GAS v4u*)dp = w0; *(GAS v4u*)(dp + 8) = w1;
    } else {
        GAS float* dp = dst_row + k0;
#pragma unroll
        for (int j = 0; j < 4; ++j) *(GAS f32x4*)(dp + 4 * j) = (f32x4){tot[4 * j] * osc, tot[4 * j + 1] * osc, tot[4 * j + 2] * osc, tot[4 * j + 3] * osc};
    }
    if (XNOUT) {
        const float r = 1.0f / sqrtf(wave_sum(ss) * (1.f / DM) + 1e-6f);
        GAS bf16* xo = F.XN + m * DM + k0;
#pragma unroll
        for (int j = 0; j < 2; ++j) {
            float o[8];
#pragma unroll
            for (int e = 0; e < 8; ++e) { const int k = 8 * j + e; o[e] = tot[k] * r * ng[k0 + k] * (1.f + nsc[k0 + k]) + nsh[k0 + k]; }
            v4u w; w.x = pk2(o[0], o[1]); w.y = pk2(o[2], o[3]); w.z = pk2(o[4], o[5]); w.w = pk2(o[6], o[7]);
            *(GAS v4u*)(xo + 8 * j) = w;
        }
    }
}
template <bool XNOUT, bool LDO = false>
__device__ __forceinline__ void peer_gather_v_idx(const Ctx& F, int l, size_t m, int i0, int i1, float wgt0, float wgt1, const GAS float* g2, GAS float* dst_row, const GAS float* ng, const GAS float* nsh, const GAS float* nsc, bool ns = false, float osc = 1.f) {
    const int lane = F.lane, q = lane & 31;
    const bool up = lane >= 32;
    const GAS unsigned char* V = F.V8 + (size_t)l * 16384 * V_ROWB;
    float acc[32];
#if VF16 && V_FP4
    if (!LDO) {
        const float sa = wave_sum(fabsf(wgt0) + fabsf(wgt1));
        int ke = 13 - (int)((__float_as_uint(sa * 6.0f) >> 23) & 0xff) + 127;
        ke = ke > 40 ? 40 : (ke < -40 ? -40 : ke);
        const float sc = __uint_as_float((unsigned)(127 + ke) << 23), isc = __uint_as_float((unsigned)(127 - ke) << 23);
        const float ws0 = __int_as_float(__builtin_bit_cast(int, __builtin_amdgcn_cvt_pkrtz(wgt0 * sc, wgt0 * sc))), ws1 = __int_as_float(__builtin_bit_cast(int, __builtin_amdgcn_cvt_pkrtz(wgt1 * sc, wgt1 * sc)));
        h2v ah[16];
#pragma unroll
        for (int k = 0; k < 16; ++k) ah[k] = (h2v){(_Float16)0.f, (_Float16)0.f};
        if (PROBE_VH && ns) {
        v4u ra[8], rb[8];
        pg_load<0, true>(ra, V, i0, i1, up, (unsigned)q);
        pg_load<1, true>(rb, V, i0, i1, up, (unsigned)q); pg_axpy_h<0, PROBE_VH>(ra, ws0, ws1, up, ah);
        pg_load<2, true>(ra, V, i0, i1, up, (unsigned)q); pg_axpy_h<1, PROBE_VH>(rb, ws0, ws1, up, ah);
        pg_load<3, true>(rb, V, i0, i1, up, (unsigned)q); pg_axpy_h<2, PROBE_VH>(ra, ws0, ws1, up, ah);
        pg_load<4, true>(ra, V, i0, i1, up, (unsigned)q); pg_axpy_h<3, PROBE_VH>(rb, ws0, ws1, up, ah);
        pg_load<5, true>(rb, V, i0, i1, up, (unsigned)q); pg_axpy_h<4, PROBE_VH>(ra, ws0, ws1, up, ah);
        pg_load<6, true>(ra, V, i0, i1, up, (unsigned)q); pg_axpy_h<5, PROBE_VH>(rb, ws0, ws1, up, ah);
        pg_load<7, true>(rb, V, i0, i1, up, (unsigned)q); pg_axpy_h<6, PROBE_VH>(ra, ws0, ws1, up, ah);
        pg_axpy_h<7, PROBE_VH>(rb, ws0, ws1, up, ah);
        } else {
        v4u ra[8], rb[8];
        pg_load<0, true>(ra, V, i0, i1, up, (unsigned)q);
        pg_load<1, true>(rb, V, i0, i1, up, (unsigned)q); pg_axpy_h<0>(ra, ws0, ws1, up, ah);
        pg_load<2, true>(ra, V, i0, i1, up, (unsigned)q); pg_axpy_h<1>(rb, ws0, ws1, up, ah);
        pg_load<3, true>(rb, V, i0, i1, up, (unsigned)q); pg_axpy_h<2>(ra, ws0, ws1, up, ah);
        pg_load<4, true>(ra, V, i0, i1, up, (unsigned)q); pg_axpy_h<3>(rb, ws0, ws1, up, ah);
        pg_load<5, true>(rb, V, i0, i1, up, (unsigned)q); pg_axpy_h<4>(ra, ws0, ws1, up, ah);
        pg_load<6, true>(ra, V, i0, i1, up, (unsigned)q); pg_axpy_h<5>(rb, ws0, ws1, up, ah);
        pg_load<7, true>(rb, V, i0, i1, up, (unsigned)q); pg_axpy_h<6>(ra, ws0, ws1, up, ah);
        pg_axpy_h<7>(rb, ws0, ws1, up, ah);
        }
#pragma unroll
        for (int k = 0; k < 16; ++k) { acc[2 * k] = (float)ah[k].x * isc; acc[2 * k + 1] = (float)ah[k].y * isc; }
        peer_v_finish<XNOUT>(F, m, acc, g2, dst_row, ng, nsh, nsc, ns, osc);
        return;
    }
#endif
#pragma unroll
    for (int k = 0; k < 32; ++k) acc[k] = 0.f;
    typename RowBuf<V_FP4 != 0>::T ra[8], rb[8];
    pg_load<0, V_FP4 != 0>(ra, V, i0, i1, up, (unsigned)q);
    pg_load<1, V_FP4 != 0>(rb, V, i0, i1, up, (unsigned)q); pg_axpy<0, V_FP4 != 0, LDO>(ra, wgt0, wgt1, up, acc);
    pg_load<2, V_FP4 != 0>(ra, V, i0, i1, up, (unsigned)q); pg_axpy<1, V_FP4 != 0, LDO>(rb, wgt0, wgt1, up, acc);
    pg_load<3, V_FP4 != 0>(rb, V, i0, i1, up, (unsigned)q); pg_axpy<2, V_FP4 != 0, LDO>(ra, wgt0, wgt1, up, acc);
    pg_load<4, V_FP4 != 0>(ra, V, i0, i1, up, (unsigned)q); pg_axpy<3, V_FP4 != 0, LDO>(rb, wgt0, wgt1, up, acc);
    pg_load<5, V_FP4 != 0>(rb, V, i0, i1, up, (unsigned)q); pg_axpy<4, V_FP4 != 0, LDO>(ra, wgt0, wgt1, up, acc);
    pg_load<6, V_FP4 != 0>(ra, V, i0, i1, up, (unsigned)q); pg_axpy<5, V_FP4 != 0, LDO>(rb, wgt0, wgt1, up, acc);
    pg_load<7, V_FP4 != 0>(rb, V, i0, i1, up, (unsigned)q); pg_axpy<6, V_FP4 != 0, LDO>(ra, wgt0, wgt1, up, acc);
    pg_axpy<7, V_FP4 != 0, LDO>(rb, wgt0, wgt1, up, acc);
    peer_v_finish<XNOUT>(F, m, acc, g2, dst_row, ng, nsh, nsc, ns, osc);
}
template <bool XNOUT>
__device__ __forceinline__ void peer_gather_v(const Ctx& F, int l, size_t m, float wgt0, float wgt1, const GAS float* g2, GAS float* dst_row, const GAS float* ng, const GAS float* nsh, const GAS float* nsc) {
    const GAS int* ip = F.IDX + m * 128;
    peer_gather_v_idx<XNOUT>(F, l, m, ip[F.lane], ip[64 + F.lane], wgt0, wgt1, g2, dst_row, ng, nsh, nsc);
}
template <int BT>
__device__ __forceinline__ float peer_gather_u_half(const Ctx& F, int l, size_t m) {
    const int lane = F.lane, q = lane & 31;
    const bool up = lane >= 32;
    const GAS int* ip = F.IDX + m * 128;
    const int i0 = ip[lane], i1 = ip[64 + lane];
    const float ga = F.GATE[m * 128 + BT * 64 + lane];
    const GAS unsigned char* U = F.U8 + (size_t)l * 16384 * U_ROWB;
    typename RowBuf<U_FP4 != 0>::T ra[8], rb[8];
    pg_load<4 * BT, U_FP4 != 0>(ra, U, i0, i1, up, (unsigned)q);
    unsigned h[16];
    { const GAS bf16* hp = F.XN + m * DM + 32 * q;
#pragma unroll
      for (int j = 0; j < 4; ++j) { const v4u w = ld16(hp + 8 * j); h[4 * j] = w.x; h[4 * j + 1] = w.y; h[4 * j + 2] = w.z; h[4 * j + 3] = w.w; } }
    f32x2 hf[16];
#pragma unroll
    for (int i = 0; i < 16; ++i) hf[i] = (f32x2){bflo(h[i]), bfhi(h[i])};
    const int ib = BT ? i1 : i0;
    const float su = F.SU[l * 16384 + ib], sv = F.SV[l * 16384 + ib];
    const int cl = (lane >> 4) & 1;
    float p[16]; float act = 0.f, tot;
    pg_load<4 * BT + 1, U_FP4 != 0>(rb, U, i0, i1, up, (unsigned)q); pg_dot<4 * BT, U_FP4 != 0>(ra, h, hf, p);
    pg_load<4 * BT + 2, U_FP4 != 0>(ra, U, i0, i1, up, (unsigned)q); pg_dot<4 * BT + 1, U_FP4 != 0>(rb, h, hf, p); tot = reduce16pairs(p, lane); act = (cl == 0) ? tot : act;
    pg_load<4 * BT + 3, U_FP4 != 0>(rb, U, i0, i1, up, (unsigned)q); pg_dot<4 * BT + 2, U_FP4 != 0>(ra, h, hf, p);
    pg_dot<4 * BT + 3, U_FP4 != 0>(rb, h, hf, p); tot = reduce16pairs(p, lane); act = (cl == 1) ? tot : act;
    return gelu_erf(act * su) * ga * sv;
}
template <int BT>
__device__ __forceinline__ void peer_gather_v_half(const Ctx& F, int l, size_t m, float wgt, float (&acc)[32]) {
    const int lane = F.lane, q = lane & 31;
    const bool up = lane >= 32;
    const GAS int* ip = F.IDX + m * 128;
    const int i0 = ip[lane], i1 = ip[64 + lane];
    const GAS unsigned char* V = F.V8 + (size_t)l * 16384 * V_ROWB;
#pragma unroll
    for (int k = 0; k < 32; ++k) acc[k] = 0.f;
    typename RowBuf<V_FP4 != 0>::T ra[8], rb[8];
    pg_load<4 * BT, V_FP4 != 0>(ra, V, i0, i1, up, (unsigned)q);
    pg_load<4 * BT + 1, V_FP4 != 0>(rb, V, i0, i1, up, (unsigned)q); pg_axpy<4 * BT, V_FP4 != 0>(ra, wgt, wgt, up, acc);
    pg_load<4 * BT + 2, V_FP4 != 0>(ra, V, i0, i1, up, (unsigned)q); pg_axpy<4 * BT + 1, V_FP4 != 0>(rb, wgt, wgt, up, acc);
    pg_load<4 * BT + 3, V_FP4 != 0>(rb, V, i0, i1, up, (unsigned)q); pg_axpy<4 * BT + 2, V_FP4 != 0>(ra, wgt, wgt, up, acc);
    pg_axpy<4 * BT + 3, V_FP4 != 0>(rb, wgt, wgt, up, acc);
}


typedef int v8i __attribute__((ext_vector_type(8)));
constexpr int UM_W = 0, UM_RB = (UMFMA == 2) ? 2048 : 4096, UM_RP = 528, UM_HB = UM_RB + 16 * UM_RP, UM_DBG = UM_HB + 2048;
constexpr int UM_STRIDE = (UMFMA == 2) ? 19456 : 16384;
template <int S>
__device__ __forceinline__ void um_consume(const v4u (&r)[8], LAS unsigned char* wl, const v4u (&bf)[8], float lsc, int lane, float& act0, float& act1, bool nowr = false) {
    constexpr int bt = S >> 2, cS = (S >> 1) & 1, sub = S & 1;
    const int q = lane & 31, up = lane >> 5;
    if (PROBE_UW && nowr) {
        unsigned x = 0;
#pragma unroll
        for (int k = 0; k < 8; ++k) x ^= r[k].x ^ r[k].y ^ r[k].z ^ r[k].w;
        if (x == 0x12345u) *(LAS unsigned*)(wl + UM_RB) = x;
    } else
#pragma unroll
    for (int k = 0; k < 8; ++k) *(LAS v4u*)(wl + UM_RB + (k + 8 * up) * UM_RP + 16 * q) = r[k];
    const int i = lane & 15, g = lane >> 4;
    f32x4 c0 = {0.f, 0.f, 0.f, 0.f}, c1 = {0.f, 0.f, 0.f, 0.f};
#pragma unroll
    for (int c = 0; c < 8; ++c) {
        const v4u a = *(LAS const v4u*)(wl + UM_RB + i * UM_RP + 64 * c + 16 * g);
        const v8i a8 = {(int)a.x, (int)a.y, (int)a.z, (int)a.w, 0, 0, 0, 0};
        const v8i b8 = {(int)bf[c].x, (int)bf[c].y, (int)bf[c].z, (int)bf[c].w, 0, 0, 0, 0};
        if (c & 1) c1 = __builtin_amdgcn_mfma_scale_f32_16x16x128_f8f6f4(a8, b8, c1, 4, 4, 0, 0x7F7F7F7F, 0, 0x7F7F7F7F);
        else       c0 = __builtin_amdgcn_mfma_scale_f32_16x16x128_f8f6f4(a8, b8, c0, 4, 4, 0, 0x7F7F7F7F, 0, 0x7F7F7F7F);
    }
    float t[4];
#pragma unroll
    for (int rr = 0; rr < 4; ++rr) { float x = (c0[rr] + c1[rr]) * lsc; x += DPP_XOR1(x); x += DPP_XOR2(x); t[rr] = x; }
    const int sel = lane & 3;
    const float v = sel == 0 ? t[0] : (sel == 1 ? t[1] : (sel == 2 ? t[2] : t[3]));
    const float tot = __shfl(v, 16 * (((lane & 7) >> 2) + 2 * (lane >> 5)) + (lane & 3));
    const bool mine = (((lane >> 4) & 1) == cS) && (((lane >> 3) & 1) == sub);
    if (bt == 0) act0 = mine ? tot : act0; else act1 = mine ? tot : act1;
}
__device__ __forceinline__ void peer_gather_u_mfma(const Ctx& F, int l, size_t m, LAS unsigned char* wl, float& wgt0, float& wgt1, int rm = -1) {
    const int lane = F.lane, q = lane & 31;
    const bool up = lane >= 32;
    const GAS int* ip = F.IDX + m * 128; const GAS float* gp = F.GATE + m * 128;
    const int i0 = ip[lane] & rm, i1 = ip[64 + lane] & rm;
    const float ga0 = gp[lane], ga1 = gp[64 + lane];
    const GAS unsigned char* U = F.U8 + (size_t)l * 16384 * U_ROWB;
    v4u ra[8], rb[8];
    pg_load<0, true>(ra, U, i0, i1, up, (unsigned)q);
    float s1;
    { const GAS bf16* hp = F.XN + m * DM + 16 * lane;
      const v4u w0 = ld16(hp), w1 = ld16(hp + 8);
      const unsigned ws[8] = {w0.x, w0.y, w0.z, w0.w, w1.x, w1.y, w1.z, w1.w};
      f32x2 rr[8]; float am = 0.f;
#pragma unroll
      for (int j = 0; j < 8; ++j) { rr[j] = (f32x2){bflo(ws[j]), bfhi(ws[j])}; am = fmaxf(am, fmaxf(fabsf(rr[j].x), fabsf(rr[j].y))); }
#pragma unroll
      for (int o = 32; o > 0; o >>= 1) am = fmaxf(am, __shfl_xor(am, o));
      s1 = am > 0.f ? am * (1.0f / 6.0f) : 1.0f;
      float sc = s1, inv = 1.0f / s1;
#pragma unroll
      for (int n = 0; n < 4; ++n) {
          unsigned pk0 = 0, pk1 = 0;
          const f32x2 inv2 = (f32x2){inv, inv}, sc2 = (f32x2){sc, sc};
#define UM_Q(PK, J, SEL) { const f32x2 tq = rr[J] * inv2; PK = __builtin_amdgcn_cvt_scalef32_pk_fp4_f32(PK, tq.x, tq.y, 1.0f, SEL); const f32x2 back = __builtin_amdgcn_cvt_scalef32_pk_f32_fp4(PK, 1.0f, SEL); rr[J] = rr[J] - back * sc2; }
          UM_Q(pk0, 0, 0) UM_Q(pk0, 1, 1) UM_Q(pk0, 2, 2) UM_Q(pk0, 3, 3) UM_Q(pk1, 4, 0) UM_Q(pk1, 5, 1) UM_Q(pk1, 6, 2) UM_Q(pk1, 7, 3)
#undef UM_Q
          *(LAS v2u*)(wl + UM_HB + n * 512 + 8 * lane) = (v2u){pk0, pk1};
          sc *= (1.0f / 6.0f); inv *= 6.0f;
      } }
    pg_load<1, true>(rb, U, i0, i1, up, (unsigned)q);
    const GAS float* SU = F.SU + l * 16384; const GAS float* SV = F.SV + l * 16384;
    const float su0 = SU[i0], sv0 = SV[i0], su1 = SU[i1], sv1 = SV[i1];
    v4u bf[8];
    { const int g = lane >> 4, n = lane & 3;
#pragma unroll
      for (int c = 0; c < 8; ++c) bf[c] = *(LAS const v4u*)(wl + UM_HB + n * 512 + 64 * c + 16 * g); }
    const int nn = lane & 15;
    const float lsc = nn == 0 ? s1 : (nn == 1 ? s1 * (1.0f / 6.0f) : (nn == 2 ? s1 * (1.0f / 36.0f) : (nn == 3 ? s1 * (1.0f / 216.0f) : 0.f)));
    float act0 = 0.f, act1 = 0.f;
    um_consume<0>(ra, wl, bf, lsc, lane, act0, act1, rm == 0x7fffffff);
    pg_load<2, true>(ra, U, i0, i1, up, (unsigned)q); um_consume<1>(rb, wl, bf, lsc, lane, act0, act1, rm == 0x7fffffff);
    pg_load<3, true>(rb, U, i0, i1, up, (unsigned)q); um_consume<2>(ra, wl, bf, lsc, lane, act0, act1, rm == 0x7fffffff);
    pg_load<4, true>(ra, U, i0, i1, up, (unsigned)q); um_consume<3>(rb, wl, bf, lsc, lane, act0, act1, rm == 0x7fffffff);
    pg_load<5, true>(rb, U, i0, i1, up, (unsigned)q); um_consume<4>(ra, wl, bf, lsc, lane, act0, act1, rm == 0x7fffffff);
    pg_load<6, true>(ra, U, i0, i1, up, (unsigned)q); um_consume<5>(rb, wl, bf, lsc, lane, act0, act1, rm == 0x7fffffff);
    pg_load<7, true>(rb, U, i0, i1, up, (unsigned)q); um_consume<6>(ra, wl, bf, lsc, lane, act0, act1, rm == 0x7fffffff);
    um_consume<7>(rb, wl, bf, lsc, lane, act0, act1, rm == 0x7fffffff);
    wgt0 = gelu_erf(act0 * su0) * ga0 * sv0;
    wgt1 = gelu_erf(act1 * su1) * ga1 * sv1;
}

__device__ __forceinline__ void um_h_to_lds(const v4u& w0, const v4u& w1, LAS unsigned char* wl, int lane, float& s1) {
    const unsigned ws[8] = {w0.x, w0.y, w0.z, w0.w, w1.x, w1.y, w1.z, w1.w};
    f32x2 rr[8]; float am = 0.f;
#pragma unroll
    for (int j = 0; j < 8; ++j) { rr[j] = (f32x2){bflo(ws[j]), bfhi(ws[j])}; am = fmaxf(am, fmaxf(fabsf(rr[j].x), fabsf(rr[j].y))); }
#pragma unroll
    for (int o = 32; o > 0; o >>= 1) am = fmaxf(am, __shfl_xor(am, o));
    s1 = am > 0.f ? am * (1.0f / 6.0f) : 1.0f;
    float sc = s1, inv = 1.0f / s1;
#pragma unroll
    for (int n = 0; n < 4; ++n) {
        unsigned pk0 = 0, pk1 = 0;
        const f32x2 inv2 = (f32x2){inv, inv}, sc2 = (f32x2){sc, sc};
#define UM_Q(PK, J, SEL) { const f32x2 tq = rr[J] * inv2; PK = __builtin_amdgcn_cvt_scalef32_pk_fp4_f32(PK, tq.x, tq.y, 1.0f, SEL); const f32x2 back = __builtin_amdgcn_cvt_scalef32_pk_f32_fp4(PK, 1.0f, SEL); rr[J] = rr[J] - back * sc2; }
        UM_Q(pk0, 0, 0) UM_Q(pk0, 1, 1) UM_Q(pk0, 2, 2) UM_Q(pk0, 3, 3) UM_Q(pk1, 4, 0) UM_Q(pk1, 5, 1) UM_Q(pk1, 6, 2) UM_Q(pk1, 7, 3)
#undef UM_Q
        *(LAS v2u*)(wl + UM_HB + n * 512 + 8 * lane) = (v2u){pk0, pk1};
        sc *= (1.0f / 6.0f); inv *= 6.0f;
    }
}
template <bool WBF16>
__device__ __forceinline__ void peer_u_pass_mfma_stream(const Ctx& F, int l, int Mown, int gw, int ngw, LAS unsigned char* wl) {
    const int lane = F.lane, q = lane & 31;
    const bool up = lane >= 32;
    const int ntok = gw < Mown ? (Mown - gw + ngw - 1) / ngw : 0;
    if (ntok == 0) return;
    const GAS unsigned char* U = F.U8 + (size_t)l * 16384 * U_ROWB;
    const GAS float* SU = F.SU + l * 16384; const GAS float* SV = F.SV + l * 16384;
    v4u b0[8], b1[8], b2[8], b3[8];
    size_t m = (size_t)gw;
    int ci0 = F.IDX[m * 128 + lane], ci1 = F.IDX[m * 128 + 64 + lane];
    pg_load<0, true>(b0, U, ci0, ci1, up, (unsigned)q); pg_load<1, true>(b1, U, ci0, ci1, up, (unsigned)q); pg_load<2, true>(b2, U, ci0, ci1, up, (unsigned)q);
    v4u hA = ld16(F.XN + m * DM + 16 * lane), hB = ld16(F.XN + m * DM + 16 * lane + 8);
    float ga0 = F.GATE[m * 128 + lane], ga1 = F.GATE[m * 128 + 64 + lane];
    float su0 = SU[ci0], sv0 = SV[ci0], su1 = SU[ci1], sv1 = SV[ci1];
#pragma unroll 1
    for (int t = 0; t < ntok; ++t) {
        const bool has_next = t + 1 < ntok;
        const size_t mn = m + (size_t)ngw;
        int ni0 = ci0, ni1 = ci1;
        if (has_next) { ni0 = F.IDX[mn * 128 + lane]; ni1 = F.IDX[mn * 128 + 64 + lane]; }
        float s1;
        um_h_to_lds(hA, hB, wl, lane, s1);
        v4u bf[8];
        { const int g = lane >> 4, n = lane & 3;
#pragma unroll
          for (int c = 0; c < 8; ++c) bf[c] = *(LAS const v4u*)(wl + UM_HB + n * 512 + 64 * c + 16 * g); }
        const int nn = lane & 15;
        const float lsc = nn == 0 ? s1 : (nn == 1 ? s1 * (1.0f / 6.0f) : (nn == 2 ? s1 * (1.0f / 36.0f) : (nn == 3 ? s1 * (1.0f / 216.0f) : 0.f)));
        float act0 = 0.f, act1 = 0.f;
        pg_load<3, true>(b3, U, ci0, ci1, up, (unsigned)q); um_consume<0>(b0, wl, bf, lsc, lane, act0, act1);
        pg_load<4, true>(b0, U, ci0, ci1, up, (unsigned)q); um_consume<1>(b1, wl, bf, lsc, lane, act0, act1);
        pg_load<5, true>(b1, U, ci0, ci1, up, (unsigned)q); um_consume<2>(b2, wl, bf, lsc, lane, act0, act1);
        pg_load<6, true>(b2, U, ci0, ci1, up, (unsigned)q); um_consume<3>(b3, wl, bf, lsc, lane, act0, act1);
        float nga0 = 0.f, nga1 = 0.f, nsu0 = 0.f, nsv0 = 0.f, nsu1 = 0.f, nsv1 = 0.f;
        if (has_next) {
            hA = ld16(F.XN + mn * DM + 16 * lane); hB = ld16(F.XN + mn * DM + 16 * lane + 8);
            nga0 = F.GATE[mn * 128 + lane]; nga1 = F.GATE[mn * 128 + 64 + lane];
            nsu0 = SU[ni0]; nsv0 = SV[ni0]; nsu1 = SU[ni1]; nsv1 = SV[ni1];
        }
        pg_load<7, true>(b3, U, ci0, ci1, up, (unsigned)q); um_consume<4>(b0, wl, bf, lsc, lane, act0, act1);
        if (has_next) pg_load<0, true>(b0, U, ni0, ni1, up, (unsigned)q);
        um_consume<5>(b1, wl, bf, lsc, lane, act0, act1);
        if (has_next) pg_load<1, true>(b1, U, ni0, ni1, up, (unsigned)q);
        um_consume<6>(b2, wl, bf, lsc, lane, act0, act1);
        if (has_next) pg_load<2, true>(b2, U, ni0, ni1, up, (unsigned)q);
        um_consume<7>(b3, wl, bf, lsc, lane, act0, act1);
        const float w0 = gelu_erf(act0 * su0) * ga0 * sv0, w1 = gelu_erf(act1 * su1) * ga1 * sv1;
        if (WBF16) { ((LAS unsigned short*)(wl + UM_W))[t * 128 + lane] = (unsigned short)f2bf(w0); ((LAS unsigned short*)(wl + UM_W))[t * 128 + 64 + lane] = (unsigned short)f2bf(w1); }
        else { ((LAS float*)(wl + UM_W))[t * 128 + lane] = w0; ((LAS float*)(wl + UM_W))[t * 128 + 64 + lane] = w1; }
        ci0 = ni0; ci1 = ni1; ga0 = nga0; ga1 = nga1; su0 = nsu0; sv0 = nsv0; su1 = nsu1; sv1 = nsv1; m = mn;
    }
}
#ifndef MK_N_LAUNCHES
#define MK_N_LAUNCHES 1
#endif
constexpr int NPH = 21;
#ifndef GEMM_ALIGN
#define GEMM_ALIGN true
#endif
#ifndef GEMM_SP2
#define GEMM_SP2 true
#endif
__host__ __device__ constexpr int rep_of(int k) { return ((PROBE_MASK >> k) & 1) ? PROBE_N : 1; }
constexpr int LDS_BYTES = 163840;
constexpr int LDSCTL_OFF = 155648, MISC_OFF = LDSCTL_OFF + 320;
struct Args { const float* in[23]; float* out; unsigned char* ws; int ph_lo, ph_hi; };


#define CAS __attribute__((address_space(4)))
__device__ __forceinline__ Ctx make_ctx(const CAS Args* ap, LAS unsigned char* lds) {
    Ctx F;
    F.lds = lds;
    { int t_ = threadIdx.x; asm volatile("" : "+v"(t_)); F.tid = t_; } F.lane = F.tid & 63; F.wave = __builtin_amdgcn_readfirstlane(F.tid >> 6);
    F.G = gridDim.x;
    { int bx = blockIdx.x; asm volatile("" : "+s"(bx)); const int vcu = (F.G % 8 == 0) ? (bx % 8) * (F.G / 8) + bx / 8 : bx; F.gw = vcu * NWAVES + F.wave; F.ngw = F.G * NWAVES; }
#define GIN(i) ((const GAS float*)ap->in[i])
    F.x = GIN(0); F.c = GIN(1); F.ctx = GIN(2); F.c_ctx = GIN(3); F.mod_w = GIN(4); F.mod_b = GIN(5); F.norm1_g = GIN(6); F.norm2_g = GIN(7);
    F.ab_w_in = GIN(8); F.ab_w_out = GIN(9); F.na_q_norm = GIN(10); F.na_k_norm = GIN(11); F.na_rpb = GIN(12); F.ret_log_decay = GIN(13);
    F.swa_w_in = GIN(14); F.swa_w_out = GIN(15); F.swa_q_norm = GIN(16); F.swa_k_norm = GIN(17); F.swa_sink = GIN(18);
    F.peer_w_q = GIN(19); F.peer_sub_keys = GIN(20); F.peer_u = GIN(21); F.peer_v = GIN(22);
#undef GIN
    F.out = (GAS float*)ap->out;
    GAS unsigned char* ws = (GAS unsigned char*)ap->ws;
    F.MOD = (GAS float*)(ws + WS_MOD); F.ROPE = (GAS float*)(ws + WS_ROPE); F.SUBK = (GAS bf16*)(ws + WS_SUBK);
    F.WIN0 = (GAS bf16*)(ws + WS_WIN0); F.WOUT0 = (GAS bf16*)(ws + WS_WOUT0); F.WQ0 = (GAS bf16*)(ws + WS_WQ0); F.WIN1 = (GAS bf16*)(ws + WS_WIN1); F.WOUT1 = (GAS bf16*)(ws + WS_WOUT1); F.WQ1 = (GAS bf16*)(ws + WS_WQ1);
    F.U8 = ws + WS_U; F.V8 = ws + WS_V; F.SU = (GAS float*)(ws + WS_SU); F.SV = (GAS float*)(ws + WS_SV); F.XN = (GAS bf16*)(ws + WS_XN); F.XS = (GAS bf16*)(ws + WS_XS); F.P = (GAS bf16*)(ws + WS_P); F.Q2 = (GAS bf16*)(ws + WS_Q2);
    F.IDX = (GAS int*)(ws + WS_IDX); F.GATE = (GAS float*)(ws + WS_GATE); F.TAV = (GAS bf16*)(ws + WS_TAV); F.TBK = (GAS bf16*)(ws + WS_TBK); F.TBV = (GAS bf16*)(ws + WS_TBV);
    F.KV = (GAS float*)(ws + WS_KV); F.ST = (GAS bf16*)(ws + WS_ST);
    return F;
}
#define PHASE_CTX const CAS Args* ap_ = (const CAS Args*)__builtin_amdgcn_kernarg_segment_ptr(); asm volatile("" : "+s"(ap_)); const Ctx F = make_ctx(ap_, (LAS unsigned char*)lds_raw); \
    LAS unsigned char* wl = F.lds + F.wave * 16384; (void)wl;

template <int L> __device__ __forceinline__ void peer_phases(int lo, int hi, unsigned char* lds_raw, const XcdBarrier& bar);

__global__ void __launch_bounds__(NTHR, 2) mk_fwd(Args args) {
    extern __shared__ __attribute__((aligned(16))) unsigned char lds_raw[];
    for (int u = threadIdx.x; u < (LDS_BYTES - LDSCTL_OFF) / 4; u += NTHR) ((LAS unsigned*)((LAS unsigned char*)lds_raw + LDSCTL_OFF))[u] = 0u;
    __syncthreads();
    const int lo = args.ph_lo, hi = args.ph_hi;
    const bool multi = (hi - lo) > 1;
    XcdBarrier bar; bar.bar = (unsigned*)(args.ws + WS_CTL) + CW_BAR; bar.x = 0; bar.st = nullptr;
    if (multi) bar = xcd_barrier_post((unsigned*)(args.ws + WS_CTL) + CW_BAR, (volatile LAS unsigned*)((LAS unsigned char*)lds_raw + MISC_OFF) + 8);
#define IN(k) (lo <= (k) && (k) < hi)
#define SEAM(k) do { if (IN(k) && IN((k) + 1)) { xcd_barrier(bar); if (PROBE_BAR) { xcd_barrier(bar); xcd_barrier(bar); } } } while (0)

    if (IN(0)) for (int rep_ = 0; rep_ < rep_of(0); ++rep_) { PHASE_CTX p0_prologue(F); }
    SEAM(0);
    if (IN(1)) for (int rep_ = 0; rep_ < rep_of(1); ++rep_) { PHASE_CTX mod_phase<false>(F, F.x, F.ctx, MALL, F.norm1_g, F.MOD, 0, 1); }
    SEAM(1);
    if (IN(2)) for (int rep_ = 0; rep_ < rep_of(2); ++rep_) { PHASE_CTX pg8::Gemm g{F.XN, F.WIN0, MALL, AB_IN, DM}; pg8::StaticOrder S; S.init(MALL, AB_IN, F.G, (int)blockIdx.x);
        pg8::EpiBf16<0> E{F.P, AB_IN, nullptr, 0, 0, 1.f};
        pg8::gemm_phase<pg8::EpiBf16<0>, pg8::StaticOrder, GEMM_ALIGN, GEMM_SP2>(F.lds, g, S, E);
        if (rep_ == 0) { int ns; const int sl = idle_slot((MALL / 256) * (AB_IN / 256), F.G, (int)blockIdx.x, ns); if (sl >= 0) side_transposes(F, sl, ns); } }
    SEAM(2);
    if (IN(3)) for (int rep_ = 0; rep_ < rep_of(3); ++rep_) { PHASE_CTX
        for (int it = F.gw; it < 272 * 48; it += F.ngw) {
            const int tt = it / 48, s = it % 48, kind = s >> 3, hd = s & 7;
            PostSlot S;
            S.col = kind * 512 + hd * 64; S.nheads = 8; S.head = hd; S.nw = nullptr; S.rope = 0; S.scale = 1.f; S.tdst = nullptr; S.write_nat = 1;
            if (kind == 0) { S.nw = F.na_q_norm; S.scale = 0.125f; }
            else if (kind == 1) { S.nw = F.na_k_norm; }
            else if (kind == 2) { S.tdst = F.TAV; S.write_nat = 0; }
            else if (kind == 3) { S.rope = 1; S.scale = 0.125f; }
            else if (kind == 4) { S.rope = 1; S.tdst = F.TBK; }
            else { S.tdst = F.TBV; S.write_nat = 0; }
            post_item(F, F.P, AB_IN, tt, S, wl);
        } }
    SEAM(3);
    if (IN(4)) for (int rep_ = 0; rep_ < rep_of(4); ++rep_) { PHASE_CTX
        na_phase(F);
        for (int v = F.gw; v < 2176; v += F.ngw) { const int dir = v & 1, pf = (v >> 1) % 34, bh = (v >> 1) / 34; ret_r1_unit(F, bh, pf, dir); } }
    SEAM(4);
    if (IN(5)) for (int rep_ = 0; rep_ < rep_of(5); ++rep_) { PHASE_CTX ret_r2(F); }
    SEAM(5);
    if (IN(6)) for (int rep_ = 0; rep_ < rep_of(6); ++rep_) { PHASE_CTX ret_r3_phase(F); }
    SEAM(6);
    if (IN(7)) for (int rep_ = 0; rep_ < rep_of(7); ++rep_) { PHASE_CTX pg8::Gemm g{F.XN, F.WOUT0, MALL, DM, DM}; pg8::StaticOrder S; S.init(MALL, DM, F.G, (int)blockIdx.x);
        pg8::EpiRes<false> E{F.x, F.ctx, F.XS, F.MOD + 2 * 1024};
        pg8::gemm_phase<pg8::EpiRes<false>, pg8::StaticOrder, GEMM_ALIGN, GEMM_SP2>(F.lds, g, S, E);
        if (rep_ == 0) side_convert(F, 0); }
    SEAM(7);
    peer_phases<0>(lo, hi, lds_raw, bar);
    SEAM(11);
    if (IN(13)) for (int rep_ = 0; rep_ < rep_of(13); ++rep_) { PHASE_CTX pg8::Gemm g{F.XN, F.WIN1, MALL, SWA_IN, DM}; pg8::StaticOrder S; S.init(MALL, SWA_IN, F.G, (int)blockIdx.x);
        pg8::EpiBf16<0> E{F.P, SWA_IN, nullptr, 0, 0, 1.f};
        pg8::gemm_phase<pg8::EpiBf16<0>, pg8::StaticOrder, GEMM_ALIGN, GEMM_SP2>(F.lds, g, S, E); }
    SEAM(13);
    if (IN(14)) for (int rep_ = 0; rep_ < rep_of(14); ++rep_) { PHASE_CTX
        for (int it = F.gw; it < 272 * 24; it += F.ngw) {
            const int tt = it / 24, s = it % 24;
            PostSlot S;
            S.col = s * 64; S.nheads = 4; S.head = s & 3; S.nw = nullptr; S.rope = 0; S.scale = 1.f; S.tdst = nullptr; S.write_nat = 1;
            if (s < 16) { S.nw = F.swa_q_norm; S.rope = 1; S.scale = 0.125f; }
            else if (s < 20) { S.nw = F.swa_k_norm; S.rope = 1; }
            else { S.tdst = F.TAV; S.write_nat = 0; }
            post_item(F, F.P, SWA_IN, tt, S, wl);
        } }
    SEAM(14);
    if (IN(15)) for (int rep_ = 0; rep_ < rep_of(15); ++rep_) { PHASE_CTX swa_phase(F); }
    SEAM(15);
    if (IN(16)) for (int rep_ = 0; rep_ < rep_of(16); ++rep_) { PHASE_CTX pg8::Gemm g{F.XN, F.WOUT1, MLAT, DM, DM}; pg8::StaticOrder S; S.init(MLAT, DM, F.G, (int)blockIdx.x);
        pg8::EpiRes<true> E{nullptr, nullptr, F.XS, F.MOD + 5 * MODW + 2 * 1024};
        pg8::gemm_phase<pg8::EpiRes<true>, pg8::StaticOrder, GEMM_ALIGN, GEMM_SP2>(F.lds, g, S, E); }
    SEAM(16);
    peer_phases<1>(lo, hi, lds_raw, bar);
}
template <int L> __device__ __forceinline__ void peer_phases(int lo, int hi, unsigned char* lds_raw, const XcdBarrier& bar) {
    constexpr int q0 = L == 0 ? 8 : 17;
    constexpr int Mp = L == 0 ? MALL : MLAT;
    if (IN(q0)) for (int rep_ = 0; rep_ < rep_of(q0); ++rep_) { PHASE_CTX mod_phase<true>(F, nullptr, nullptr, Mp, F.norm2_g + (size_t)L * DM, F.MOD + (size_t)L * 5 * MODW, 3, 4); }
    SEAM(q0);
    if (IN(q0 + 1)) for (int rep_ = 0; rep_ < rep_of(q0 + 1); ++rep_) { PHASE_CTX pg8::Gemm g{F.XN, L == 0 ? F.WQ0 : F.WQ1, Mp, PQD, DM}; pg8::StaticOrder S; S.init(Mp, PQD, F.G, (int)blockIdx.x);
        pg8::EpiBf16<0> E{F.Q2, PQD, nullptr, 0, 0, 1.f};
        pg8::gemm_phase<pg8::EpiBf16<0>, pg8::StaticOrder, GEMM_ALIGN, GEMM_SP2>(F.lds, g, S, E);
        if (L == 0 && rep_ == 0) side_convert(F, 1); }
    SEAM(q0 + 1);
    if (IN(q0 + 2)) for (int rep_ = 0; rep_ < rep_of(q0 + 2); ++rep_) { PHASE_CTX peer_score_phase(F, L, Mp); }
    SEAM(q0 + 2);
    if (IN(q0 + 3)) for (int rep_ = 0; rep_ < rep_of(q0 + 3); ++rep_) { PHASE_CTX
        const GAS float* mod_l = F.MOD + (size_t)L * 5 * MODW;
        const bool part_ = true; const int gw_ = F.gw, ngw_ = F.ngw;
        if (part_) {
        LAS float* wsl = (LAS float*)wl;
        const bool shared4 = (L == 0) && (F.G == 256) && (PROBE_HALF == 0);
        const int Mown = shared4 ? MLAT : Mp;
        const int rm_ = (PROBE_RM && rep_) ? PROBE_RM : -1;
        const bool ns_ = (PROBE_RM || PROBE_VH) && rep_;
        for (int mb_ = gw_; mb_ < Mown; mb_ += ((UMFMA == 1) ? 8 : 4096) * ngw_) {
        const int me_ = (UMFMA == 1 && Mown - mb_ > 8 * ngw_) ? mb_ + 8 * ngw_ : Mown;
        { int nt = 0;
          for (int m = mb_; m < me_; m += ngw_, ++nt) { float w0, w1; peer_gather_u_mfma(F, L, (size_t)m, wl, w0, w1);
            wsl[nt * 128 + F.lane] = w0; wsl[nt * 128 + 64 + F.lane] = w1; } }
        LDS_WAIT();
        { int nt = 0;
          for (int m = mb_; m < me_; m += ngw_, ++nt) {
            const int cond = m < MLAT ? (m >> 12) : 4;
            const float w0 = wsl[nt * 128 + F.lane], w1 = wsl[nt * 128 + 64 + F.lane];
            const int vi0 = F.IDX[(size_t)m * 128 + F.lane] & rm_, vi1 = F.IDX[(size_t)m * 128 + 64 + F.lane] & rm_;
            if (L == 0) {
                const GAS float* mod1 = F.MOD + (size_t)5 * MODW + (size_t)cond * MODW;
                peer_gather_v_idx<true>(F, L, (size_t)m, vi0, vi1, w0, w1, mod_l + (size_t)cond * MODW + 5 * 1024, nullptr, F.norm1_g + DM, mod1, mod1 + 1024, ns_);
            } else {
                peer_gather_v_idx<false>(F, L, (size_t)m, vi0, vi1, w0, w1, mod_l + (size_t)cond * MODW + 5 * 1024, F.out + (size_t)m * DM, nullptr, nullptr, nullptr, ns_);
            }
          } }
        LDS_WAIT();
        }
        if (L == 0 && shared4) {
            const int vcu = F.gw >> 3, j = F.wave >> 1, bt = F.wave & 1;
            const size_t m = (size_t)MLAT + (size_t)vcu * 4 + j;
            float acc[32];
            if (bt == 0) { const float w = peer_gather_u_half<0>(F, L, m); peer_gather_v_half<0>(F, L, m, w, acc); }
            else { const float w = peer_gather_u_half<1>(F, L, m); peer_gather_v_half<1>(F, L, m, w, acc); }
            LAS float* xch = (LAS float*)(F.lds + (2 * j + 1) * 16384 + 8192);
            if (bt == 1) {
#pragma unroll
                for (int k = 0; k < 32; ++k) xch[k * 64 + F.lane] = acc[k];
            }
            __syncthreads();
            if (bt == 0) {
#pragma unroll
                for (int k = 0; k < 32; ++k) acc[k] += xch[k * 64 + F.lane];
                const GAS float* mod1 = F.MOD + (size_t)5 * MODW + (size_t)4 * MODW;
                peer_v_finish<true>(F, m, acc, mod_l + (size_t)4 * MODW + 5 * 1024, nullptr, F.norm1_g + DM, mod1, mod1 + 1024);
            }
        }
        }
    }
}
#undef IN
#undef SEAM

extern "C" void kernel_launch(void* const* d_in, const int* in_sizes, int n_in, void* d_out, int out_size, void* d_ws, size_t ws_size, hipStream_t stream) {
    static int grid = 0;
    if (grid == 0) {
        if (n_in != 23 || out_size != MLAT * DM || ws_size < WS_END) { fprintf(stderr, "kernel_launch: unexpected shapes (n_in %d, out %d, ws %zu); nothing launched\n", n_in, out_size, ws_size); grid = -1; return; }
        int dev = 0, cus = 0, per_cu = 0;
        if (hipGetDevice(&dev) != hipSuccess || hipDeviceGetAttribute(&cus, hipDeviceAttributeMultiprocessorCount, dev) != hipSuccess) { grid = -1; return; }
        if (hipFuncSetAttribute((const void*)mk_fwd, hipFuncAttributeMaxDynamicSharedMemorySize, LDS_BYTES) != hipSuccess) { fprintf(stderr, "kernel_launch: hipFuncSetAttribute failed\n"); grid = -1; return; }
        if (hipOccupancyMaxActiveBlocksPerMultiprocessor(&per_cu, (const void*)mk_fwd, NTHR, LDS_BYTES) != hipSuccess || per_cu < 1) { fprintf(stderr, "kernel_launch: occupancy query says %d\n", per_cu); }
        (void)hipGetLastError();
        grid = cus;
    }
    if (grid < 0) return;
    (void)hipMemsetAsync((char*)d_ws + WS_CTL, 0, CTL_ZERO_BYTES, stream);
    Args a{};
    for (int i = 0; i < 23; ++i) a.in[i] = (const float*)d_in[i];
    a.out = (float*)d_out; a.ws = (unsigned char*)d_ws;
#if MK_N_LAUNCHES == 1
    a.ph_lo = 0; a.ph_hi = NPH;
    hipLaunchKernelGGL(mk_fwd, dim3(grid), dim3(NTHR), LDS_BYTES, stream, a);
#else
    for (int p = 0; p < NPH; ++p) { a.ph_lo = p; a.ph_hi = p + 1; hipLaunchKernelGGL(mk_fwd, dim3(grid), dim3(NTHR), LDS_BYTES, stream, a); }
#endif
}
```

```cpp
#define MK_N_LAUNCHES 1
#define PROBE_MASK 0
#define PROBE_N 1
#define PROBE_HALF 0
#define PROBE_BAR 0
#define USLICE 0
#define USORT 0
#define UMFMA 1
#define VF16 2
#define PROBE_UW 0
#define SCPF 0
#define SC2 0
#define PROBE_VH 0
#define CONV3 0
#define NA4 1
#define QFRAG 1
#define PROBE_RM 0
#define GEMM_ALIGN true
#define GEMM_SP2 true
#include <hip/hip_runtime.h>
#include <cstdio>
#include <cstdint>
namespace pg8 {
#define PG8_LAS __attribute__((address_space(3)))
#ifndef GAS
#define GAS __attribute__((address_space(1)))
#endif
typedef unsigned short bf16_t;
typedef short bf16x8 __attribute__((ext_vector_type(8)));
typedef float f32x4 __attribute__((ext_vector_type(4)));
typedef unsigned u32x4 __attribute__((ext_vector_type(4)));
constexpr int BM = 256, BK = 64, HALF = 128, HTB = HALF * BK * 2  , STAGE_BYTES = 8 * HTB, NXCD = 8, WGM = 8;

__host__ __device__ __forceinline__ int lds_byte(int r, int c) { const int st = (r >> 4) * 2 + (c >> 5), rr = r & 15, cc = c & 31, ob = rr * 64 + cc * 2; return st * 1024 + (ob ^ (((ob >> 9) & 1) << 5)); }
__host__ __device__ __forceinline__ void stage_rc(int b, int& R, int& C) { const int st = b / 1024, sb = b % 1024, swz = sb ^ (((sb >> 9) & 1) << 5); R = (st >> 1) * 16 + swz / 64; C = (st & 1) * 32 + (swz % 64) / 2; }
__host__ __device__ __forceinline__ int perm32(int rho) { const int n = rho >> 4, i = rho & 15; return 8 * (i >> 2) + 4 * n + (i & 3); }

struct Unit { int pm, pn; };
struct Gemm { const GAS bf16_t* A; const GAS bf16_t* Bt; int M, N, K; };

struct StaticOrder {
    int nM, nN, nwg, G, c;
    __host__ __device__ void init(int M, int N, int G_, int c_) { nM = M / BM; nN = N / BM; nwg = nM * nN; G = G_; c = c_; }
    __host__ __device__ bool next(int i, Unit& u) const {
        const long L = (long)i * G + c; if (L >= nwg) return false;
        int wgid = (int)L; { const int q = nwg / NXCD, r = nwg % NXCD, xcd = wgid % NXCD, off = wgid / NXCD; wgid = (xcd < r ? xcd * (q + 1) : r * (q + 1) + (xcd - r) * q) + off; }
        const int nig = WGM * nN, gid = wgid / nig, fm = gid * WGM, gsz = (nM - fm) < WGM ? (nM - fm) : WGM;
        u.pm = fm + ((wgid % nig) % gsz); u.pn = (wgid % nig) / gsz; return true;
    }
    __device__ __forceinline__ void a_ready(const Unit&) const {}
    __device__ __forceinline__ void done(const Unit&) const {}
};

__device__ __forceinline__ unsigned cvt_pk_bf16(float lo, float hi) { unsigned r; asm volatile("v_cvt_pk_bf16_f32 %0, %1, %2" : "=v"(r) : "v"(lo), "v"(hi)); return r; }
typedef float f32x2 __attribute__((ext_vector_type(2)));
__device__ __forceinline__ f32x2 gelu_pk(f32x2 v) {
    const f32x2 av = __builtin_elementwise_abs(v), d = av * 0.2316418882f + 1.0f;
    f32x2 t; t.x = __builtin_amdgcn_rcpf(d.x); t.y = __builtin_amdgcn_rcpf(d.y);
    f32x2 q = t * 0.5307027145f + (-0.7265760135f); q = q * t + 0.7107068705f; q = q * t + (-0.142248368f); q = q * t + 0.127414796f; q = q * t;
    const f32x2 s = (v * v) * (-0.72134752044f);
    f32x2 e; e.x = __builtin_amdgcn_exp2f(s.x); e.y = __builtin_amdgcn_exp2f(s.y);
    const f32x2 m = v * (q * e), r = v - m;
    f32x2 o; o.x = v.x < 0.f ? m.x : r.x; o.y = v.y < 0.f ? m.y : r.y; return o;
}

template <int ACT  > struct EpiBf16 {
    static constexpr bool PERM = true, AFTER_DRAIN = false; static_assert(ACT == 0 || ACT == 1, "EpiBf16: ACT is 0 (none) or 1 (gelu_pk)");
    GAS bf16_t* O; int ldc; const GAS float* bias; int split_cols; size_t split_stride; float scale0;
    __device__ __forceinline__ void operator()(const f32x4 (&acc)[2][2][4][2], const Unit& u, int wr, int wc, int fr, int fq) const {
        const int row0 = u.pm * BM + wr * 64 + fr; int colt = u.pn * BM; GAS bf16_t* base = O;
        float sc = 1.f; if (split_cols) { const int t = colt / split_cols; base += (size_t)t * split_stride; colt -= t * split_cols; if (t == 0) sc = scale0; }
        const int col0 = colt + wc * 32 + 8 * fq, bcol0 = u.pn * BM + wc * 32 + 8 * fq;
        f32x4 bv[2][2];
#pragma unroll
        for (int bj = 0; bj < 2; ++bj)
#pragma unroll
            for (int n = 0; n < 2; ++n) bv[bj][n] = bias ? *(const GAS f32x4*)(bias + bcol0 + bj * HALF + 4 * n) : (f32x4){0.f, 0.f, 0.f, 0.f};
#pragma unroll
        for (int ai = 0; ai < 2; ++ai)
#pragma unroll
            for (int m = 0; m < 4; ++m) { GAS bf16_t* rowp = base + (size_t)(row0 + ai * HALF + m * 16) * ldc + col0;
#pragma unroll
                for (int bj = 0; bj < 2; ++bj) { f32x4 v0 = acc[ai][bj][m][0] + bv[bj][0], v1 = acc[ai][bj][m][1] + bv[bj][1];
                    if (ACT == 1) { f32x2 a = gelu_pk((f32x2){v0[0], v0[1]}), b = gelu_pk((f32x2){v0[2], v0[3]}), c = gelu_pk((f32x2){v1[0], v1[1]}), d = gelu_pk((f32x2){v1[2], v1[3]});
                        v0 = (f32x4){a.x, a.y, b.x, b.y}; v1 = (f32x4){c.x, c.y, d.x, d.y}; }
                    v0 = v0 * sc; v1 = v1 * sc; u32x4 w; w.x = cvt_pk_bf16(v0[0], v0[1]); w.y = cvt_pk_bf16(v0[2], v0[3]); w.z = cvt_pk_bf16(v1[0], v1[1]); w.w = cvt_pk_bf16(v1[2], v1[3]);
                    *(GAS u32x4*)(rowp + bj * HALF) = w; } }
    }
};

template <bool BASEB> struct EpiRes {
    static constexpr bool PERM = true, AFTER_DRAIN = false;
    const GAS float* base_lat; const GAS float* base_ctx; GAS bf16_t* xs; const GAS float* gate;
    __device__ __forceinline__ void operator()(const f32x4 (&acc)[2][2][4][2], const Unit& u, int wr, int wc, int fr, int fq) const {
        const int rowt = u.pm * BM;
        const int cond = rowt < 16384 ? (rowt >> 12) : 4;
        const GAS float* g = gate + (size_t)cond * 6144;
        const int col0 = u.pn * BM + wc * 32 + 8 * fq;
        f32x4 gv[2][2];
#pragma unroll
        for (int bj = 0; bj < 2; ++bj)
#pragma unroll
            for (int n = 0; n < 2; ++n) gv[bj][n] = *(const GAS f32x4*)(g + col0 + bj * HALF + 4 * n);
#pragma unroll
        for (int ai = 0; ai < 2; ++ai) {
            f32x4 bsv[4][2][2];
#pragma unroll
            for (int m = 0; m < 4; ++m) {
                const int r = rowt + ai * HALF + wr * 64 + m * 16 + fr;
                const GAS float* bp = r < 16384 ? base_lat + (size_t)r * 1024 : base_ctx + (size_t)(r - 16384) * 1024;
                const GAS bf16_t* op = xs + (size_t)r * 1024;
#pragma unroll
                for (int bj = 0; bj < 2; ++bj) {
                    const int off = col0 + bj * HALF;
                    if (BASEB) { const u32x4 w = *(const GAS u32x4*)(op + off);
                        bsv[m][bj][0] = (f32x4){__uint_as_float(w.x << 16), __uint_as_float(w.x & 0xffff0000u), __uint_as_float(w.y << 16), __uint_as_float(w.y & 0xffff0000u)};
                        bsv[m][bj][1] = (f32x4){__uint_as_float(w.z << 16), __uint_as_float(w.z & 0xffff0000u), __uint_as_float(w.w << 16), __uint_as_float(w.w & 0xffff0000u)}; }
                    else { bsv[m][bj][0] = *(const GAS f32x4*)(bp + off); bsv[m][bj][1] = *(const GAS f32x4*)(bp + off + 4); }
                }
            }
#pragma unroll
            for (int m = 0; m < 4; ++m) {
                const int r = rowt + ai * HALF + wr * 64 + m * 16 + fr;
                GAS bf16_t* op = xs + (size_t)r * 1024;
#pragma unroll
                for (int bj = 0; bj < 2; ++bj) {
                    const f32x4 o0 = bsv[m][bj][0] + gv[bj][0] * acc[ai][bj][m][0], o1 = bsv[m][bj][1] + gv[bj][1] * acc[ai][bj][m][1];
                    u32x4 w; w.x = cvt_pk_bf16(o0[0], o0[1]); w.y = cvt_pk_bf16(o0[2], o0[3]); w.z = cvt_pk_bf16(o1[0], o1[1]); w.w = cvt_pk_bf16(o1[2], o1[3]);
                    *(GAS u32x4*)(op + col0 + bj * HALF) = w;
                }
            }
        }
    }
};

struct EpiQfrag {
    static constexpr bool PERM = true, AFTER_DRAIN = false;
    GAS bf16_t* O;
    __device__ __forceinline__ void operator()(const f32x4 (&acc)[2][2][4][2], const Unit& u, int wr, int wc, int fr, int fq) const {
#pragma unroll
        for (int ai = 0; ai < 2; ++ai)
#pragma unroll
            for (int m = 0; m < 4; ++m) {
                const size_t tb = (size_t)(u.pm * BM + ai * HALF + wr * 64 + m * 16) >> 4;
#pragma unroll
                for (int bj = 0; bj < 2; ++bj) {
                    const f32x4 v0 = acc[ai][bj][m][0], v1 = acc[ai][bj][m][1];
                    u32x4 w; w.x = cvt_pk_bf16(v0[0], v0[1]); w.y = cvt_pk_bf16(v0[2], v0[3]); w.z = cvt_pk_bf16(v1[0], v1[1]); w.w = cvt_pk_bf16(v1[2], v1[3]);
                    *(GAS u32x4*)(O + ((((((tb * 8 + u.pn) * 2 + bj) * 4 + wc) * 4 + fq) * 16 + fr) * 8)) = w;
                }
            }
    }
};

template <class Epi, class Sched, bool ALIGN_EPI = false, bool SP2 = false>
__device__ __forceinline__ void gemm_phase(PG8_LAS unsigned char* lds, const Gemm g, const Sched& S, const Epi& E) {
    const int tid = threadIdx.x, wid = __builtin_amdgcn_readfirstlane(tid >> 6), lane = tid & 63, wr = wid >> 2, wc = wid & 3, fr = lane & 15, fq = lane >> 4;
    const int K = g.K, nt = K / BK;
    unsigned voffA[2], voffB[2];
#pragma unroll
    for (int i = 0; i < 2; ++i) { int R, C; stage_rc(tid * 16 + i * 8192, R, C); const int Rb = Epi::PERM ? ((R & ~31) + perm32(R & 31)) : R;
        voffA[i] = (unsigned)(R * K + C) * 2u; voffB[i] = (unsigned)(Rb * K + C) * 2u; }
    const size_t kstep = (size_t)(BK * 2);
    const size_t hstep = (size_t)HALF * K * 2;
    const size_t tstep = 2 * hstep;
    const unsigned ldsw = (unsigned)wid * 1024u;
    const int aoff = lds_byte(wr * 64 + fr, fq * 8), boff = lds_byte(wc * 32 + fr, fq * 8);
#define PG8_SA(b, h) (((b) * 2 + (h)) * HTB)
#define PG8_SB(b, h) ((4 + (b) * 2 + (h)) * HTB)
#define PG8_STAGE(bufoff, gbase, voff) do { _Pragma("unroll") for (int _i = 0; _i < 2; ++_i) \
        __builtin_amdgcn_global_load_lds((const unsigned*)((const char*)(gbase) + (voff)[_i]), (PG8_LAS unsigned*)(lds + (bufoff) + ldsw + _i * 8192), 16, 0, 0); } while (0)
#define PG8_LDA(dst, b, h) do { _Pragma("unroll") for (int m = 0; m < 4; ++m) _Pragma("unroll") for (int k = 0; k < 2; ++k) dst[m][k] = *(const PG8_LAS bf16x8*)(lds + PG8_SA(b, h) + aoff + m * 2048 + k * 1024); } while (0)
#define PG8_LDB(dst, b, h) do { _Pragma("unroll") for (int n = 0; n < 2; ++n) _Pragma("unroll") for (int k = 0; k < 2; ++k) dst[n][k] = *(const PG8_LAS bf16x8*)(lds + PG8_SB(b, h) + boff + n * 2048 + k * 1024); } while (0)
#define PG8_MMA(ai, bj, At, Bt) do { __builtin_amdgcn_s_setprio(1); _Pragma("unroll") for (int m = 0; m < 4; ++m) _Pragma("unroll") for (int n = 0; n < 2; ++n) _Pragma("unroll") for (int k = 0; k < 2; ++k) \
        acc[ai][bj][m][n] = __builtin_amdgcn_mfma_f32_16x16x32_bf16(Bt[n][k], At[m][k], acc[ai][bj][m][n], 0, 0, 0); __builtin_amdgcn_s_setprio(0); } while (0)
#define PG8_WAIT_V(n) asm volatile("s_waitcnt vmcnt(" #n ")" ::: "memory")
#define PG8_WAIT_L(n) asm volatile("s_waitcnt lgkmcnt(" #n ")" ::: "memory")
#define PG8_BAR __builtin_amdgcn_s_barrier()
#define PG8_SCHED __builtin_amdgcn_sched_barrier(0)
    Unit cur, nxt; int ui = 0;
    if (!S.next(0, cur)) return;
    f32x4 acc[2][2][4][2];
#pragma unroll
    for (int a = 0; a < 2; ++a)
#pragma unroll
        for (int b = 0; b < 2; ++b)
#pragma unroll
            for (int m = 0; m < 4; ++m)
#pragma unroll
                for (int n = 0; n < 2; ++n) acc[a][b][m][n] = (f32x4){0.f, 0.f, 0.f, 0.f};
    bf16x8 At[4][2], B0[2][2], B1[2][2];
    const char* cA = (const char*)g.A + (size_t)cur.pm * tstep; const char* cB = (const char*)g.Bt + (size_t)cur.pn * tstep;
    S.a_ready(cur);
    if constexpr (SP2) {
        PG8_STAGE(PG8_SB(0, 0), cB, voffB); PG8_STAGE(PG8_SB(0, 1), cB + hstep, voffB); PG8_STAGE(PG8_SA(0, 0), cA, voffA); PG8_STAGE(PG8_SA(0, 1), cA + hstep, voffA);
        if (wr == 1) PG8_BAR;
        PG8_WAIT_V(2); PG8_BAR;
        PG8_STAGE(PG8_SB(1, 0), cB + kstep, voffB); PG8_STAGE(PG8_SA(1, 0), cA + kstep, voffA); PG8_STAGE(PG8_SB(1, 1), cB + hstep + kstep, voffB);
        PG8_WAIT_V(6); PG8_BAR;
    } else {
        PG8_STAGE(PG8_SB(0, 0), cB, voffB); PG8_STAGE(PG8_SA(0, 0), cA, voffA); PG8_STAGE(PG8_SB(0, 1), cB + hstep, voffB); PG8_STAGE(PG8_SA(0, 1), cA + hstep, voffA);
        if (wr == 1) PG8_BAR;
        PG8_WAIT_V(4); PG8_BAR;
        PG8_STAGE(PG8_SB(1, 0), cB + kstep, voffB); PG8_STAGE(PG8_SA(1, 0), cA + kstep, voffA); PG8_STAGE(PG8_SB(1, 1), cB + hstep + kstep, voffB);
        PG8_WAIT_V(6); PG8_BAR;
    }
    for (;;) {
        const bool has_next = S.next(ui + 1, nxt);
        const char* nA = has_next ? (const char*)g.A + (size_t)nxt.pm * tstep : cA; const char* nB = has_next ? (const char*)g.Bt + (size_t)nxt.pn * tstep : cB;
        for (int t = 0; t < nt; t += 2) {
            const bool last = (t == nt - 2);
            const char* a1 = cA + (size_t)(t + 1) * kstep;
            const char* a2 = last ? nA : cA + (size_t)(t + 2) * kstep; const char* b2 = last ? nB : cB + (size_t)(t + 2) * kstep;
            const char* a3 = a2 + kstep; const char* b3 = b2 + kstep;
            if (last && has_next) S.a_ready(nxt);
            if constexpr (SP2) {
            PG8_LDB(B0, 0, 0); PG8_LDB(B1, 0, 1); PG8_SCHED; PG8_LDA(At, 0, 0); PG8_STAGE(PG8_SA(1, 1), a1 + hstep, voffA);
            PG8_WAIT_V(8); PG8_WAIT_L(0); PG8_BAR; PG8_MMA(0, 0, At, B0); PG8_MMA(0, 1, At, B1); PG8_BAR; PG8_SCHED;
            PG8_LDA(At, 0, 1); PG8_STAGE(PG8_SB(0, 0), b2, voffB); PG8_STAGE(PG8_SB(0, 1), b2 + hstep, voffB); PG8_STAGE(PG8_SA(0, 0), a2, voffA);
            PG8_WAIT_V(8); PG8_WAIT_L(0); PG8_BAR; PG8_MMA(1, 0, At, B0); PG8_MMA(1, 1, At, B1); PG8_BAR; PG8_SCHED;
            PG8_LDB(B0, 1, 0); PG8_LDB(B1, 1, 1); PG8_SCHED; PG8_LDA(At, 1, 0); PG8_STAGE(PG8_SA(0, 1), a2 + hstep, voffA);
            PG8_WAIT_V(8); PG8_WAIT_L(0); PG8_BAR; PG8_MMA(0, 0, At, B0); PG8_MMA(0, 1, At, B1); PG8_BAR; PG8_SCHED;
            PG8_LDA(At, 1, 1); PG8_STAGE(PG8_SB(1, 0), b3, voffB); PG8_STAGE(PG8_SB(1, 1), b3 + hstep, voffB); PG8_STAGE(PG8_SA(1, 0), a3, voffA);
            PG8_WAIT_V(8); PG8_WAIT_L(0); PG8_BAR; PG8_MMA(1, 0, At, B0); PG8_MMA(1, 1, At, B1); PG8_BAR; PG8_SCHED;
            } else {
            PG8_LDB(B0, 0, 0); PG8_SCHED; PG8_LDA(At, 0, 0); PG8_STAGE(PG8_SA(1, 1), a1 + hstep, voffA);
            PG8_WAIT_L(8); PG8_BAR; PG8_WAIT_L(0); PG8_MMA(0, 0, At, B0); PG8_BAR; PG8_SCHED;
            PG8_LDB(B1, 0, 1); PG8_STAGE(PG8_SB(0, 0), b2, voffB);
            PG8_BAR; PG8_WAIT_L(0); PG8_MMA(0, 1, At, B1); PG8_BAR;
            PG8_LDA(At, 0, 1); PG8_STAGE(PG8_SA(0, 0), a2, voffA);
            PG8_BAR; PG8_WAIT_L(0); PG8_MMA(1, 0, At, B0); PG8_BAR; PG8_SCHED;
            PG8_STAGE(PG8_SB(0, 1), b2 + hstep, voffB);
            PG8_WAIT_V(6); PG8_BAR; PG8_MMA(1, 1, At, B1); PG8_BAR;
            PG8_LDB(B0, 1, 0); PG8_SCHED; PG8_LDA(At, 1, 0); PG8_STAGE(PG8_SA(0, 1), a2 + hstep, voffA);
            PG8_WAIT_L(8); PG8_BAR; PG8_WAIT_L(0); PG8_MMA(0, 0, At, B0); PG8_BAR; PG8_SCHED;
            PG8_LDB(B1, 1, 1); PG8_STAGE(PG8_SB(1, 0), b3, voffB);
            PG8_BAR; PG8_WAIT_L(0); PG8_MMA(0, 1, At, B1); PG8_BAR;
            PG8_LDA(At, 1, 1); PG8_STAGE(PG8_SA(1, 0), a3, voffA);
            PG8_BAR; PG8_WAIT_L(0); PG8_MMA(1, 0, At, B0); PG8_BAR; PG8_SCHED;
            PG8_STAGE(PG8_SB(1, 1), b3 + hstep, voffB);
            PG8_WAIT_V(6); PG8_BAR; PG8_MMA(1, 1, At, B1); PG8_BAR;
            }
        }
        if constexpr (ALIGN_EPI) { if (wr == 0) PG8_BAR; }
        if constexpr (!Epi::AFTER_DRAIN) { E(acc, cur, wr, wc, fr, fq); S.done(cur); }
        if (!has_next) break;
#pragma unroll
        for (int a = 0; a < 2; ++a)
#pragma unroll
            for (int b = 0; b < 2; ++b)
#pragma unroll
                for (int m = 0; m < 4; ++m)
#pragma unroll
                    for (int n = 0; n < 2; ++n) acc[a][b][m][n] = (f32x4){0.f, 0.f, 0.f, 0.f};
        cur = nxt; cA = nA; cB = nB; ++ui;
        if constexpr (ALIGN_EPI) { if (wr == 1) PG8_BAR; }
    }
    PG8_WAIT_V(0);
    if constexpr (!ALIGN_EPI) { if (wr == 0) PG8_BAR; }
    PG8_BAR;
    if constexpr (Epi::AFTER_DRAIN) { E.fused(acc, cur, wr, wc, fr, fq, lds, wid, lane); S.done(cur); }
#undef PG8_SA
#undef PG8_SB
#undef PG8_STAGE
#undef PG8_LDA
#undef PG8_LDB
#undef PG8_MMA
#undef PG8_WAIT_V
#undef PG8_WAIT_L
#undef PG8_BAR
#undef PG8_SCHED
}
}
#define GAS __attribute__((address_space(1)))
#define LAS __attribute__((address_space(3)))
typedef unsigned short bf16;
typedef unsigned v4u __attribute__((ext_vector_type(4)));
typedef float f32x4 __attribute__((ext_vector_type(4)));
typedef short bf16x8 __attribute__((ext_vector_type(8)));
typedef GAS unsigned gu32;
typedef GAS unsigned long long gu64;
#define RLX_AGENT __ATOMIC_RELAXED, __HIP_MEMORY_SCOPE_AGENT
#define LDS_WAIT() asm volatile("s_waitcnt lgkmcnt(0)" ::: "memory")
#define VM_WAIT() asm volatile("s_waitcnt vmcnt(0)" ::: "memory")
__device__ __forceinline__ unsigned long long rt() { return __builtin_amdgcn_s_memrealtime(); }
__device__ __forceinline__ unsigned f2bf(float f) { unsigned u = __builtin_bit_cast(unsigned, f); return (u + 0x7fffu + ((u >> 16) & 1u)) >> 16; }
typedef float pk2_f2_t __attribute__((ext_vector_type(2))); typedef __bf16 pk2_b2_t __attribute__((ext_vector_type(2)));
__device__ __forceinline__ unsigned pk2(float lo, float hi) { pk2_f2_t v = {lo, hi}; return __builtin_bit_cast(unsigned, __builtin_convertvector(v, pk2_b2_t)); }

#define XB_TMO      128
#define XB_XCNT(j)  (256  + 64 * (j))
#define XB_XSUB(j)  (1280 + 64 * (j))
#define XB_XGEN(j)  (2304 + 64 * (j))
#define XB_TOP      3328
#define XB_TOPGEN   3392
#define XCD_BAR_WORDS 3456
#define XB_SPIN_CAP (1u << 18)

__device__ __forceinline__ unsigned xb_ld(unsigned* p)              { return __hip_atomic_load(p, __ATOMIC_RELAXED, __HIP_MEMORY_SCOPE_AGENT); }
__device__ __forceinline__ unsigned xb_add(unsigned* p, unsigned v) { return __hip_atomic_fetch_add(p, v, __ATOMIC_RELAXED, __HIP_MEMORY_SCOPE_AGENT); }
__device__ __forceinline__ unsigned xb_xcc_id() { return (unsigned)__builtin_amdgcn_s_getreg((3 << 11) | 20) & 0xFu; }
#define XB_SPIN(cond, bar) do { unsigned _sp = 0; while (cond) { __builtin_amdgcn_s_sleep(1); \
    if ((++_sp & 255u) == 0u) { if (xb_ld(&(bar)[XB_TMO])) break; if (_sp > XB_SPIN_CAP) { atomicAdd(&(bar)[XB_TMO], 1u); break; } } } } while (0)

struct XcdBarrier {
    unsigned* bar; unsigned x;
    volatile LAS unsigned* st;
};

__device__ __forceinline__ XcdBarrier xcd_barrier_post(unsigned* bar, volatile LAS unsigned* st) {
    XcdBarrier b; b.bar = bar; b.x = xb_xcc_id(); b.st = st;
    if (threadIdx.x == 0) (void)xb_add(&bar[XB_XCNT(b.x)], 1u);
    return b;
}
__device__ __forceinline__ void xcd_barrier_complete(unsigned* bar, unsigned x, unsigned& nloc, unsigned& nx) {
    const unsigned G = gridDim.x * gridDim.y * gridDim.z;
    unsigned sum, cnt, mine, sp = 0u;
    for (;;) {
        sum = 0u; cnt = 0u; mine = 0u;
#pragma unroll
        for (unsigned j = 0; j < 16; ++j) { const unsigned c = xb_ld(&bar[XB_XCNT(j)]); sum += c; cnt += (c > 0u) ? 1u : 0u; mine = (j == x) ? c : mine; }
        if (sum == G) break;
        __builtin_amdgcn_s_sleep(1);
        if ((++sp & 255u) == 0u) { if (xb_ld(&bar[XB_TMO])) break; if (sp > XB_SPIN_CAP) { atomicAdd(&bar[XB_TMO], 1u); break; } }
    }
    nloc = mine > 0u ? mine : 1u; nx = cnt > 0u ? cnt : 1u;
}

__device__ __forceinline__ void xcd_barrier(const XcdBarrier& b) {
    asm volatile("s_waitcnt vmcnt(0)" ::: "memory");
    __syncthreads();
    if (threadIdx.x == 0) {
        unsigned* bar = b.bar;
        __builtin_amdgcn_s_waitcnt(0);
        unsigned nloc = b.st[0], nx = b.st[1];
        if (nloc == 0u) { xcd_barrier_complete(bar, b.x, nloc, nx); b.st[0] = nloc; b.st[1] = nx; }
        const unsigned old = xb_add(&bar[XB_XSUB(b.x)], 1u);
        const unsigned gen = old / nloc;
        if (old + 1u == (gen + 1u) * nloc) {
            __builtin_amdgcn_fence(__ATOMIC_RELEASE, "agent");
            asm volatile("s_waitcnt vmcnt(0)" ::: "memory");
            const unsigned og = xb_add(&bar[XB_TOP], 1u);
            const unsigned tg = og / nx;
            if (og + 1u == (tg + 1u) * nx) xb_add(&bar[XB_TOPGEN], 1u);
            else XB_SPIN(xb_ld(&bar[XB_TOPGEN]) == tg, bar);
            __builtin_amdgcn_fence(__ATOMIC_ACQUIRE, "agent");
            xb_add(&bar[XB_XGEN(b.x)], 1u);
            asm volatile("s_waitcnt vmcnt(0)" ::: "memory");
        } else {
            XB_SPIN(xb_ld(&bar[XB_XGEN(b.x)]) == gen, bar);
            __builtin_amdgcn_fence(__ATOMIC_ACQUIRE, "agent");
            asm volatile("s_waitcnt vmcnt(0)" ::: "memory");
        }
    }
    __syncthreads();
}
constexpr int NWAVES = 8, NTHR = 512;
constexpr int DM = 1024, NBATCH = 4, SEQ = 4096, CL = 256;
constexpr int MLAT = NBATCH * SEQ, MCTX = NBATCH * CL, MALL = MLAT + MCTX;
constexpr int AB_IN = 3584, SWA_IN = 1536, PQD = 2048, MODW = 6144;
constexpr size_t MiB = 1u << 20;
#ifndef U_FP4
#define U_FP4 1
#endif
#ifndef V_FP4
#define V_FP4 1
#endif
constexpr int U_ROWB = U_FP4 ? 512 : 768, V_ROWB = V_FP4 ? 512 : 768;
constexpr size_t WS_CTL = 0, CTL_ZERO_BYTES = 1 * MiB;
constexpr size_t WS_MOD = 1 * MiB;
constexpr size_t WS_ROPE = 1 * MiB + 512 * 1024;
constexpr size_t WS_SU = 1 * MiB + 640 * 1024, WS_SV = 1 * MiB + 768 * 1024;
constexpr size_t WS_SUBK = 2 * MiB;
constexpr size_t WS_WIN0 = 4 * MiB, WS_WOUT0 = 11 * MiB, WS_WQ0 = 13 * MiB, WS_WIN1 = 17 * MiB, WS_WOUT1 = 20 * MiB, WS_WQ1 = 22 * MiB;
constexpr size_t WS_U = 32 * MiB, WS_V = 96 * MiB;
constexpr size_t WS_XN = 160 * MiB;
constexpr size_t WS_XS = 194 * MiB;
constexpr size_t WS_P = 262 * MiB;
constexpr size_t WS_Q2 = 262 * MiB;
constexpr size_t WS_IDX = 330 * MiB, WS_GATE = 339 * MiB;
constexpr size_t WS_TAV = 381 * MiB, WS_TBK = 398 * MiB, WS_TBV = 415 * MiB;
constexpr size_t WS_KV = 432 * MiB;
constexpr size_t WS_ST = 466 * MiB;
constexpr size_t WS_END = 483 * MiB;
constexpr int CW_BAR = 4096;

typedef unsigned v2u __attribute__((ext_vector_type(2)));
typedef __bf16 bf16x2_t __attribute__((ext_vector_type(2)));
__device__ __forceinline__ float bflo(unsigned u) { return __uint_as_float(u << 16); }
__device__ __forceinline__ float bfhi(unsigned u) { return __uint_as_float(u & 0xffff0000u); }
__device__ __forceinline__ float bf1(bf16 u) { return __uint_as_float((unsigned)u << 16); }
__device__ __forceinline__ v4u ld16(const GAS bf16* p) { return *(const GAS v4u*)p; }
__device__ __forceinline__ bf16x8 ldfrag(const GAS bf16* p) { return __builtin_bit_cast(bf16x8, *(const GAS v4u*)p); }
__device__ __forceinline__ f32x4 mfma16(bf16x8 a, bf16x8 b, f32x4 c) { return __builtin_amdgcn_mfma_f32_16x16x32_bf16(a, b, c, 0, 0, 0); }
__device__ __forceinline__ float wave_sum(float v) {
#pragma unroll
    for (int o = 1; o < 64; o <<= 1) v += __shfl_xor(v, o);
    return v;
}
__device__ __forceinline__ float fexp2(float x) { return __builtin_amdgcn_exp2f(x); }
__device__ __forceinline__ float fexp(float x) { return __builtin_amdgcn_exp2f(x * 1.4426950408889634f); }
__device__ __forceinline__ bf16x8 pack8(const f32x4& a, const f32x4& b) {
    v4u w; w.x = pk2(a[0], a[1]); w.y = pk2(a[2], a[3]); w.z = pk2(b[0], b[1]); w.w = pk2(b[2], b[3]);
    return __builtin_bit_cast(bf16x8, w);
}
__device__ __forceinline__ float dot2bf(unsigned a, unsigned b, float acc) {
    return __builtin_amdgcn_fdot2_f32_bf16(__builtin_bit_cast(bf16x2_t, a), __builtin_bit_cast(bf16x2_t, b), acc, false);
}
__device__ __forceinline__ float gelu_erf(float v) {
    const float av = fabsf(v), d = av * 0.2316418882f + 1.0f;
    const float t = __builtin_amdgcn_rcpf(d);
    float q = t * 0.5307027145f + (-0.7265760135f); q = q * t + 0.7107068705f; q = q * t + (-0.142248368f); q = q * t + 0.127414796f; q = q * t;
    const float e = __builtin_amdgcn_exp2f((v * v) * (-0.72134752044f));
    const float m = v * (q * e), r = v - m;
    return v < 0.f ? m : r;
}

struct Ctx {
    LAS unsigned char* lds;
    int tid, lane, wave, gw, ngw, G;
    const GAS float *x, *c, *ctx, *c_ctx, *mod_w, *mod_b, *norm1_g, *norm2_g, *ab_w_in, *ab_w_out, *na_q_norm, *na_k_norm, *na_rpb, *ret_log_decay,
                *swa_w_in, *swa_w_out, *swa_q_norm, *swa_k_norm, *swa_sink, *peer_w_q, *peer_sub_keys, *peer_u, *peer_v;
    GAS float* out;
    GAS float* MOD; GAS float* ROPE; GAS bf16* SUBK; GAS bf16 *WIN0, *WOUT0, *WQ0, *WIN1, *WOUT1, *WQ1; GAS unsigned char *U8, *V8; GAS float *SU, *SV; GAS bf16* XN; GAS bf16* XS; GAS bf16* P; GAS bf16* Q2;
    GAS int* IDX; GAS float* GATE; GAS bf16 *TAV, *TBK, *TBV; GAS float* KV; GAS bf16* ST;
};

__device__ __forceinline__ void p0_transpose_item(const GAS float* W, int K, int N, GAS bf16* WT, LAS float* scr, int item, int lane) {
    const int nblk = N / 32, kb = item / nblk, nb = item % nblk, k0 = 64 * kb, n0 = 32 * nb;
    float wv[32];
#pragma unroll
    for (int i = 0; i < 32; ++i) wv[i] = W[(size_t)(k0 + 2 * i + (lane >> 5)) * N + n0 + (lane & 31)];
#pragma unroll
    for (int i = 0; i < 32; ++i) scr[(2 * i + (lane >> 5)) * 33 + (lane & 31)] = wv[i];
    LDS_WAIT(); asm volatile("" ::: "memory");
    const int c = lane & 7;
#pragma unroll
    for (int j = 0; j < 4; ++j) { const int n = (lane >> 3) + 8 * j; const LAS float* s = scr + (8 * c) * 33 + n;
        v4u o; o.x = pk2(s[0 * 33], s[1 * 33]); o.y = pk2(s[2 * 33], s[3 * 33]); o.z = pk2(s[4 * 33], s[5 * 33]); o.w = pk2(s[6 * 33], s[7 * 33]);
        *(GAS v4u*)(WT + (size_t)(n0 + n) * K + k0 + 8 * c) = o; }
    LDS_WAIT(); asm volatile("" ::: "memory");
}
__device__ __forceinline__ void p0_convert(const Ctx& F, const GAS float* src, GAS bf16* dst, size_t n8) {
    const size_t gt = (size_t)F.gw * 64 + F.lane, NT = (size_t)F.ngw * 64;
    for (size_t i = gt; i < n8; i += NT) {
        const f32x4 a = *(const GAS f32x4*)(src + i * 8), b = *(const GAS f32x4*)(src + i * 8 + 4);
        v4u o; o.x = pk2(a[0], a[1]); o.y = pk2(a[2], a[3]); o.z = pk2(b[0], b[1]); o.w = pk2(b[2], b[3]);
        *(GAS v4u*)(dst + i * 8) = o;
    }
}

#ifndef FP6_PACK_INTERLEAVED
#define FP6_PACK_INTERLEAVED 1
#endif
typedef float f32x16v __attribute__((ext_vector_type(16)));
typedef float f32x32v __attribute__((ext_vector_type(32)));
typedef unsigned u32x6v __attribute__((ext_vector_type(6)));
__device__ __forceinline__ int conv_vrow(int v) { return CONV3 ? (v < 16384 ? v : (v < 32768 ? v + 16384 : (v < 49152 ? v - 16384 : v))) : v; }
__device__ __forceinline__ void convert_fp6_rows(const Ctx& F, int rbeg, int rend) {
    const int q = F.lane & 31, hf = F.lane >> 5;
    constexpr int NB = 3;
    for (int Rb = rbeg + F.wave * 2; Rb < rend; Rb += NWAVES * 2 * NB) {
      f32x4 raw[NB][8];
#pragma unroll
      for (int u = 0; u < NB; ++u) {
          const int Rv = Rb + u * NWAVES * 2 + hf;
          const int Rc = conv_vrow(Rv < rend ? Rv : rbeg);
          const GAS float* xr = ((Rc >= 32768) ? F.peer_v : F.peer_u) + (size_t)(Rc & 32767) * 1024 + 32 * q;
#pragma unroll
          for (int j = 0; j < 8; ++j) raw[u][j] = *(const GAS f32x4*)(xr + 4 * j);
      }
#pragma unroll
      for (int u = 0; u < NB; ++u) {
        const int Rv = Rb + u * NWAVES * 2 + hf;
        if (Rv >= rend) continue;
        const int R = conv_vrow(Rv);
        const bool isv = R >= 32768; const int r = R & 32767;
        f32x16v a, b; float am = 0.f;
#pragma unroll
        for (int j = 0; j < 4; ++j) { const f32x4 v = raw[u][j]; a[4 * j] = v[0]; a[4 * j + 1] = v[1]; a[4 * j + 2] = v[2]; a[4 * j + 3] = v[3];
            am = fmaxf(fmaxf(fmaxf(fabsf(v[0]), fabsf(v[1])), fmaxf(fabsf(v[2]), fabsf(v[3]))), am); }
#pragma unroll
        for (int j = 0; j < 4; ++j) { const f32x4 v = raw[u][4 + j]; b[4 * j] = v[0]; b[4 * j + 1] = v[1]; b[4 * j + 2] = v[2]; b[4 * j + 3] = v[3];
            am = fmaxf(fmaxf(fmaxf(fabsf(v[0]), fabsf(v[1])), fmaxf(fabsf(v[2]), fabsf(v[3]))), am); }
#pragma unroll
        for (int o = 1; o < 32; o <<= 1) am = fmaxf(am, __shfl_xor(am, o));
        const bool fp4 = isv ? (V_FP4 != 0) : (U_FP4 != 0);
        const float sc = am > 0.f ? am * (fp4 ? (1.0f / 6.0f) : (1.0f / 7.5f)) : 1.0f, inv = 1.0f / sc;
        a = a * inv; b = b * inv;
        if (fp4) {
            v4u o;
#pragma unroll
            for (int d = 0; d < 4; ++d) { unsigned pk = 0;
#define X_(e) ((e) < 16 ? a[(e) & 15] : b[(e) & 15])
                pk = __builtin_amdgcn_cvt_scalef32_pk_fp4_f32(pk, X_(8 * d + 0), X_(8 * d + 1), 1.0f, 0);
                pk = __builtin_amdgcn_cvt_scalef32_pk_fp4_f32(pk, X_(8 * d + 2), X_(8 * d + 3), 1.0f, 1);
                pk = __builtin_amdgcn_cvt_scalef32_pk_fp4_f32(pk, X_(8 * d + 4), X_(8 * d + 5), 1.0f, 2);
                pk = __builtin_amdgcn_cvt_scalef32_pk_fp4_f32(pk, X_(8 * d + 6), X_(8 * d + 7), 1.0f, 3);
#undef X_
                o[d] = pk; }
            *(GAS v4u*)((isv ? F.V8 : F.U8) + (size_t)r * 512 + 16 * q) = o;
        } else {
        { f32x16v a2, b2;
#pragma unroll
          for (int i = 0; i < 8; ++i) { a2[i] = a[2 * i]; b2[i] = a[2 * i + 1]; a2[8 + i] = b[2 * i]; b2[8 + i] = b[2 * i + 1]; }
          a = a2; b = b2; }
        const u32x6v pk = __builtin_amdgcn_cvt_scalef32_2xpk16_fp6_f32(a, b, 1.0f);
        GAS unsigned* dp = (GAS unsigned*)((isv ? F.V8 : F.U8) + (size_t)r * 768 + 24 * q);
        *(GAS v2u*)dp = (v2u){pk[0], pk[1]}; *(GAS v2u*)(dp + 2) = (v2u){pk[2], pk[3]}; *(GAS v2u*)(dp + 4) = (v2u){pk[4], pk[5]};
        }
        if (q == 0) { if (isv) F.SV[r] = sc; else F.SU[r] = sc; }
      }
    }
}
__device__ __forceinline__ int idle_slot(int nwg, int G, int c, int& nslots) {
    const int mx = (nwg + G - 1) / G, full = nwg - (mx - 1) * G;
    nslots = G - full;
    if (nslots == 0) { nslots = G; return c; }
    return c >= full ? c - full : -1;
}
__device__ __forceinline__ void side_transposes(const Ctx& F, int slot, int nslots) {
    LAS float* scr = (LAS float*)(F.lds + F.wave * 16384);
    constexpr int I_O = 16 * 32, I_Q = 16 * (PQD / 32), I_IN1 = 16 * (SWA_IN / 32);
    constexpr int NITEMS = I_O + I_Q + I_IN1 + I_O + I_Q;
    for (int it = slot * NWAVES + F.wave; it < NITEMS; it += nslots * NWAVES) {
        int r = it;
        if (r < I_O) { p0_transpose_item(F.ab_w_out, DM, DM, F.WOUT0, scr, r, F.lane); continue; } r -= I_O;
        if (r < I_Q) { p0_transpose_item(F.peer_w_q, DM, PQD, F.WQ0, scr, r, F.lane); continue; } r -= I_Q;
        if (r < I_IN1) { p0_transpose_item(F.swa_w_in, DM, SWA_IN, F.WIN1, scr, r, F.lane); continue; } r -= I_IN1;
        if (r < I_O) { p0_transpose_item(F.swa_w_out, DM, DM, F.WOUT1, scr, r, F.lane); continue; } r -= I_O;
        p0_transpose_item(F.peer_w_q + (size_t)DM * PQD, DM, PQD, F.WQ1, scr, r, F.lane);
    }
}
__device__ __forceinline__ void side_convert(const Ctx& F, int part) {
    int n7, n9; const int s7 = idle_slot((MALL / 256) * (DM / 256), F.G, (int)blockIdx.x, n7), s9 = idle_slot((MALL / 256) * (PQD / 256), F.G, (int)blockIdx.x, n9);
    const int slot = part == 0 ? s7 : (s9 < 0 ? -1 : n7 + s9);
    if (slot < 0) return;
    const int per = (65536 + n7 + n9 - 1) / (n7 + n9);
    const int rbeg = min(slot * per, 65536), rend = min(rbeg + per, 65536);
    convert_fp6_rows(F, rbeg, rend);
}
__device__ __forceinline__ void p0_prologue(const Ctx& F) {
    if (blockIdx.x < 192) {
        const int l = blockIdx.x / 96, cb = blockIdx.x % 96, col = cb * 64 + F.lane;
        LAS float* s = (LAS float*)F.lds;
        LAS float* part = (LAS float*)(F.lds + 20480);
        for (int i = F.tid; i < 5120; i += NTHR) { const int r = i >> 10, k = i & 1023; const float cv = r < 4 ? F.c[r * 1024 + k] : F.c_ctx[k]; s[i] = cv / (1.f + __expf(-cv)); }
        __syncthreads();
        float acc[5] = {0.f, 0.f, 0.f, 0.f, 0.f};
        const GAS float* wp = F.mod_w + ((size_t)l * 1024 + F.wave * 128) * MODW + col;
#pragma unroll 32
        for (int k = 0; k < 128; ++k) { const float wv = wp[(size_t)k * MODW];
#pragma unroll
            for (int r = 0; r < 5; ++r) acc[r] += s[r * 1024 + F.wave * 128 + k] * wv; }
#pragma unroll
        for (int r = 0; r < 5; ++r) part[(F.wave * 5 + r) * 64 + F.lane] = acc[r];
        __syncthreads();
        if (F.wave < 5) { float t = F.mod_b[l * MODW + col];
#pragma unroll
            for (int w = 0; w < 8; ++w) t += part[(w * 5 + F.wave) * 64 + F.lane];
            F.MOD[(size_t)(l * 5 + F.wave) * MODW + col] = t; }
        __syncthreads();
    }
    { const int gt = F.gw * 64 + F.lane;
      if (gt < 1024) { const int pos = gt >> 4, f = gt & 15; const float invf = fexp2(-(float)f * (13.287712379549449f / 16.f)); const float rev = (float)pos * invf * 0.15915494309189535f;
          F.ROPE[gt * 2] = __builtin_amdgcn_cosf(rev); F.ROPE[gt * 2 + 1] = __builtin_amdgcn_sinf(rev); } }
    { LAS float* scr = (LAS float*)(F.lds + F.wave * 16384);
      constexpr int I_IN0 = 16 * (AB_IN / 32);
      for (int it = F.gw; it < I_IN0; it += F.ngw) p0_transpose_item(F.ab_w_in, DM, AB_IN, F.WIN0, scr, it, F.lane); }
    p0_convert(F, F.peer_sub_keys, F.SUBK, (size_t)2 * 8 * 2 * 128 * 128 / 8);
}

template <bool SRCB>
__device__ __forceinline__ void mod_phase(const Ctx& F, const GAS float* src_lat, const GAS float* src_ctx, int M, const GAS float* normg, const GAS float* mod_l, int sh, int sc) {
    for (int m = F.gw; m < M; m += F.ngw) {
        const int cond = m < MLAT ? (m >> 12) : 4;
        const GAS float* shp = mod_l + (size_t)cond * MODW + sh * 1024; const GAS float* scp = mod_l + (size_t)cond * MODW + sc * 1024;
        f32x4 v[4]; float s = 0.f;
#pragma unroll
        for (int j = 0; j < 4; ++j) {
            if (SRCB) { const v2u w = *(const GAS v2u*)(F.XS + (size_t)m * DM + 4 * F.lane + 256 * j); v[j] = (f32x4){bflo(w.x), bfhi(w.x), bflo(w.y), bfhi(w.y)}; }
            else { const GAS float* xr = m < MLAT ? src_lat + (size_t)m * DM : src_ctx + (size_t)(m - MLAT) * DM; v[j] = *(const GAS f32x4*)(xr + 4 * F.lane + 256 * j); }
            s += (v[j][0] * v[j][0] + v[j][1] * v[j][1]) + (v[j][2] * v[j][2] + v[j][3] * v[j][3]); }
        f32x4 g[4], a[4], b[4];
#pragma unroll
        for (int j = 0; j < 4; ++j) { const int k = 4 * F.lane + 256 * j; g[j] = *(const GAS f32x4*)(normg + k); a[j] = *(const GAS f32x4*)(scp + k); b[j] = *(const GAS f32x4*)(shp + k); }
        const float r = 1.0f / sqrtf(wave_sum(s) * (1.f / DM) + 1e-6f);
        GAS bf16* orow = F.XN + (size_t)m * DM;
        v2u w[4];
#pragma unroll
        for (int j = 0; j < 4; ++j) {
            f32x4 o;
#pragma unroll
            for (int e = 0; e < 4; ++e) o[e] = v[j][e] * r * g[j][e] * (1.f + a[j][e]) + b[j][e];
            w[j].x = pk2(o[0], o[1]); w[j].y = pk2(o[2], o[3]); }
#pragma unroll
        for (int j = 0; j < 4; ++j) *(GAS v2u*)(orow + 4 * F.lane + 256 * j) = w[j];
    }
}

struct PostSlot { int col; const GAS float* nw; int rope; float scale; GAS bf16* tdst; int nheads; int head; int write_nat; };
constexpr int POST_ROPE = 131072;
__device__ __forceinline__ void post_stage_rope(const Ctx& F) {
    __syncthreads();
    for (int i = F.tid; i < 512; i += NTHR) *(LAS f32x4*)(F.lds + POST_ROPE + 16 * i) = *(const GAS f32x4*)(F.ROPE + 4 * i);
    __syncthreads();
}
__device__ __forceinline__ void post_load(const Ctx& F, const GAS bf16* P, int ld, int tt, int col, v4u (&raws)[8]) {
    const int c = F.lane & 7, rsub = F.lane >> 3;
#pragma unroll
    for (int it = 0; it < 8; ++it) raws[it] = *(const GAS v4u*)(P + (size_t)(tt * 64 + it * 8 + rsub) * ld + col + 8 * c);
}
__device__ __forceinline__ void post_item(const Ctx& F, GAS bf16* P, int ld, int tt, const PostSlot& S, LAS unsigned char* wl) {
    v4u raws[8];
    post_load(F, P, ld, tt, S.col, raws);
    const int lane = F.lane, c = lane & 7, rsub = lane >> 3;
    const bool latent = tt < 256;
    const int m0 = tt * 64;
    const int b = latent ? (tt >> 6) : ((tt - 256) >> 2);
    const int t0 = latent ? ((tt & 63) * 64) : (((tt - 256) & 3) * 64);
    f32x4 nwa = {1.f, 1.f, 1.f, 1.f}, nwb = {1.f, 1.f, 1.f, 1.f};
    if (S.nw) { nwa = *(const GAS f32x4*)(S.nw + 8 * c); nwb = *(const GAS f32x4*)(S.nw + 8 * c + 4); }
#pragma unroll
    for (int it = 0; it < 8; ++it) {
        const int row = it * 8 + rsub;
        GAS bf16* pp = P + (size_t)(m0 + row) * ld + S.col + 8 * c;
        const v4u raw = raws[it];
        float v[8] = {bflo(raw.x), bfhi(raw.x), bflo(raw.y), bfhi(raw.y), bflo(raw.z), bfhi(raw.z), bflo(raw.w), bfhi(raw.w)};
        if (S.nw) {
            float ss = 0.f;
#pragma unroll
            for (int e = 0; e < 8; ++e) ss += v[e] * v[e];
            ss += __shfl_xor(ss, 1); ss += __shfl_xor(ss, 2); ss += __shfl_xor(ss, 4);
            const float r = 1.0f / sqrtf(ss * (1.f / 64.f) + 1e-6f);
#pragma unroll
            for (int e = 0; e < 4; ++e) { v[e] *= r * nwa[e]; v[4 + e] *= r * nwb[e]; }
        }
        if (S.rope && latent) {
            const int t = t0 + row, pos = ((c & 3) < 2) ? (t >> 6) : (t & 63), f0 = (c & 1) * 8;
            LAS const float* rp = (LAS const float*)(F.lds + POST_ROPE) + (pos * 16 + f0) * 2;
            f32x4 rq[4];
#pragma unroll
            for (int j = 0; j < 4; ++j) rq[j] = *(LAS const f32x4*)(rp + 4 * j);
#pragma unroll
            for (int e = 0; e < 8; ++e) {
                const float other = __shfl_xor(v[e], 4);
                const float cs = rq[e >> 1][2 * (e & 1)], sn = rq[e >> 1][2 * (e & 1) + 1];
                v[e] = (c < 4) ? (v[e] * cs - other * sn) : (other * sn + v[e] * cs);
            }
        }
        v4u o; o.x = pk2(v[0] * S.scale, v[1] * S.scale); o.y = pk2(v[2] * S.scale, v[3] * S.scale); o.z = pk2(v[4] * S.scale, v[5] * S.scale); o.w = pk2(v[6] * S.scale, v[7] * S.scale);
        if (S.write_nat) *(GAS v4u*)pp = o;
        if (S.tdst) *(LAS v4u*)(wl + row * 144 + 16 * c) = o;
    }
    if (S.tdst) {
        LDS_WAIT(); asm volatile("" ::: "memory");
        const int tlen = latent ? SEQ : CL;
        GAS bf16* dst = S.tdst + (latent ? (size_t)0 : (size_t)NBATCH * S.nheads * 64 * SEQ) + ((size_t)(b * S.nheads + S.head) * 64 + lane) * tlen + t0;
#pragma unroll
        for (int q = 0; q < 8; ++q) {
            unsigned w[4];
#pragma unroll
            for (int e = 0; e < 4; ++e) {
                const unsigned lo = *(LAS const unsigned short*)(wl + (8 * q + 2 * e) * 144 + 2 * lane);
                const unsigned hi = *(LAS const unsigned short*)(wl + (8 * q + 2 * e + 1) * 144 + 2 * lane);
                w[e] = lo | (hi << 16);
            }
            v4u o; o.x = w[0]; o.y = w[1]; o.z = w[2]; o.w = w[3];
            *(GAS v4u*)(dst + 8 * q) = o;
        }
        LDS_WAIT(); asm volatile("" ::: "memory");
    }
}
#define NEG_BIG (-1.0e30f)
constexpr int SW_KP = 144, SW_CK = 0, SW_CVP = 528, SW_CV = 36864, SW_LK = 70656, SW_LVP = 592, SW_LV = 112128, SW_END = 150016;
__device__ __forceinline__ int kswz(int row, int c8) { const int t = row & 31; return ((row & ~31) + 16 * ((t >> 2) & 1) + 4 * (t >> 3) + (t & 3)) * 144 + 16 * c8; }
__device__ __forceinline__ bf16x8 ldsfrag(LAS const unsigned char* p) { return __builtin_bit_cast(bf16x8, *(LAS const v4u*)p); }

constexpr int NA_RPB = 70656;
template <bool CTXQ>
__device__ __forceinline__ void na_unit2(const Ctx& F, int b, int h, int r, int cg, float Bl2) {
    const int lane = F.lane, qi = lane & 15, g = lane >> 4;
    const GAS bf16* P = F.P;
    LAS const unsigned char* L = F.lds;
    const int c = cg * 16 + qi;
    const size_t qrow = CTXQ ? (size_t)(MLAT + b * CL + r * 16 + qi) : (size_t)(b * SEQ + r * 64 + c);
    const GAS bf16* qp = P + qrow * AB_IN + h * 64 + 8 * g;
    bf16x8 bq[2]; bq[0] = ldfrag(qp); bq[1] = ldfrag(qp + 32);
    const int arow = 8 * (qi >> 2) + (qi & 3);
    const int kz0 = 16 * g, kz1 = kz0 + 64;
    float l = 0.f;
    f32x4 o[4];
#pragma unroll
    for (int db = 0; db < 4; ++db) o[db] = (f32x4){0.f, 0.f, 0.f, 0.f};
    if (!CTXQ) {
        const int kr0 = min(max(r - 4, 0), 56), kc0 = cg == 0 ? 0 : (cg == 1 ? 8 : (cg == 2 ? 24 : 32)), start = min(max(c - 8, 0), 48);
        LAS const float* rpb = (LAS const float*)(L + NA_RPB);
        const GAS bf16* vx = F.TAV + ((size_t)(b * 8 + h) * 64 + qi) * SEQ + 8 * g;
#pragma unroll 4
        for (int y = 0; y < 8; ++y) {
            const int T0 = (kr0 + y) * 64 + kc0;
            LAS const float* rpr = rpb + ((kr0 + y) - r + 7) * 31;
            f32x4 st[2];
#pragma unroll
            for (int hh = 0; hh < 2; ++hh) {
                const GAS bf16* kp = P + (size_t)(b * SEQ + T0 + arow + 4 * hh) * AB_IN + 512 + h * 64 + 8 * g;
                f32x4 a = {0.f, 0.f, 0.f, 0.f};
                a = mfma16(ldfrag(kp), bq[0], a); a = mfma16(ldfrag(kp + 32), bq[1], a);
#pragma unroll
                for (int rr = 0; rr < 4; ++rr) {
                    const int kc = kc0 + 8 * g + 4 * hh + rr;
                    const bool valid = (kc >= start) && (kc < start + 16);
                    const int bi = min(max(kc - c + 15, 0), 30);
                    const float p = fexp2((a[rr] + rpr[bi]) * 1.4426950408889634f - Bl2);
                    a[rr] = valid ? p : 0.f; l += a[rr];
                }
                st[hh] = a;
            }
            const bf16x8 bp = pack8(st[0], st[1]);
#pragma unroll
            for (int db = 0; db < 4; ++db) o[db] = mfma16(ldfrag(vx + (size_t)(16 * db) * SEQ + T0), bp, o[db]);
        }
    }
#pragma unroll 2
    for (int y = 0; y < 8; ++y) {
        f32x4 st[2];
#pragma unroll
        for (int hh = 0; hh < 2; ++hh) {
            LAS const unsigned char* kp = L + SW_CK + (32 * y + 16 * hh + qi) * SW_KP;
            f32x4 a = {0.f, 0.f, 0.f, 0.f};
            a = mfma16(ldsfrag(kp + kz0), bq[0], a); a = mfma16(ldsfrag(kp + kz1), bq[1], a);
#pragma unroll
            for (int rr = 0; rr < 4; ++rr) { const float p = fexp2(a[rr] * 1.4426950408889634f - Bl2); a[rr] = p; l += p; }
            st[hh] = a;
        }
        const bf16x8 bp = pack8(st[0], st[1]);
#pragma unroll
        for (int db = 0; db < 4; ++db) o[db] = mfma16(ldsfrag(L + SW_CV + (16 * db + qi) * SW_CVP + (32 * y + 8 * g) * 2), bp, o[db]);
    }
    l += __shfl_xor(l, 16); l += __shfl_xor(l, 32);
    const float inv = 1.0f / l;
    GAS bf16* op = F.XN + qrow * DM + h * 64 + 4 * g;
#pragma unroll
    for (int db = 0; db < 4; ++db) { v2u w; w.x = pk2(o[db][0] * inv, o[db][1] * inv); w.y = pk2(o[db][2] * inv, o[db][3] * inv); *(GAS v2u*)(op + 16 * db) = w; }
}
__device__ __forceinline__ void na_units4(const Ctx& F, int b, int h, int r0, int cg, float Bl2) {
    const int lane = F.lane, qi = lane & 15, g = lane >> 4;
    const GAS bf16* P = F.P;
    LAS const unsigned char* L = F.lds;
    const int c = cg * 16 + qi;
    const int arow = 8 * (qi >> 2) + (qi & 3);
    const int kz0 = 16 * g, kz1 = kz0 + 64;
    const int kc0 = cg == 0 ? 0 : (cg == 1 ? 8 : (cg == 2 ? 24 : 32)), start = min(max(c - 8, 0), 48);
    LAS const float* rpb = (LAS const float*)(L + NA_RPB);
    bf16x8 bq[4][2]; float l[4]; f32x4 o[4][4];
#pragma unroll
    for (int k = 0; k < 4; ++k) {
        const GAS bf16* qp = P + (size_t)(b * SEQ + (r0 + k) * 64 + c) * AB_IN + h * 64 + 8 * g;
        bq[k][0] = ldfrag(qp); bq[k][1] = ldfrag(qp + 32); l[k] = 0.f;
#pragma unroll
        for (int db = 0; db < 4; ++db) o[k][db] = (f32x4){0.f, 0.f, 0.f, 0.f};
    }
    const int ymin = min(max(r0 - 4, 0), 56), ymax = min(max(r0 + 3 - 4, 0), 56) + 7;
    const GAS bf16* vx = F.TAV + ((size_t)(b * 8 + h) * 64 + qi) * SEQ + 8 * g;
    const GAS bf16* kbase = P + (size_t)(b * SEQ + kc0 + arow) * AB_IN + 512 + h * 64 + 8 * g;
    bf16x8 kf[2][2], vf[4], kn[2][2];
#define NA4_LDK(RR, KF) { const GAS bf16* kp_ = kbase + (size_t)((RR) * 64) * AB_IN; \
        KF[0][0] = ldfrag(kp_); KF[0][1] = ldfrag(kp_ + 32); KF[1][0] = ldfrag(kp_ + (size_t)4 * AB_IN); KF[1][1] = ldfrag(kp_ + (size_t)4 * AB_IN + 32); }
#define NA4_LDV(RR, VF) { const GAS bf16* vp_ = vx + (RR) * 64 + kc0; \
        VF[0] = ldfrag(vp_); VF[1] = ldfrag(vp_ + (size_t)16 * SEQ); VF[2] = ldfrag(vp_ + (size_t)32 * SEQ); VF[3] = ldfrag(vp_ + (size_t)48 * SEQ); }
    if (NA4 == 2) NA4_LDK(ymin, kf)
#pragma unroll 1
    for (int R = ymin; R <= ymax; ++R) {
        if (NA4 == 2) { NA4_LDV(R, vf) if (R < ymax) NA4_LDK(R + 1, kn) __builtin_amdgcn_sched_barrier(0); }
        else { NA4_LDK(R, kf) NA4_LDV(R, vf) }
#pragma unroll
        for (int k = 0; k < 4; ++k) {
            const int r = r0 + k, kr0 = min(max(r - 4, 0), 56);
            if (R >= kr0 && R < kr0 + 8) {
                LAS const float* rpr = rpb + (R - r + 7) * 31;
                f32x4 st[2];
#pragma unroll
                for (int hh = 0; hh < 2; ++hh) {
                    f32x4 a = {0.f, 0.f, 0.f, 0.f};
                    a = mfma16(kf[hh][0], bq[k][0], a); a = mfma16(kf[hh][1], bq[k][1], a);
#pragma unroll
                    for (int rr = 0; rr < 4; ++rr) {
                        const int kc = kc0 + 8 * g + 4 * hh + rr;
                        const bool valid = (kc >= start) && (kc < start + 16);
                        const int bi = min(max(kc - c + 15, 0), 30);
                        const float p = fexp2((a[rr] + rpr[bi]) * 1.4426950408889634f - Bl2);
                        a[rr] = valid ? p : 0.f; l[k] += a[rr];
                    }
                    st[hh] = a;
                }
                const bf16x8 bp = pack8(st[0], st[1]);
#pragma unroll
                for (int db = 0; db < 4; ++db) o[k][db] = mfma16(vf[db], bp, o[k][db]);
            }
        }
        if (NA4 == 2) {
#pragma unroll
            for (int hh = 0; hh < 2; ++hh) { kf[hh][0] = kn[hh][0]; kf[hh][1] = kn[hh][1]; }
        }
    }
#undef NA4_LDK
#undef NA4_LDV
#pragma unroll 2
    for (int y = 0; y < 8; ++y) {
        bf16x8 ck[2][2], cv[4];
#pragma unroll
        for (int hh = 0; hh < 2; ++hh) { LAS const unsigned char* kp = L + SW_CK + (32 * y + 16 * hh + qi) * SW_KP; ck[hh][0] = ldsfrag(kp + kz0); ck[hh][1] = ldsfrag(kp + kz1); }
#pragma unroll
        for (int db = 0; db < 4; ++db) cv[db] = ldsfrag(L + SW_CV + (16 * db + qi) * SW_CVP + (32 * y + 8 * g) * 2);
#pragma unroll
        for (int k = 0; k < 4; ++k) {
            f32x4 st[2];
#pragma unroll
            for (int hh = 0; hh < 2; ++hh) {
                f32x4 a = {0.f, 0.f, 0.f, 0.f};
                a = mfma16(ck[hh][0], bq[k][0], a); a = mfma16(ck[hh][1], bq[k][1], a);
#pragma unroll
                for (int rr = 0; rr < 4; ++rr) { const float p = fexp2(a[rr] * 1.4426950408889634f - Bl2); a[rr] = p; l[k] += p; }
                st[hh] = a;
            }
            const bf16x8 bp = pack8(st[0], st[1]);
#pragma unroll
            for (int db = 0; db < 4; ++db) o[k][db] = mfma16(cv[db], bp, o[k][db]);
        }
    }
#pragma unroll
    for (int k = 0; k < 4; ++k) {
        float lk = l[k];
        lk += __shfl_xor(lk, 16); lk += __shfl_xor(lk, 32);
        const float inv = 1.0f / lk;
        GAS bf16* op = F.XN + (size_t)(b * SEQ + (r0 + k) * 64 + c) * DM + h * 64 + 4 * g;
#pragma unroll
        for (int db = 0; db < 4; ++db) { v2u w; w.x = pk2(o[k][db][0] * inv, o[k][db][1] * inv); w.y = pk2(o[k][db][2] * inv, o[k][db][3] * inv); *(GAS v2u*)(op + 16 * db) = w; }
    }
}
__device__ __forceinline__ void swa_phase(const Ctx& F) {
    const int lane = F.lane, qi = lane & 15, g = lane >> 4, tid = F.tid;
    const GAS bf16* P = F.P;
    LAS unsigned char* L = F.lds;
    float mq = fabsf(F.swa_q_norm[lane]), mk = fabsf(F.swa_k_norm[lane]);
#pragma unroll
    for (int o = 1; o < 64; o <<= 1) { mq = fmaxf(mq, __shfl_xor(mq, o)); mk = fmaxf(mk, __shfl_xor(mk, o)); }
    const float Bl2 = 8.1f * mq * mk * 1.4426950408889634f;
    const int arow = 8 * (qi >> 2) + (qi & 3);
    const int vcu = F.gw >> 3;
    for (int su = vcu; su < 256; su += F.G) {
        const int b = su >> 6, kvh = (su >> 4) & 3, qb0 = (su & 15) * 8;
        const int hq = kvh * 4 + (F.wave >> 1), sb = F.wave & 1;
        __syncthreads();
#pragma unroll
        for (int j = 0; j < 4; ++j) {
            const int cid = tid + 512 * j;
            { const int row = cid >> 3, c8 = cid & 7;
              *(LAS v4u*)(L + SW_CK + kswz(row, c8)) = ld16(P + (size_t)(MLAT + b * CL + row) * SWA_IN + 1024 + kvh * 64 + 8 * c8); }
            { const int d = cid >> 5, c = cid & 31;
              *(LAS v4u*)(L + SW_CV + d * SW_CVP + 16 * c) = ld16(F.TAV + (size_t)NBATCH * 4 * 64 * SEQ + ((size_t)(b * 4 + kvh) * 64 + d) * CL + 8 * c); }
        }
        const float sinkp = fexp2(F.swa_sink[hq] * 1.4426950408889634f - Bl2);
        v4u kreg[5], vreg[5];
#define SW_PREFETCH(T0) do { _Pragma("unroll") for (int j = 0; j < 5; ++j) { const int cid = tid + 512 * j; if (cid < 2304) { \
            { const int row = cid >> 3, c8 = cid & 7; const int s_ = min(max((T0) - 128 + row, 0), SEQ - 1); kreg[j] = ld16(P + (size_t)(b * SEQ + s_) * SWA_IN + 1024 + kvh * 64 + 8 * c8); } \
            { const int d = cid / 36, c = cid - d * 36; const int tok = min(max((T0) - 128 + 8 * c, 0), SEQ - 8); vreg[j] = ld16(F.TAV + ((size_t)(b * 4 + kvh) * 64 + d) * SEQ + tok); } } } } while (0)
        SW_PREFETCH(32 * qb0);
#pragma unroll 1
        for (int iq = 0; iq < 8; ++iq) {
            const int t0 = 32 * (qb0 + iq);
            if (iq > 0) __syncthreads();
#pragma unroll
            for (int j = 0; j < 5; ++j) {
                const int cid = tid + 512 * j;
                if (cid < 2304) {
                    { const int row = cid >> 3, c8 = cid & 7; *(LAS v4u*)(L + SW_LK + kswz(row, c8)) = kreg[j]; }
                    { const int d = cid / 36, c = cid - d * 36; *(LAS v4u*)(L + SW_LV + d * SW_LVP + 16 * c) = vreg[j]; }
                }
            }
            if (iq + 1 < 8) SW_PREFETCH(t0 + 32);
            const int t = t0 + 16 * sb + qi;
            const GAS bf16* qp = P + (size_t)(b * SEQ + t) * SWA_IN + hq * 64 + 8 * g;
            bf16x8 bq[2]; bq[0] = ldfrag(qp); bq[1] = ldfrag(qp + 32);
            __syncthreads();
            float l = 0.f;
            f32x4 o[4];
#pragma unroll
            for (int db = 0; db < 4; ++db) o[db] = (f32x4){0.f, 0.f, 0.f, 0.f};
            f32x4 Sraw[2][2]; bf16x8 Ppk[2];
            const int kc0 = 16 * g, kc1 = kc0 + 64;
#define SW_A(y) do { _Pragma("unroll") for (int hh = 0; hh < 2; ++hh) { \
                LAS const unsigned char* kp = ((y) < 9) ? (L + SW_LK + (32 * (y) + 16 * hh + qi) * SW_KP) : (L + SW_CK + (32 * ((y) - 9) + 16 * hh + qi) * SW_KP); \
                f32x4 a = {0.f, 0.f, 0.f, 0.f}; a = mfma16(ldsfrag(kp + kc0), bq[0], a); a = mfma16(ldsfrag(kp + kc1), bq[1], a); Sraw[(y) & 1][hh] = a; } } while (0)
#define SW_B(y) do { f32x4 st[2]; _Pragma("unroll") for (int hh = 0; hh < 2; ++hh) { f32x4 a = Sraw[(y) & 1][hh]; \
                _Pragma("unroll") for (int rr = 0; rr < 4; ++rr) { float p = fexp2(a[rr] * 1.4426950408889634f - Bl2); \
                    if ((y) < 9) { const int s_ = t0 - 128 + 32 * (y) + 8 * g + 4 * hh + rr; const int d = t - s_; \
                        const bool valid = (s_ >= 0) && (s_ < SEQ) && (d <= 128) && (d >= -128); p = valid ? p : 0.f; } \
                    a[rr] = p; l += p; } st[hh] = a; } Ppk[(y) & 1] = pack8(st[0], st[1]); } while (0)
#define SW_C(y) do { _Pragma("unroll") for (int db = 0; db < 4; ++db) { \
                LAS const unsigned char* vp = ((y) < 9) ? (L + SW_LV + (16 * db + qi) * SW_LVP + (32 * (y) + 8 * g) * 2) : (L + SW_CV + (16 * db + qi) * SW_CVP + (32 * ((y) - 9) + 8 * g) * 2); \
                o[db] = mfma16(ldsfrag(vp), Ppk[(y) & 1], o[db]); } } while (0)
            SW_A(0);
            SW_A(1); SW_B(0);
#pragma unroll
            for (int y = 1; y < 17; ++y) {
                if (y + 1 < 17) SW_A(y + 1);
                SW_C(y - 1);
                SW_B(y);
            }
            SW_C(16);
#undef SW_A
#undef SW_B
#undef SW_C
            l += __shfl_xor(l, 16); l += __shfl_xor(l, 32);
            l += sinkp;
            const float inv = 1.0f / l;
            GAS bf16* op = F.XN + (size_t)(b * SEQ + t) * DM + hq * 64 + 4 * g;
#pragma unroll
            for (int db = 0; db < 4; ++db) { v2u w; w.x = pk2(o[db][0] * inv, o[db][1] * inv); w.y = pk2(o[db][2] * inv, o[db][3] * inv); *(GAS v2u*)(op + 16 * db) = w; }
        }
#undef SW_PREFETCH
    }
    __syncthreads();
}

__device__ __forceinline__ void na_phase(const Ctx& F) {
    const int lane = F.lane, tid = F.tid;
    const GAS bf16* P = F.P;
    LAS unsigned char* L = F.lds;
    float mq = fabsf(F.na_q_norm[lane]), mk = fabsf(F.na_k_norm[lane]);
#pragma unroll
    for (int o = 1; o < 64; o <<= 1) { mq = fmaxf(mq, __shfl_xor(mq, o)); mk = fmaxf(mk, __shfl_xor(mk, o)); }
    const int vcu = F.gw >> 3;
    for (int su = vcu; su < 256; su += F.G) {
        const int bh = su >> 3, e8 = su & 7, b = bh >> 3, h = bh & 7;
        __syncthreads();
#pragma unroll
        for (int j = 0; j < 4; ++j) {
            const int cid = tid + 512 * j;
            { const int row = cid >> 3, c8 = cid & 7;
              *(LAS v4u*)(L + SW_CK + kswz(row, c8)) = ld16(P + (size_t)(MLAT + b * CL + row) * AB_IN + 512 + h * 64 + 8 * c8); }
            { const int d = cid >> 5, c = cid & 31;
              *(LAS v4u*)(L + SW_CV + d * SW_CVP + 16 * c) = ld16(F.TAV + (size_t)NBATCH * 8 * 64 * SEQ + ((size_t)(b * 8 + h) * 64 + d) * CL + 8 * c); }
        }
        float mb = 0.f;
        if (tid < 465) { const float v = F.na_rpb[h * 465 + tid]; ((LAS float*)(L + NA_RPB))[tid] = v; }
        for (int i = lane; i < 465; i += 64) mb = fmaxf(mb, fabsf(F.na_rpb[h * 465 + i]));
#pragma unroll
        for (int o = 1; o < 64; o <<= 1) mb = fmaxf(mb, __shfl_xor(mb, o));
        const float Bl2 = (8.1f * mq * mk + mb) * 1.4426950408889634f;
        __syncthreads();
        na_units4(F, b, h, e8 * 8 + 4 * (F.wave >> 2), F.wave & 3, Bl2);
        if (F.wave < 2) na_unit2<true>(F, b, h, e8 * 2 + F.wave, 0, Bl2);
    }
    __syncthreads();
}

__device__ __forceinline__ int ret_pb(int pf) { return pf < 2 ? 32 + pf : pf - 2; }
__device__ __forceinline__ void ret_r1_unit(const Ctx& F, int bh, int pf, int dir) {
    const int lane = F.lane, qi = lane & 15, g = lane >> 4;
    const int h = bh & 7;
    const float lg2 = -__expf(F.ret_log_decay[dir * 8 + h]) * 1.4426950408889634f;
    const bool isctx = pf < 2;
    const int tlen = isctx ? CL : SEQ;
    const size_t boff = (isctx ? (size_t)NBATCH * 8 * 64 * SEQ : (size_t)0) + (size_t)bh * 64 * tlen + (isctx ? pf * 128 : (pf - 2) * 128);
    const GAS bf16* kt = F.TBK + boff + (size_t)qi * tlen + 8 * g;
    const GAS bf16* vt = F.TBV + boff + (size_t)qi * tlen + 8 * g;
    f32x4 acc[4][4];
#pragma unroll
    for (int db = 0; db < 4; ++db)
#pragma unroll
        for (int kb = 0; kb < 4; ++kb) acc[db][kb] = (f32x4){0.f, 0.f, 0.f, 0.f};
    v4u kr[4], vr[4], kn[4], vn[4];
#define R1_LD(JS, KR, VR) { _Pragma("unroll") for (int x_ = 0; x_ < 4; ++x_) { KR[x_] = ld16(kt + (size_t)(16 * x_) * tlen + 32 * (JS)); VR[x_] = ld16(vt + (size_t)(16 * x_) * tlen + 32 * (JS)); } }
    R1_LD(0, kr, vr)
#pragma unroll 2
    for (int js = 0; js < 4; ++js) {
        if (js + 1 < 4) R1_LD(js + 1, kn, vn)
        __builtin_amdgcn_sched_barrier(0);
        float w[8];
#pragma unroll
        for (int jj = 0; jj < 8; ++jj) { const int j = 32 * js + 8 * g + jj; w[jj] = fexp2(lg2 * (float)(dir == 0 ? 127 - j : j)); }
        bf16x8 bk[4];
#pragma unroll
        for (int kb = 0; kb < 4; ++kb) {
            const v4u raw = kr[kb];
            v4u o; o.x = pk2(bflo(raw.x) * w[0], bfhi(raw.x) * w[1]); o.y = pk2(bflo(raw.y) * w[2], bfhi(raw.y) * w[3]);
            o.z = pk2(bflo(raw.z) * w[4], bfhi(raw.z) * w[5]); o.w = pk2(bflo(raw.w) * w[6], bfhi(raw.w) * w[7]);
            bk[kb] = __builtin_bit_cast(bf16x8, o);
        }
#pragma unroll
        for (int db = 0; db < 4; ++db) {
            const bf16x8 a = __builtin_bit_cast(bf16x8, vr[db]);
#pragma unroll
            for (int kb = 0; kb < 4; ++kb) acc[db][kb] = mfma16(a, bk[kb], acc[db][kb]);
        }
#pragma unroll
        for (int x_ = 0; x_ < 4; ++x_) { kr[x_] = kn[x_]; vr[x_] = vn[x_]; }
    }
#undef R1_LD
    const int idx = dir == 0 ? pf : ret_pb(pf);
    GAS float* out = F.KV + ((size_t)(bh * 2 + dir) * 34 + idx) * 4096;
#pragma unroll
    for (int db = 0; db < 4; ++db)
#pragma unroll
        for (int kb = 0; kb < 4; ++kb)
#pragma unroll
            for (int rr = 0; rr < 4; ++rr) out[(16 * db + 4 * g + rr) * 64 + 16 * kb + qi] = acc[db][kb][rr];
}
__device__ __forceinline__ void ret_r2(const Ctx& F) {
    const int NT = F.ngw * 64;
    for (int it = F.gw * 64 + F.lane; it < 64 * 4096; it += NT) {
        const int unit = it >> 12, e = it & 4095;
        const int dir = unit & 1, h = (unit >> 1) & 7;
        const float gC = fexp2(-__expf(F.ret_log_decay[dir * 8 + h]) * 1.4426950408889634f * 128.f);
        const GAS float* kv = F.KV + (size_t)unit * 34 * 4096 + e;
        GAS bf16* st = F.ST + (size_t)unit * 34 * 4096 + e;
        float kvv[34];
#pragma unroll
        for (int p = 0; p < 34; ++p) kvv[p] = kv[(size_t)p * 4096];
        float S = 0.f;
        if (dir == 0) {
#pragma unroll
            for (int p = 0; p < 34; ++p) { st[(size_t)p * 4096] = (bf16)f2bf(S); S = S * gC + kvv[p]; }
        } else {
#pragma unroll
            for (int p = 33; p >= 0; --p) { st[(size_t)p * 4096] = (bf16)f2bf(S); S = S * gC + kvv[p]; }
        }
    }
}
constexpr int R3_KP = 144, R3_K = 0, R3_VP = 272, R3_V = 18432, R3_SP = 144, R3_SF = 35840, R3_SB = 45056, R3_END = 54272;
__device__ __forceinline__ void ret_r3_phase(const Ctx& F) {
    const int lane = F.lane, qi = lane & 15, g = lane >> 4, tid = F.tid, ib = F.wave;
    const GAS bf16* P = F.P;
    LAS unsigned char* L = F.lds;
    const int arow = 8 * (qi >> 2) + (qi & 3);
    const int kc0 = 16 * g, kc1 = kc0 + 64;
    const int vcu = F.gw >> 3;
    for (int grp = vcu; grp < 32 * 34; grp += F.G) {
        const int bh = grp / 34, pf = grp - bh * 34;
        const int b = bh >> 3, h = bh & 7;
        const bool isctx = pf < 2;
        const size_t row0 = isctx ? (size_t)(MLAT + b * CL + pf * 128) : (size_t)(b * SEQ + (pf - 2) * 128);
        const int tlen = isctx ? CL : SEQ;
        const GAS bf16* vt = F.TBV + (isctx ? (size_t)NBATCH * 8 * 64 * SEQ : (size_t)0) + (size_t)bh * 64 * tlen + (isctx ? pf * 128 : (pf - 2) * 128);
        const GAS bf16* sfp = F.ST + ((size_t)(bh * 2 + 0) * 34 + pf) * 4096;
        const GAS bf16* sbp = F.ST + ((size_t)(bh * 2 + 1) * 34 + ret_pb(pf)) * 4096;
        v4u stk[2], stv[2], stf, stb;
#pragma unroll
        for (int j = 0; j < 2; ++j) {
            const int cid = tid + 512 * j;
            stk[j] = ld16(P + (row0 + (cid >> 3)) * AB_IN + 2048 + h * 64 + 8 * (cid & 7));
            stv[j] = ld16(vt + (size_t)(cid >> 4) * tlen + 8 * (cid & 15));
        }
        stf = ld16(sfp + (tid >> 3) * 64 + 8 * (tid & 7)); stb = ld16(sbp + (tid >> 3) * 64 + 8 * (tid & 7));
        __builtin_amdgcn_sched_barrier(0);
        __syncthreads();
#pragma unroll
        for (int j = 0; j < 2; ++j) {
            const int cid = tid + 512 * j;
            { const int row = cid >> 3, c8 = cid & 7; *(LAS v4u*)(L + R3_K + kswz(row, c8)) = stk[j]; }
            { const int d = cid >> 4, c = cid & 15; *(LAS v4u*)(L + R3_V + d * R3_VP + 16 * c) = stv[j]; }
        }
        { const int d = tid >> 3, c8 = tid & 7;
          *(LAS v4u*)(L + R3_SF + d * R3_SP + 16 * c8) = stf;
          *(LAS v4u*)(L + R3_SB + d * R3_SP + 16 * c8) = stb; }
        const int i = 16 * ib + qi;
        const float lgf = -__expf(F.ret_log_decay[h]) * 1.4426950408889634f, lgb = -__expf(F.ret_log_decay[8 + h]) * 1.4426950408889634f;
        const GAS bf16* qp = P + (row0 + i) * AB_IN + 1536 + h * 64 + 8 * g;
        bf16x8 bq[2]; bq[0] = ldfrag(qp); bq[1] = ldfrag(qp + 32);
        __syncthreads();
        f32x4 o[4];
#pragma unroll
        for (int db = 0; db < 4; ++db) o[db] = (f32x4){0.f, 0.f, 0.f, 0.f};
#pragma unroll
        for (int y = 0; y < 4; ++y) {
            f32x4 st[2];
#pragma unroll
            for (int hh = 0; hh < 2; ++hh) {
                LAS const unsigned char* kp = L + R3_K + (32 * y + 16 * hh + qi) * R3_KP;
                f32x4 a = {0.f, 0.f, 0.f, 0.f};
                a = mfma16(ldsfrag(kp + kc0), bq[0], a); a = mfma16(ldsfrag(kp + kc1), bq[1], a);
#pragma unroll
                for (int rr = 0; rr < 4; ++rr) {
                    const int j = 32 * y + 8 * g + 4 * hh + rr; const int d = i - j;
                    const float w = d > 0 ? fexp2(lgf * (float)d) : (d < 0 ? fexp2(lgb * (float)(-d)) : 1.0f);
                    a[rr] *= w;
                }
                st[hh] = a;
            }
            const bf16x8 bp = pack8(st[0], st[1]);
#pragma unroll
            for (int db = 0; db < 4; ++db) o[db] = mfma16(ldsfrag(L + R3_V + (16 * db + qi) * R3_VP + (32 * y + 8 * g) * 2), bp, o[db]);
        }
        {
            const float df = fexp2(lgf * (float)(i + 1)), dbk = fexp2(lgb * (float)(128 - i));
#pragma unroll
            for (int db = 0; db < 4; ++db) {
                LAS const unsigned char* sf = L + R3_SF + (16 * db + qi) * R3_SP + 16 * g;
                LAS const unsigned char* sb = L + R3_SB + (16 * db + qi) * R3_SP + 16 * g;
                f32x4 xf = {0.f, 0.f, 0.f, 0.f}, xb = {0.f, 0.f, 0.f, 0.f};
                xf = mfma16(ldsfrag(sf), bq[0], xf); xf = mfma16(ldsfrag(sf + 64), bq[1], xf);
                xb = mfma16(ldsfrag(sb), bq[0], xb); xb = mfma16(ldsfrag(sb + 64), bq[1], xb);
                o[db] = o[db] + xf * df + xb * dbk;
            }
        }
        float s = 0.f;
#pragma unroll
        for (int db = 0; db < 4; ++db) s += (o[db][0] + o[db][1]) + (o[db][2] + o[db][3]);
        s += __shfl_xor(s, 16); s += __shfl_xor(s, 32);
        const float mu = s * (1.f / 64.f);
        float q = 0.f;
#pragma unroll
        for (int db = 0; db < 4; ++db)
#pragma unroll
            for (int rr = 0; rr < 4; ++rr) { const float d = o[db][rr] - mu; o[db][rr] = d; q += d * d; }
        q += __shfl_xor(q, 16); q += __shfl_xor(q, 32);
        const float rstd = 1.0f / sqrtf(q * (1.f / 64.f) + 1e-5f);
        const GAS bf16* gp = P + (row0 + i) * AB_IN + 3072 + h * 64 + 4 * g;
        GAS bf16* op = F.XN + (row0 + i) * DM + 512 + h * 64 + 4 * g;
#pragma unroll
        for (int db = 0; db < 4; ++db) {
            const v2u gr = *(const GAS v2u*)(gp + 16 * db);
            const float gv[4] = {bflo(gr.x), bfhi(gr.x), bflo(gr.y), bfhi(gr.y)};
            float r[4];
#pragma unroll
            for (int rr = 0; rr < 4; ++rr) r[rr] = o[db][rr] * rstd * (gv[rr] / (1.f + fexp(-gv[rr])));
            v2u w; w.x = pk2(r[0], r[1]); w.y = pk2(r[2], r[3]); *(GAS v2u*)(op + 16 * db) = w;
        }
    }
    __syncthreads();
}
__device__ __constant__ unsigned char CAND_TAB[52] = {
    0x00,0x01,0x02,0x03,0x04,0x05,0x06,0x07,0x08,0x09,0x0a,0x0b,0x0c,0x0d,0x0e,0x0f,
    0x10,0x11,0x12,0x13,0x14,0x15,0x16,0x17,
    0x20,0x21,0x22,0x23,0x24,
    0x30,0x31,0x32,0x33,
    0x40,0x41,0x42, 0x50,0x51, 0x60,0x61, 0x70,0x71,
    0x80,0x90,0xa0,0xb0,0xc0,0xd0,0xe0,0xf0,
    0x00,0x00 };
#define SORT_NEG (-3.0e38f)
template <int LOGN>
__device__ __forceinline__ void bitonic_sort_desc(float (&v)[1 << LOGN]) {
    constexpr int N = 1 << LOGN;
#pragma unroll
    for (int kk = 1; kk <= LOGN; ++kk) {
#pragma unroll
        for (int jj = kk - 1; jj >= 0; --jj) {
#pragma unroll
            for (int i = 0; i < N; ++i) {
                const int k = 1 << kk, j = 1 << jj, l = i ^ j;
                if (l > i) {
                    const bool desc = ((i & k) == 0);
                    const float a = v[i], b = v[l];
                    const float hi = fmaxf(a, b), lo = fminf(a, b);
                    v[i] = desc ? hi : lo; v[l] = desc ? lo : hi;
                }
            }
        }
    }
}
__device__ __forceinline__ void merge_top16(float (&v)[16], int mask) {
    float c[16];
#pragma unroll
    for (int i = 0; i < 16; ++i) c[i] = fmaxf(v[i], __shfl_xor(v[15 - i], mask));
#pragma unroll
    for (int jj = 3; jj >= 0; --jj) {
#pragma unroll
        for (int i = 0; i < 16; ++i) { const int j = 1 << jj, l = i ^ j;
            if (l > i) { const float a = c[i], b = c[l]; c[i] = fmaxf(a, b); c[l] = fminf(a, b); } }
    }
#pragma unroll
    for (int i = 0; i < 16; ++i) v[i] = c[i];
}
__device__ __forceinline__ void merge_top16_local(float (&a)[16], const float (&b)[16]) {
    float c[16];
#pragma unroll
    for (int i = 0; i < 16; ++i) c[i] = fmaxf(a[i], b[15 - i]);
#pragma unroll
    for (int jj = 3; jj >= 0; --jj) {
#pragma unroll
        for (int i = 0; i < 16; ++i) { const int j = 1 << jj, l = i ^ j;
            if (l > i) { const float x = c[i], y = c[l]; c[i] = fmaxf(x, y); c[l] = fminf(x, y); } }
    }
#pragma unroll
    for (int i = 0; i < 16; ++i) a[i] = c[i];
}
constexpr int SC_KP = 272, SC_KEYS = 0, SC_PSTRIDE = 128 * SC_KP, SC_WL = 73728;
__device__ __forceinline__ size_t q2_off(size_t tb, int qi, int h, int p, int ks, int g) {
    return QFRAG ? ((((((tb * 8 + h) * 2 + p) * 4 + ks) * 4 + g) * 16 + qi) * 8) : ((tb * 16 + qi) * PQD + h * 256 + p * 128 + 32 * ks + 8 * g);
}
__device__ __forceinline__ void peer_score_unit(const Ctx& F, int tb, int h, LAS unsigned* wl, bf16x8 (&bq0)[4], int tbn) {
    const int lane = F.lane, qi = lane & 15, g = lane >> 4;
    const size_t m = (size_t)tb * 16 + qi;
    bf16x8 bq1[4];
#pragma unroll 1
    for (int p = 0; p < 2; ++p) {
        bf16x8 bq[4];
#pragma unroll
        for (int ks = 0; ks < 4; ++ks) bq[ks] = ldfrag(F.Q2 + q2_off((size_t)tb, qi, h, p, ks, g));
        LAS const unsigned char* kp = F.lds + SC_KEYS + p * SC_PSTRIDE + qi * SC_KP + 16 * g;
        float va[16], vb[16];
#pragma unroll
        for (int kb = 0; kb < 8; ++kb) {
            f32x4 a = {0.f, 0.f, 0.f, 0.f};
#pragma unroll
            for (int ks = 0; ks < 4; ++ks) a = mfma16(ldsfrag(kp + (16 * kb) * SC_KP + 64 * ks), bq[ks], a);
#pragma unroll
            for (int rr = 0; rr < 4; ++rr) {
                const float pv = __uint_as_float((__float_as_uint(a[rr]) & ~127u) | (unsigned)(16 * kb + 4 * g + rr));
                if (kb < 4) va[4 * kb + rr] = pv; else vb[4 * (kb - 4) + rr] = pv;
            }
        }
        bitonic_sort_desc<4>(va); bitonic_sort_desc<4>(vb);
        merge_top16_local(va, vb);
        merge_top16(va, 16); merge_top16(va, 32);
        if (g == 0) {
#pragma unroll
            for (int i = 0; i < 16; ++i) wl[(qi * 2 + p) * 16 + i] = __float_as_uint(va[i]);
        }
    }
    LDS_WAIT(); asm volatile("" ::: "memory");
    LAS const unsigned char* tab = (LAS const unsigned char*)(wl + 512);
    float cd[16];
#pragma unroll
    for (int k = 0; k < 13; ++k) {
        const int code = g * 13 + k;
        const unsigned ij = tab[code];
        const unsigned a = wl[(qi * 2 + 0) * 16 + (ij >> 4)], b = wl[(qi * 2 + 1) * 16 + (ij & 15)];
        const float s = __uint_as_float(a & ~127u) + __uint_as_float(b & ~127u);
        cd[k] = code < 50 ? __uint_as_float((__float_as_uint(s) & ~63u) | (unsigned)code) : SORT_NEG;
    }
    cd[13] = SORT_NEG; cd[14] = SORT_NEG; cd[15] = SORT_NEG;
    bitonic_sort_desc<4>(cd);
    merge_top16(cd, 16); merge_top16(cd, 32);
    float e[16]; float sum = 0.f;
    const float mx = __uint_as_float(__float_as_uint(cd[0]) & ~63u);
#pragma unroll
    for (int k = 0; k < 16; ++k) { e[k] = fexp(__uint_as_float(__float_as_uint(cd[k]) & ~63u) - mx); sum += e[k]; }
    const float inv = 1.0f / sum;
    typedef int i32x4 __attribute__((ext_vector_type(4)));
    i32x4 oi; f32x4 og;
#pragma unroll
    for (int k = 0; k < 4; ++k) {
        const float cv = g == 0 ? cd[k] : (g == 1 ? cd[4 + k] : (g == 2 ? cd[8 + k] : cd[12 + k]));
        const float ev = g == 0 ? e[k] : (g == 1 ? e[4 + k] : (g == 2 ? e[8 + k] : e[12 + k]));
        const unsigned code = __float_as_uint(cv) & 63u;
        const unsigned ij = tab[code];
        const unsigned a = wl[(qi * 2 + 0) * 16 + (ij >> 4)] & 127u, b = wl[(qi * 2 + 1) * 16 + (ij & 15)] & 127u;
        oi[k] = (int)(a * 128u + b);
        og[k] = ev * inv;
    }
    *(GAS i32x4*)(F.IDX + m * 128 + h * 16 + 4 * g) = oi;
    *(GAS f32x4*)(F.GATE + m * 128 + h * 16 + 4 * g) = og;
    LDS_WAIT(); asm volatile("" ::: "memory");
}
__device__ __forceinline__ void peer_score_phase(const Ctx& F, int l, int Mp) {
    const int vcu = F.gw >> 3, tid = F.tid;
    LAS unsigned* wl = (LAS unsigned*)(F.lds + SC_WL + F.wave * (SC2 ? 8192 : 4096));
    if (F.lane < 52) ((LAS unsigned char*)(wl + 512))[F.lane] = CAND_TAB[F.lane];
    const int nj = (F.G >= 8) ? F.G / 8 : 1;
    const int nb = Mp / 16;
    for (int hh = vcu & 7; hh < 8; hh += (F.G >= 8 ? 8 : F.G)) {
        __syncthreads();
        const GAS bf16* src = F.SUBK + (size_t)((l * 8 + hh) * 2) * 128 * 128;
#pragma unroll
        for (int j = 0; j < 8; ++j) { const int cid = tid + 512 * j; const int row = cid >> 4, c16 = cid & 15;
            *(LAS v4u*)(F.lds + SC_KEYS + row * SC_KP + 16 * c16) = ld16(src + (size_t)row * 128 + 8 * c16); }
        __syncthreads();
        { const int tb0 = (vcu >> 3) % nj + nj * F.wave, qi = F.lane & 15, g = F.lane >> 4;
          bf16x8 bq0[4];
          if (SCPF && tb0 < nb) {
#pragma unroll
              for (int ks = 0; ks < 4; ++ks) bq0[ks] = ldfrag(F.Q2 + q2_off((size_t)tb0, qi, hh, 0, ks, g));
          }
          for (int tb = tb0; tb < nb; tb += nj * NWAVES) { const int tbn = tb + nj * NWAVES; peer_score_unit(F, tb, hh, wl, bq0, tbn < nb ? tbn : -1); }
        }
    }
    __syncthreads();
}

typedef float f32x2 __attribute__((ext_vector_type(2)));
#define DPP_XOR1(x) __builtin_bit_cast(float, __builtin_amdgcn_update_dpp(0, __builtin_bit_cast(int, (x)), 0xB1, 0xf, 0xf, false))
#define DPP_XOR2(x) __builtin_bit_cast(float, __builtin_amdgcn_update_dpp(0, __builtin_bit_cast(int, (x)), 0x4E, 0xf, 0xf, false))
#define DPP_ROR4(x) __builtin_bit_cast(float, __builtin_amdgcn_update_dpp(0, __builtin_bit_cast(int, (x)), 0x124, 0xf, 0xf, false))
#define DPP_ROR8(x) __builtin_bit_cast(float, __builtin_amdgcn_update_dpp(0, __builtin_bit_cast(int, (x)), 0x128, 0xf, 0xf, false))
__device__ __forceinline__ float xsum16(float x) { auto rr = __builtin_amdgcn_permlane16_swap(__float_as_uint(x), __float_as_uint(x), false, false); return __uint_as_float(rr[0]) + __uint_as_float(rr[1]); }
__device__ __forceinline__ float xsum32(float x) { auto rr = __builtin_amdgcn_permlane32_swap(__float_as_uint(x), __float_as_uint(x), false, false); return __uint_as_float(rr[0]) + __uint_as_float(rr[1]); }
__device__ __forceinline__ float reduce16pairs(const float (&p)[16], int lane) {
    const bool o1 = lane & 1, o2 = lane & 2;
    float a[8];
#pragma unroll
    for (int k = 0; k < 8; ++k) { const float keep = o1 ? p[2 * k + 1] : p[2 * k], send = o1 ? p[2 * k] : p[2 * k + 1]; a[k] = keep + DPP_XOR1(send); }
    float b[4];
#pragma unroll
    for (int k = 0; k < 4; ++k) { const float keep = o2 ? a[2 * k + 1] : a[2 * k], send = o2 ? a[2 * k] : a[2 * k + 1]; b[k] = keep + DPP_XOR2(send); }
#pragma unroll
    for (int k = 0; k < 4; ++k) { b[k] += DPP_ROR4(b[k]); b[k] += DPP_ROR8(b[k]); b[k] = xsum16(b[k]); }
    const int j = (lane >> 2) & 3;
    return j == 0 ? b[0] : (j == 1 ? b[1] : (j == 2 ? b[2] : b[3]));
}
typedef unsigned u32x16v __attribute__((ext_vector_type(16)));
__device__ __forceinline__ u32x6v ld24(const GAS unsigned char* p) {
    const v2u a = *(const GAS v2u*)p, b = *(const GAS v2u*)(p + 8), c = *(const GAS v2u*)(p + 16);
    return (u32x6v){a.x, a.y, b.x, b.y, c.x, c.y};
}
template <bool FP4> struct RowBuf { typedef u32x6v T; };
template <> struct RowBuf<true> { typedef v4u T; };
__device__ __forceinline__ void row_ld(v4u& r, const GAS unsigned char* T, unsigned row, unsigned q) { r = *(const GAS v4u*)(T + (row * 512u + 16u * q)); }
__device__ __forceinline__ void row_ld(u32x6v& r, const GAS unsigned char* T, unsigned row, unsigned q) { r = ld24(T + (row * 768u + 24u * q)); }
__device__ __forceinline__ u32x16v row_unpack(const v4u& r) {
    u32x16v f;
#pragma unroll
    for (int d = 0; d < 4; ++d) {
        f[4 * d + 0] = __builtin_bit_cast(unsigned, __builtin_amdgcn_cvt_scalef32_pk_bf16_fp4(r[d], 1.0f, 0));
        f[4 * d + 1] = __builtin_bit_cast(unsigned, __builtin_amdgcn_cvt_scalef32_pk_bf16_fp4(r[d], 1.0f, 1));
        f[4 * d + 2] = __builtin_bit_cast(unsigned, __builtin_amdgcn_cvt_scalef32_pk_bf16_fp4(r[d], 1.0f, 2));
        f[4 * d + 3] = __builtin_bit_cast(unsigned, __builtin_amdgcn_cvt_scalef32_pk_bf16_fp4(r[d], 1.0f, 3));
    }
    return f;
}
__device__ __forceinline__ u32x16v row_unpack(const u32x6v& r) { return __builtin_bit_cast(u32x16v, __builtin_amdgcn_cvt_scalef32_pk32_bf16_fp6(r, 1.0f)); }
template <int S, bool FP4>
__device__ __forceinline__ void pg_load(typename RowBuf<FP4>::T (&r)[8], const GAS unsigned char* T, int i0, int i1, bool up, unsigned q) {
    constexpr int bt = S >> 2, c = (S >> 1) & 1, sub = S & 1;
    const int idv = bt ? i1 : i0;
    constexpr int j0 = c * 16 + sub * 8;
    row_ld(r[0], T, (unsigned)__builtin_amdgcn_ds_swizzle(idv, (j0 + 0) << 5), q); row_ld(r[1], T, (unsigned)__builtin_amdgcn_ds_swizzle(idv, (j0 + 1) << 5), q);
    row_ld(r[2], T, (unsigned)__builtin_amdgcn_ds_swizzle(idv, (j0 + 2) << 5), q); row_ld(r[3], T, (unsigned)__builtin_amdgcn_ds_swizzle(idv, (j0 + 3) << 5), q);
    row_ld(r[4], T, (unsigned)__builtin_amdgcn_ds_swizzle(idv, (j0 + 4) << 5), q); row_ld(r[5], T, (unsigned)__builtin_amdgcn_ds_swizzle(idv, (j0 + 5) << 5), q);
    row_ld(r[6], T, (unsigned)__builtin_amdgcn_ds_swizzle(idv, (j0 + 6) << 5), q); row_ld(r[7], T, (unsigned)__builtin_amdgcn_ds_swizzle(idv, (j0 + 7) << 5), q);
#pragma unroll
    for (int k = 0; k < 8; ++k) {
    }
}
template <int S, bool FP4, bool LDO = false>
__device__ __forceinline__ void pg_dot(const typename RowBuf<FP4>::T (&r)[8], const unsigned (&h)[16], const f32x2 (&hf)[16], float (&p)[16]) {
    constexpr int sub = S & 1;
#pragma unroll
    for (int k = 0; k < 8; ++k) {
        if (LDO) { p[sub * 8 + k] = __uint_as_float((r[k][0] ^ r[k][1] ^ r[k][2] ^ r[k][3]) & 0x3fffffffu); }
        else if (FP4) {
            f32x2 s0 = {0.f, 0.f}, s1 = {0.f, 0.f};
#pragma unroll
            for (int d = 0; d < 4; ++d) {
                s0 += __builtin_amdgcn_cvt_scalef32_pk_f32_fp4(r[k][d], 1.0f, 0) * hf[4 * d + 0];
                s1 += __builtin_amdgcn_cvt_scalef32_pk_f32_fp4(r[k][d], 1.0f, 1) * hf[4 * d + 1];
                s0 += __builtin_amdgcn_cvt_scalef32_pk_f32_fp4(r[k][d], 1.0f, 2) * hf[4 * d + 2];
                s1 += __builtin_amdgcn_cvt_scalef32_pk_f32_fp4(r[k][d], 1.0f, 3) * hf[4 * d + 3];
            }
            const f32x2 t = s0 + s1;
            p[sub * 8 + k] = t.x + t.y;
        } else {
            const u32x16v f = row_unpack(r[k]);
            float s0 = 0.f, s1 = 0.f;
#pragma unroll
            for (int e = 0; e < 16; e += 2) { s0 = dot2bf(f[e], h[e], s0); s1 = dot2bf(f[e + 1], h[e + 1], s1); }
            p[sub * 8 + k] = s0 + s1;
        }
    }
}
template <int S, bool FP4, bool LDO = false>
__device__ __forceinline__ void pg_axpy(const typename RowBuf<FP4>::T (&r)[8], float wgt0, float wgt1, bool up, float (&acc)[32]) {
    constexpr int bt = S >> 2, c = (S >> 1) & 1, sub = S & 1;
    const float wgt = bt ? wgt1 : wgt0;
#pragma unroll
    for (int k = 0; k < 8; ++k) {
        if (LDO) { acc[(S * 8 + k) & 31] += __uint_as_float((r[k][0] ^ r[k][1] ^ r[k][2] ^ r[k][3]) & 0x3fffffffu); continue; }
        const float wA = __uint_as_float(__builtin_amdgcn_readlane(__float_as_uint(wgt), c * 16 + sub * 8 + k));
        const float wB = __uint_as_float(__builtin_amdgcn_readlane(__float_as_uint(wgt), 32 + c * 16 + sub * 8 + k));
        const float w = up ? wB : wA;
        if (FP4) {
            const f32x2 w2 = (f32x2){w, w};
#pragma unroll
            for (int d = 0; d < 4; ++d) {
                { const f32x2 f = __builtin_amdgcn_cvt_scalef32_pk_f32_fp4(r[k][d], 1.0f, 0); const f32x2 a = (f32x2){acc[8 * d + 0], acc[8 * d + 1]} + w2 * f; acc[8 * d + 0] = a.x; acc[8 * d + 1] = a.y; }
                { const f32x2 f = __builtin_amdgcn_cvt_scalef32_pk_f32_fp4(r[k][d], 1.0f, 1); const f32x2 a = (f32x2){acc[8 * d + 2], acc[8 * d + 3]} + w2 * f; acc[8 * d + 2] = a.x; acc[8 * d + 3] = a.y; }
                { const f32x2 f = __builtin_amdgcn_cvt_scalef32_pk_f32_fp4(r[k][d], 1.0f, 2); const f32x2 a = (f32x2){acc[8 * d + 4], acc[8 * d + 5]} + w2 * f; acc[8 * d + 4] = a.x; acc[8 * d + 5] = a.y; }
                { const f32x2 f = __builtin_amdgcn_cvt_scalef32_pk_f32_fp4(r[k][d], 1.0f, 3); const f32x2 a = (f32x2){acc[8 * d + 6], acc[8 * d + 7]} + w2 * f; acc[8 * d + 6] = a.x; acc[8 * d + 7] = a.y; }
            }
        } else {
            const unsigned wlo = f2bf(w), whi = wlo << 16;
            const u32x16v f = row_unpack(r[k]);
#pragma unroll
            for (int e = 0; e < 16; ++e) { acc[2 * e] = dot2bf(f[e], wlo, acc[2 * e]); acc[2 * e + 1] = dot2bf(f[e], whi, acc[2 * e + 1]); }
        }
    }
}
typedef _Float16 h2v __attribute__((ext_vector_type(2)));
template <int S, int PH = 0>
__device__ __forceinline__ void pg_axpy_h(const v4u (&r)[8], float wgt0, float wgt1, bool up, h2v (&acc)[16]) {
    constexpr int bt = S >> 2, c = (S >> 1) & 1, sub = S & 1, j0 = c * 16 + sub * 8;
    const int wp = __float_as_int(bt ? wgt1 : wgt0);
    const int wsw[8] = {__builtin_amdgcn_ds_swizzle(wp, (j0 + 0) << 5), __builtin_amdgcn_ds_swizzle(wp, (j0 + 1) << 5), __builtin_amdgcn_ds_swizzle(wp, (j0 + 2) << 5), __builtin_amdgcn_ds_swizzle(wp, (j0 + 3) << 5),
                        __builtin_amdgcn_ds_swizzle(wp, (j0 + 4) << 5), __builtin_amdgcn_ds_swizzle(wp, (j0 + 5) << 5), __builtin_amdgcn_ds_swizzle(wp, (j0 + 6) << 5), __builtin_amdgcn_ds_swizzle(wp, (j0 + 7) << 5)};
#pragma unroll
    for (int k = 0; k < 8; ++k) {
        const h2v wh = __builtin_bit_cast(h2v, wsw[k]);
        int f[16];
        if (PH & 2) {
#pragma unroll
            for (int e = 0; e < 16; ++e) f[e] = (int)(r[k][e & 3] & 0x3c003c00u) + e;
        } else
#pragma unroll
        for (int d = 0; d < 4; ++d) {
            f[4 * d + 0] = __builtin_bit_cast(int, __builtin_amdgcn_cvt_scalef32_pk_f16_fp4(r[k][d], 1.0f, 0));
            f[4 * d + 1] = __builtin_bit_cast(int, __builtin_amdgcn_cvt_scalef32_pk_f16_fp4(r[k][d], 1.0f, 1));
            f[4 * d + 2] = __builtin_bit_cast(int, __builtin_amdgcn_cvt_scalef32_pk_f16_fp4(r[k][d], 1.0f, 2));
            f[4 * d + 3] = __builtin_bit_cast(int, __builtin_amdgcn_cvt_scalef32_pk_f16_fp4(r[k][d], 1.0f, 3));
        }
        asm volatile("" : "+v"(f[0]), "+v"(f[1]), "+v"(f[2]), "+v"(f[3]), "+v"(f[4]), "+v"(f[5]), "+v"(f[6]), "+v"(f[7]), "+v"(f[8]), "+v"(f[9]), "+v"(f[10]), "+v"(f[11]), "+v"(f[12]), "+v"(f[13]), "+v"(f[14]), "+v"(f[15]));
        if (PH & 1) {
#pragma unroll
            for (int e = 0; e < 16; ++e) asm volatile("" :: "v"(f[e]));
            acc[k] = __builtin_bit_cast(h2v, f[k] ^ __builtin_bit_cast(int, wh));
        } else
#pragma unroll
        for (int e = 0; e < 16; ++e) acc[e] = __builtin_elementwise_fma(wh, __builtin_bit_cast(h2v, f[e]), acc[e]);
    }
}
template <bool LDO = false>
__device__ __forceinline__ void peer_gather_u(const Ctx& F, int l, size_t m, float& wgt0, float& wgt1, int rm = -1) {
    const int lane = F.lane, q = lane & 31;
    const bool up = lane >= 32;
    const GAS int* ip = F.IDX + m * 128; const GAS float* gp = F.GATE + m * 128;
    const int i0 = ip[lane] & rm, i1 = ip[64 + lane] & rm;
    const float ga0 = gp[lane], ga1 = gp[64 + lane];
    const GAS unsigned char* U = F.U8 + (size_t)l * 16384 * U_ROWB;
    typename RowBuf<U_FP4 != 0>::T ra[8], rb[8];
    pg_load<0, U_FP4 != 0>(ra, U, i0, i1, up, (unsigned)q);
    unsigned h[16];
    { const GAS bf16* hp = F.XN + m * DM + 32 * q;
#pragma unroll
      for (int j = 0; j < 4; ++j) { const v4u w = ld16(hp + 8 * j); h[4 * j] = w.x; h[4 * j + 1] = w.y; h[4 * j + 2] = w.z; h[4 * j + 3] = w.w; } }
    f32x2 hf[16];
#pragma unroll
    for (int i = 0; i < 16; ++i) hf[i] = (f32x2){bflo(h[i]), bfhi(h[i])};
    const GAS float* SU = F.SU + l * 16384; const GAS float* SV = F.SV + l * 16384;
    const float su0 = SU[i0], sv0 = SV[i0], su1 = SU[i1], sv1 = SV[i1];
    const int cl = (lane >> 4) & 1;
    float p[16]; float act0 = 0.f, act1 = 0.f, tot;
    pg_load<1, U_FP4 != 0>(rb, U, i0, i1, up, (unsigned)q); pg_dot<0, U_FP4 != 0, LDO>(ra, h, hf, p);
    pg_load<2, U_FP4 != 0>(ra, U, i0, i1, up, (unsigned)q); pg_dot<1, U_FP4 != 0, LDO>(rb, h, hf, p); tot = reduce16pairs(p, lane); act0 = (cl == 0) ? tot : act0;
    pg_load<3, U_FP4 != 0>(rb, U, i0, i1, up, (unsigned)q); pg_dot<2, U_FP4 != 0, LDO>(ra, h, hf, p);
    pg_load<4, U_FP4 != 0>(ra, U, i0, i1, up, (unsigned)q); pg_dot<3, U_FP4 != 0, LDO>(rb, h, hf, p); tot = reduce16pairs(p, lane); act0 = (cl == 1) ? tot : act0;
    pg_load<5, U_FP4 != 0>(rb, U, i0, i1, up, (unsigned)q); pg_dot<4, U_FP4 != 0, LDO>(ra, h, hf, p);
    pg_load<6, U_FP4 != 0>(ra, U, i0, i1, up, (unsigned)q); pg_dot<5, U_FP4 != 0, LDO>(rb, h, hf, p); tot = reduce16pairs(p, lane); act1 = (cl == 0) ? tot : act1;
    pg_load<7, U_FP4 != 0>(rb, U, i0, i1, up, (unsigned)q); pg_dot<6, U_FP4 != 0, LDO>(ra, h, hf, p);
    pg_dot<7, U_FP4 != 0, LDO>(rb, h, hf, p); tot = reduce16pairs(p, lane); act1 = (cl == 1) ? tot : act1;
    wgt0 = gelu_erf(act0 * su0) * ga0 * sv0;
    wgt1 = gelu_erf(act1 * su1) * ga1 * sv1;
}
template <bool XNOUT>
__device__ __forceinline__ void peer_v_finish_tot(const Ctx& F, size_t m, float (&tot)[16], const GAS float* g2, GAS float* dst_row, const GAS float* ng, const GAS float* nsh, const GAS float* nsc, bool ns, float osc);
template <bool XNOUT>
__device__ __forceinline__ void peer_v_finish(const Ctx& F, size_t m, float (&acc)[32], const GAS float* g2, GAS float* dst_row, const GAS float* ng, const GAS float* nsh, const GAS float* nsc, bool ns = false, float osc = 1.f) {
    float tot[16];
#pragma unroll
    for (int i = 0; i < 16; ++i) {
        auto rr = __builtin_amdgcn_permlane32_swap(__float_as_uint(acc[i]), __float_as_uint(acc[i + 16]), false, false);
        tot[i] = __uint_as_float(rr[0]) + __uint_as_float(rr[1]);
    }
    peer_v_finish_tot<XNOUT>(F, m, tot, g2, dst_row, ng, nsh, nsc, ns, osc);
}
template <bool XNOUT>
__device__ __forceinline__ void peer_v_finish_tot(const Ctx& F, size_t m, float (&tot)[16], const GAS float* g2, GAS float* dst_row, const GAS float* ng, const GAS float* nsh, const GAS float* nsc, bool ns, float osc) {
    const int lane = F.lane, q = lane & 31;
    const bool up = lane >= 32;
    const int k0 = 32 * q + (up ? 16 : 0);
    const GAS bf16* src = F.XS + m * DM + k0;
    const GAS float* gg = g2 + k0;
    float xin[16];
    { const v4u a = ld16(src), b = ld16(src + 8);
      xin[0] = bflo(a.x); xin[1] = bfhi(a.x); xin[2] = bflo(a.y); xin[3] = bfhi(a.y); xin[4] = bflo(a.z); xin[5] = bfhi(a.z); xin[6] = bflo(a.w); xin[7] = bfhi(a.w);
      xin[8] = bflo(b.x); xin[9] = bfhi(b.x); xin[10] = bflo(b.y); xin[11] = bfhi(b.y); xin[12] = bflo(b.z); xin[13] = bfhi(b.z); xin[14] = bflo(b.w); xin[15] = bfhi(b.w); }
    float ss = 0.f;
#pragma unroll
    for (int j = 0; j < 4; ++j) {
        const f32x4 ga = *(const GAS f32x4*)(gg + 4 * j);
#pragma unroll
        for (int e = 0; e < 4; ++e) { const float o = xin[4 * j + e] + ga[e] * tot[4 * j + e]; tot[4 * j + e] = o; ss += o * o; }
    }
    if (ns && ss != 1.2345e-30f) return;
    if (XNOUT) {
        GAS bf16* dp = F.XS + m * DM + k0;
        v4u w0, w1;
        w0.x = pk2(tot[0], tot[1]); w0.y = pk2(tot[2], tot[3]); w0.z = pk2(tot[4], tot[5]); w0.w = pk2(tot[6], tot[7]);
        w1.x = pk2(tot[8], tot[9]); w1.y = pk2(tot[10], tot[11]); w1.z = pk2(tot[12], tot[13]); w1.w = pk2(tot[14], tot[15]);
        *(GAS v4u*)dp = w0; *(GAS v4u*)(dp + 8) = w1;
    } else {
        GAS float* dp = dst_row + k0;
#pragma unroll
        for (int j = 0; j < 4; ++j) *(GAS f32x4*)(dp + 4 * j) = (f32x4){tot[4 * j] * osc, tot[4 * j + 1] * osc, tot[4 * j + 2] * osc, tot[4 * j + 3] * osc};
    }
    if (XNOUT) {
        const float r = 1.0f / sqrtf(wave_sum(ss) * (1.f / DM) + 1e-6f);
        GAS bf16* xo = F.XN + m * DM + k0;
#pragma unroll
        for (int j = 0; j < 2; ++j) {
            float o[8];
#pragma unroll
            for (int e = 0; e < 8; ++e) { const int k = 8 * j + e; o[e] = tot[k] * r * ng[k0 + k] * (1.f + nsc[k0 + k]) + nsh[k0 + k]; }
            v4u w; w.x = pk2(o[0], o[1]); w.y = pk2(o[2], o[3]); w.z = pk2(o[4], o[5]); w.w = pk2(o[6], o[7]);
            *(GAS v4u*)(xo + 8 * j) = w;
        }
    }
}
template <bool XNOUT> struct VFin { v4u xa, xb; f32x4 ga[4]; f32x4 ng[XNOUT ? 4 : 1], nsc[XNOUT ? 4 : 1], nsh[XNOUT ? 4 : 1]; };
template <bool XNOUT>
__device__ __forceinline__ void vfin_load(const Ctx& F, size_t m, const GAS float* g2, const GAS float* ng, const GAS float* nsh, const GAS float* nsc, VFin<XNOUT>& P) {
    const int lane = F.lane, k0 = 32 * (lane & 31) + (lane >= 32 ? 16 : 0);
    const GAS bf16* src = F.XS + m * DM + k0;
    P.xa = ld16(src); P.xb = ld16(src + 8);
#pragma unroll
    for (int j = 0; j < 4; ++j) P.ga[j] = *(const GAS f32x4*)(g2 + k0 + 4 * j);
    if (XNOUT) {
#pragma unroll
        for (int j = 0; j < 4; ++j) { P.ng[j] = *(const GAS f32x4*)(ng + k0 + 4 * j); P.nsc[j] = *(const GAS f32x4*)(nsc + k0 + 4 * j); P.nsh[j] = *(const GAS f32x4*)(nsh + k0 + 4 * j); }
    }
}
template <bool XNOUT>
__device__ __forceinline__ void peer_v_finish_pre(const Ctx& F, size_t m, float (&tot)[16], GAS float* dst_row, const VFin<XNOUT>& P) {
    const int lane = F.lane, k0 = 32 * (lane & 31) + (lane >= 32 ? 16 : 0);
    const v4u a = P.xa, b = P.xb;
    const float xin[16] = {bflo(a.x), bfhi(a.x), bflo(a.y), bfhi(a.y), bflo(a.z), bfhi(a.z), bflo(a.w), bfhi(a.w), bflo(b.x), bfhi(b.x), bflo(b.y), bfhi(b.y), bflo(b.z), bfhi(b.z), bflo(b.w), bfhi(b.w)};
    float ss = 0.f;
#pragma unroll
    for (int j = 0; j < 4; ++j)
#pragma unroll
        for (int e = 0; e < 4; ++e) { const float o = xin[4 * j + e] + P.ga[j][e] * tot[4 * j + e]; tot[4 * j + e] = o; ss += o * o; }
    if (XNOUT) {
        GAS bf16* dp = F.XS + m * DM + k0;
        v4u w0, w1;
        w0.x = pk2(tot[0], tot[1]); w0.y = pk2(tot[2], tot[3]); w0.z = pk2(tot[4], tot[5]); w0.w = pk2(tot[6], tot[7]);
        w1.x = pk2(tot[8], tot[9]); w1.y = pk2(tot[10], tot[11]); w1.z = pk2(tot[12], tot[13]); w1.w = pk2(tot[14], tot[15]);
        *(GAS v4u*)dp = w0; *(GAS v4u*)(dp + 8) = w1;
        const float r = 1.0f / sqrtf(wave_sum(ss) * (1.f / DM) + 1e-6f);
        GAS bf16* xo = F.XN + m * DM + k0;
#pragma unroll
        for (int j = 0; j < 2; ++j) {
            float o[8];
#pragma unroll
            for (int e = 0; e < 8; ++e) { const int k = 8 * j + e; o[e] = tot[k] * r * P.ng[k >> 2][k & 3] * (1.f + P.nsc[k >> 2][k & 3]) + P.nsh[k >> 2][k & 3]; }
            v4u w; w.x = pk2(o[0], o[1]); w.y = pk2(o[2], o[3]); w.z = pk2(o[4], o[5]); w.w = pk2(o[6], o[7]);
            *(GAS v4u*)(xo + 8 * j) = w;
        }
    } else {
        GAS float* dp = dst_row + k0;
#pragma unroll
        for (int j = 0; j < 4; ++j) *(GAS f32x4*)(dp + 4 * j) = (f32x4){tot[4 * j], tot[4 * j + 1], tot[4 * j + 2], tot[4 * j + 3]};
    }
}
template <bool XNOUT, bool LDO = false>
__device__ __forceinline__ void peer_gather_v_idx(const Ctx& F, int l, size_t m, int i0, int i1, float wgt0, float wgt1, const GAS float* g2, GAS float* dst_row, const GAS float* ng, const GAS float* nsh, const GAS float* nsc, bool ns = false, float osc = 1.f) {
    const int lane = F.lane, q = lane & 31;
    const bool up = lane >= 32;
    const GAS unsigned char* V = F.V8 + (size_t)l * 16384 * V_ROWB;
    float acc[32];
#if VF16 && V_FP4
    if (!LDO) {
        const float sa = wave_sum(fabsf(wgt0) + fabsf(wgt1));
        int ke = 13 - (int)((__float_as_uint(sa * 6.0f) >> 23) & 0xff) + 127;
        ke = ke > 40 ? 40 : (ke < -40 ? -40 : ke);
        const float sc = __uint_as_float((unsigned)(127 + ke) << 23), isc = __uint_as_float((unsigned)(127 - ke) << 23);
        const float ws0 = __int_as_float(__builtin_bit_cast(int, __builtin_amdgcn_cvt_pkrtz(wgt0 * sc, wgt0 * sc))), ws1 = __int_as_float(__builtin_bit_cast(int, __builtin_amdgcn_cvt_pkrtz(wgt1 * sc, wgt1 * sc)));
        h2v ah[16];
#pragma unroll
        for (int k = 0; k < 16; ++k) ah[k] = (h2v){(_Float16)0.f, (_Float16)0.f};
        if (PROBE_VH && ns) {
        v4u ra[8], rb[8];
        pg_load<0, true>(ra, V, i0, i1, up, (unsigned)q);
        pg_load<1, true>(rb, V, i0, i1, up, (unsigned)q); pg_axpy_h<0, PROBE_VH>(ra, ws0, ws1, up, ah);
        pg_load<2, true>(ra, V, i0, i1, up, (unsigned)q); pg_axpy_h<1, PROBE_VH>(rb, ws0, ws1, up, ah);
        pg_load<3, true>(rb, V, i0, i1, up, (unsigned)q); pg_axpy_h<2, PROBE_VH>(ra, ws0, ws1, up, ah);
        pg_load<4, true>(ra, V, i0, i1, up, (unsigned)q); pg_axpy_h<3, PROBE_VH>(rb, ws0, ws1, up, ah);
        pg_load<5, true>(rb, V, i0, i1, up, (unsigned)q); pg_axpy_h<4, PROBE_VH>(ra, ws0, ws1, up, ah);
        pg_load<6, true>(ra, V, i0, i1, up, (unsigned)q); pg_axpy_h<5, PROBE_VH>(rb, ws0, ws1, up, ah);
        pg_load<7, true>(rb, V, i0, i1, up, (unsigned)q); pg_axpy_h<6, PROBE_VH>(ra, ws0, ws1, up, ah);
        pg_axpy_h<7, PROBE_VH>(rb, ws0, ws1, up, ah);
        } else {
        v4u ra[8], rb[8];
        pg_load<0, true>(ra, V, i0, i1, up, (unsigned)q);
        pg_load<1, true>(rb, V, i0, i1, up, (unsigned)q);
        pg_axpy_h<0>(ra, ws0, ws1, up, ah);
        pg_load<2, true>(ra, V, i0, i1, up, (unsigned)q); pg_axpy_h<1>(rb, ws0, ws1, up, ah);
        pg_load<3, true>(rb, V, i0, i1, up, (unsigned)q); pg_axpy_h<2>(ra, ws0, ws1, up, ah);
        pg_load<4, true>(ra, V, i0, i1, up, (unsigned)q); pg_axpy_h<3>(rb, ws0, ws1, up, ah);
        pg_load<5, true>(rb, V, i0, i1, up, (unsigned)q); pg_axpy_h<4>(ra, ws0, ws1, up, ah);
        pg_load<6, true>(ra, V, i0, i1, up, (unsigned)q); pg_axpy_h<5>(rb, ws0, ws1, up, ah);
        pg_load<7, true>(rb, V, i0, i1, up, (unsigned)q); pg_axpy_h<6>(ra, ws0, ws1, up, ah);
        pg_axpy_h<7>(rb, ws0, ws1, up, ah);
        }
#pragma unroll
        for (int k = 0; k < 16; ++k) { acc[2 * k] = (float)ah[k].x * isc; acc[2 * k + 1] = (float)ah[k].y * isc; }
        peer_v_finish<XNOUT>(F, m, acc, g2, dst_row, ng, nsh, nsc, ns, osc);
        return;
    }
#endif
#pragma unroll
    for (int k = 0; k < 32; ++k) acc[k] = 0.f;
    typename RowBuf<V_FP4 != 0>::T ra[8], rb[8];
    pg_load<0, V_FP4 != 0>(ra, V, i0, i1, up, (unsigned)q);
    pg_load<1, V_FP4 != 0>(rb, V, i0, i1, up, (unsigned)q); pg_axpy<0, V_FP4 != 0, LDO>(ra, wgt0, wgt1, up, acc);
    pg_load<2, V_FP4 != 0>(ra, V, i0, i1, up, (unsigned)q); pg_axpy<1, V_FP4 != 0, LDO>(rb, wgt0, wgt1, up, acc);
    pg_load<3, V_FP4 != 0>(rb, V, i0, i1, up, (unsigned)q); pg_axpy<2, V_FP4 != 0, LDO>(ra, wgt0, wgt1, up, acc);
    pg_load<4, V_FP4 != 0>(ra, V, i0, i1, up, (unsigned)q); pg_axpy<3, V_FP4 != 0, LDO>(rb, wgt0, wgt1, up, acc);
    pg_load<5, V_FP4 != 0>(rb, V, i0, i1, up, (unsigned)q); pg_axpy<4, V_FP4 != 0, LDO>(ra, wgt0, wgt1, up, acc);
    pg_load<6, V_FP4 != 0>(ra, V, i0, i1, up, (unsigned)q); pg_axpy<5, V_FP4 != 0, LDO>(rb, wgt0, wgt1, up, acc);
    pg_load<7, V_FP4 != 0>(rb, V, i0, i1, up, (unsigned)q); pg_axpy<6, V_FP4 != 0, LDO>(ra, wgt0, wgt1, up, acc);
    pg_axpy<7, V_FP4 != 0, LDO>(rb, wgt0, wgt1, up, acc);
    peer_v_finish<XNOUT>(F, m, acc, g2, dst_row, ng, nsh, nsc, ns, osc);
}
template <bool XNOUT>
__device__ __forceinline__ void peer_gather_v(const Ctx& F, int l, size_t m, float wgt0, float wgt1, const GAS float* g2, GAS float* dst_row, const GAS float* ng, const GAS float* nsh, const GAS float* nsc) {
    const GAS int* ip = F.IDX + m * 128;
    peer_gather_v_idx<XNOUT>(F, l, m, ip[F.lane], ip[64 + F.lane], wgt0, wgt1, g2, dst_row, ng, nsh, nsc);
}
template <int BT>
__device__ __forceinline__ float peer_gather_u_half(const Ctx& F, int l, size_t m) {
    const int lane = F.lane, q = lane & 31;
    const bool up = lane >= 32;
    const GAS int* ip = F.IDX + m * 128;
    const int i0 = ip[lane], i1 = ip[64 + lane];
    const float ga = F.GATE[m * 128 + BT * 64 + lane];
    const GAS unsigned char* U = F.U8 + (size_t)l * 16384 * U_ROWB;
    typename RowBuf<U_FP4 != 0>::T ra[8], rb[8];
    pg_load<4 * BT, U_FP4 != 0>(ra, U, i0, i1, up, (unsigned)q);
    unsigned h[16];
    { const GAS bf16* hp = F.XN + m * DM + 32 * q;
#pragma unroll
      for (int j = 0; j < 4; ++j) { const v4u w = ld16(hp + 8 * j); h[4 * j] = w.x; h[4 * j + 1] = w.y; h[4 * j + 2] = w.z; h[4 * j + 3] = w.w; } }
    f32x2 hf[16];
#pragma unroll
    for (int i = 0; i < 16; ++i) hf[i] = (f32x2){bflo(h[i]), bfhi(h[i])};
    const int ib = BT ? i1 : i0;
    const float su = F.SU[l * 16384 + ib], sv = F.SV[l * 16384 + ib];
    const int cl = (lane >> 4) & 1;
    float p[16]; float act = 0.f, tot;
    pg_load<4 * BT + 1, U_FP4 != 0>(rb, U, i0, i1, up, (unsigned)q); pg_dot<4 * BT, U_FP4 != 0>(ra, h, hf, p);
    pg_load<4 * BT + 2, U_FP4 != 0>(ra, U, i0, i1, up, (unsigned)q); pg_dot<4 * BT + 1, U_FP4 != 0>(rb, h, hf, p); tot = reduce16pairs(p, lane); act = (cl == 0) ? tot : act;
    pg_load<4 * BT + 3, U_FP4 != 0>(rb, U, i0, i1, up, (unsigned)q); pg_dot<4 * BT + 2, U_FP4 != 0>(ra, h, hf, p);
    pg_dot<4 * BT + 3, U_FP4 != 0>(rb, h, hf, p); tot = reduce16pairs(p, lane); act = (cl == 1) ? tot : act;
    return gelu_erf(act * su) * ga * sv;
}
template <int BT>
__device__ __forceinline__ void peer_gather_v_half(const Ctx& F, int l, size_t m, float wgt, float (&acc)[32]) {
    const int lane = F.lane, q = lane & 31;
    const bool up = lane >= 32;
    const GAS int* ip = F.IDX + m * 128;
    const int i0 = ip[lane], i1 = ip[64 + lane];
    const GAS unsigned char* V = F.V8 + (size_t)l * 16384 * V_ROWB;
#pragma unroll
    for (int k = 0; k < 32; ++k) acc[k] = 0.f;
    typename RowBuf<V_FP4 != 0>::T ra[8], rb[8];
    pg_load<4 * BT, V_FP4 != 0>(ra, V, i0, i1, up, (unsigned)q);
    pg_load<4 * BT + 1, V_FP4 != 0>(rb, V, i0, i1, up, (unsigned)q); pg_axpy<4 * BT, V_FP4 != 0>(ra, wgt, wgt, up, acc);
    pg_load<4 * BT + 2, V_FP4 != 0>(ra, V, i0, i1, up, (unsigned)q); pg_axpy<4 * BT + 1, V_FP4 != 0>(rb, wgt, wgt, up, acc);
    pg_load<4 * BT + 3, V_FP4 != 0>(rb, V, i0, i1, up, (unsigned)q); pg_axpy<4 * BT + 2, V_FP4 != 0>(ra, wgt, wgt, up, acc);
    pg_axpy<4 * BT + 3, V_FP4 != 0>(rb, wgt, wgt, up, acc);
}


typedef int v8i __attribute__((ext_vector_type(8)));
constexpr int UM_W = 0, UM_RB = (UMFMA == 2) ? 2048 : 4096, UM_RP = 528, UM_HB = UM_RB + 16 * UM_RP, UM_DBG = UM_HB + 2048;
constexpr int UM_STRIDE = (UMFMA == 2) ? 19456 : 16384;
template <int S>
__device__ __forceinline__ void um_consume(const v4u (&r)[8], LAS unsigned char* wl, const v4u (&bf)[8], float lsc, int lane, float& act0, float& act1, bool nowr = false) {
    constexpr int bt = S >> 2, cS = (S >> 1) & 1, sub = S & 1;
    const int q = lane & 31, up = lane >> 5;
    if (PROBE_UW && nowr) {
        unsigned x = 0;
#pragma unroll
        for (int k = 0; k < 8; ++k) x ^= r[k].x ^ r[k].y ^ r[k].z ^ r[k].w;
        if (x == 0x12345u) *(LAS unsigned*)(wl + UM_RB) = x;
    } else
#pragma unroll
    for (int k = 0; k < 8; ++k) *(LAS v4u*)(wl + UM_RB + (k + 8 * up) * UM_RP + 16 * q) = r[k];
    const int i = lane & 15, g = lane >> 4;
    f32x4 c0 = {0.f, 0.f, 0.f, 0.f}, c1 = {0.f, 0.f, 0.f, 0.f};
#pragma unroll
    for (int c = 0; c < 8; ++c) {
        const v4u a = *(LAS const v4u*)(wl + UM_RB + i * UM_RP + 64 * c + 16 * g);
        const v8i a8 = {(int)a.x, (int)a.y, (int)a.z, (int)a.w, 0, 0, 0, 0};
        const v8i b8 = {(int)bf[c].x, (int)bf[c].y, (int)bf[c].z, (int)bf[c].w, 0, 0, 0, 0};
        if (c & 1) c1 = __builtin_amdgcn_mfma_scale_f32_16x16x128_f8f6f4(a8, b8, c1, 4, 4, 0, 0x7F7F7F7F, 0, 0x7F7F7F7F);
        else       c0 = __builtin_amdgcn_mfma_scale_f32_16x16x128_f8f6f4(a8, b8, c0, 4, 4, 0, 0x7F7F7F7F, 0, 0x7F7F7F7F);
    }
    float t[4];
#pragma unroll
    for (int rr = 0; rr < 4; ++rr) { float x = (c0[rr] + c1[rr]) * lsc; x += DPP_XOR1(x); x += DPP_XOR2(x); t[rr] = x; }
    const int sel = lane & 3;
    const float v = sel == 0 ? t[0] : (sel == 1 ? t[1] : (sel == 2 ? t[2] : t[3]));
    const float tot = __shfl(v, 16 * (((lane & 7) >> 2) + 2 * (lane >> 5)) + (lane & 3));
    const bool mine = (((lane >> 4) & 1) == cS) && (((lane >> 3) & 1) == sub);
    if (bt == 0) act0 = mine ? tot : act0; else act1 = mine ? tot : act1;
}
__device__ __forceinline__ void peer_gather_u_mfma(const Ctx& F, int l, size_t m, LAS unsigned char* wl, float& wgt0, float& wgt1, int rm = -1) {
    const int lane = F.lane, q = lane & 31;
    const bool up = lane >= 32;
    const GAS int* ip = F.IDX + m * 128; const GAS float* gp = F.GATE + m * 128;
    const int i0 = ip[lane] & rm, i1 = ip[64 + lane] & rm;
    const float ga0 = gp[lane], ga1 = gp[64 + lane];
    const GAS unsigned char* U = F.U8 + (size_t)l * 16384 * U_ROWB;
    v4u ra[8], rb[8];
    pg_load<0, true>(ra, U, i0, i1, up, (unsigned)q);
    float s1;
    { const GAS bf16* hp = F.XN + m * DM + 16 * lane;
      const v4u w0 = ld16(hp), w1 = ld16(hp + 8);
      const unsigned ws[8] = {w0.x, w0.y, w0.z, w0.w, w1.x, w1.y, w1.z, w1.w};
      f32x2 rr[8]; float am = 0.f;
#pragma unroll
      for (int j = 0; j < 8; ++j) { rr[j] = (f32x2){bflo(ws[j]), bfhi(ws[j])}; am = fmaxf(am, fmaxf(fabsf(rr[j].x), fabsf(rr[j].y))); }
#pragma unroll
      for (int o = 32; o > 0; o >>= 1) am = fmaxf(am, __shfl_xor(am, o));
      s1 = am > 0.f ? am * (1.0f / 6.0f) : 1.0f;
      float sc = s1, inv = 1.0f / s1;
#pragma unroll
      for (int n = 0; n < 4; ++n) {
          unsigned pk0 = 0, pk1 = 0;
          const f32x2 inv2 = (f32x2){inv, inv}, sc2 = (f32x2){sc, sc};
#define UM_Q(PK, J, SEL) { const f32x2 tq = rr[J] * inv2; PK = __builtin_amdgcn_cvt_scalef32_pk_fp4_f32(PK, tq.x, tq.y, 1.0f, SEL); const f32x2 back = __builtin_amdgcn_cvt_scalef32_pk_f32_fp4(PK, 1.0f, SEL); rr[J] = rr[J] - back * sc2; }
          UM_Q(pk0, 0, 0) UM_Q(pk0, 1, 1) UM_Q(pk0, 2, 2) UM_Q(pk0, 3, 3) UM_Q(pk1, 4, 0) UM_Q(pk1, 5, 1) UM_Q(pk1, 6, 2) UM_Q(pk1, 7, 3)
#undef UM_Q
          *(LAS v2u*)(wl + UM_HB + n * 512 + 8 * lane) = (v2u){pk0, pk1};
          sc *= (1.0f / 6.0f); inv *= 6.0f;
      } }
    pg_load<1, true>(rb, U, i0, i1, up, (unsigned)q);
    const GAS float* SU = F.SU + l * 16384; const GAS float* SV = F.SV + l * 16384;
    const float su0 = SU[i0], sv0 = SV[i0], su1 = SU[i1], sv1 = SV[i1];
    v4u bf[8];
    { const int g = lane >> 4, n = lane & 3;
#pragma unroll
      for (int c = 0; c < 8; ++c) bf[c] = *(LAS const v4u*)(wl + UM_HB + n * 512 + 64 * c + 16 * g); }
    const int nn = lane & 15;
    const float lsc = nn == 0 ? s1 : (nn == 1 ? s1 * (1.0f / 6.0f) : (nn == 2 ? s1 * (1.0f / 36.0f) : (nn == 3 ? s1 * (1.0f / 216.0f) : 0.f)));
    float act0 = 0.f, act1 = 0.f;
    um_consume<0>(ra, wl, bf, lsc, lane, act0, act1, rm == 0x7fffffff);
    pg_load<2, true>(ra, U, i0, i1, up, (unsigned)q); um_consume<1>(rb, wl, bf, lsc, lane, act0, act1, rm == 0x7fffffff);
    pg_load<3, true>(rb, U, i0, i1, up, (unsigned)q); um_consume<2>(ra, wl, bf, lsc, lane, act0, act1, rm == 0x7fffffff);
    pg_load<4, true>(ra, U, i0, i1, up, (unsigned)q); um_consume<3>(rb, wl, bf, lsc, lane, act0, act1, rm == 0x7fffffff);
    pg_load<5, true>(rb, U, i0, i1, up, (unsigned)q); um_consume<4>(ra, wl, bf, lsc, lane, act0, act1, rm == 0x7fffffff);
    pg_load<6, true>(ra, U, i0, i1, up, (unsigned)q); um_consume<5>(rb, wl, bf, lsc, lane, act0, act1, rm == 0x7fffffff);
    pg_load<7, true>(rb, U, i0, i1, up, (unsigned)q); um_consume<6>(ra, wl, bf, lsc, lane, act0, act1, rm == 0x7fffffff);
    um_consume<7>(rb, wl, bf, lsc, lane, act0, act1, rm == 0x7fffffff);
    wgt0 = gelu_erf(act0 * su0) * ga0 * sv0;
    wgt1 = gelu_erf(act1 * su1) * ga1 * sv1;
}

__device__ __forceinline__ void um_h_to_lds(const v4u& w0, const v4u& w1, LAS unsigned char* wl, int lane, float& s1) {
    const unsigned ws[8] = {w0.x, w0.y, w0.z, w0.w, w1.x, w1.y, w1.z, w1.w};
    f32x2 rr[8]; float am = 0.f;
#pragma unroll
    for (int j = 0; j < 8; ++j) { rr[j] = (f32x2){bflo(ws[j]), bfhi(ws[j])}; am = fmaxf(am, fmaxf(fabsf(rr[j].x), fabsf(rr[j].y))); }
#pragma unroll
    for (int o = 32; o > 0; o >>= 1) am = fmaxf(am, __shfl_xor(am, o));
    s1 = am > 0.f ? am * (1.0f / 6.0f) : 1.0f;
    float sc = s1, inv = 1.0f / s1;
#pragma unroll
    for (int n = 0; n < 4; ++n) {
        unsigned pk0 = 0, pk1 = 0;
        const f32x2 inv2 = (f32x2){inv, inv}, sc2 = (f32x2){sc, sc};
#define UM_Q(PK, J, SEL) { const f32x2 tq = rr[J] * inv2; PK = __builtin_amdgcn_cvt_scalef32_pk_fp4_f32(PK, tq.x, tq.y, 1.0f, SEL); const f32x2 back = __builtin_amdgcn_cvt_scalef32_pk_f32_fp4(PK, 1.0f, SEL); rr[J] = rr[J] - back * sc2; }
        UM_Q(pk0, 0, 0) UM_Q(pk0, 1, 1) UM_Q(pk0, 2, 2) UM_Q(pk0, 3, 3) UM_Q(pk1, 4, 0) UM_Q(pk1, 5, 1) UM_Q(pk1, 6, 2) UM_Q(pk1, 7, 3)
#undef UM_Q
        *(LAS v2u*)(wl + UM_HB + n * 512 + 8 * lane) = (v2u){pk0, pk1};
        sc *= (1.0f / 6.0f); inv *= 6.0f;
    }
}
template <bool WBF16>
__device__ __forceinline__ void peer_u_pass_mfma_stream(const Ctx& F, int l, int Mown, int gw, int ngw, LAS unsigned char* wl) {
    const int lane = F.lane, q = lane & 31;
    const bool up = lane >= 32;
    const int ntok = gw < Mown ? (Mown - gw + ngw - 1) / ngw : 0;
    if (ntok == 0) return;
    const GAS unsigned char* U = F.U8 + (size_t)l * 16384 * U_ROWB;
    const GAS float* SU = F.SU + l * 16384; const GAS float* SV = F.SV + l * 16384;
    v4u b0[8], b1[8], b2[8], b3[8];
    size_t m = (size_t)gw;
    int ci0 = F.IDX[m * 128 + lane], ci1 = F.IDX[m * 128 + 64 + lane];
    pg_load<0, true>(b0, U, ci0, ci1, up, (unsigned)q); pg_load<1, true>(b1, U, ci0, ci1, up, (unsigned)q); pg_load<2, true>(b2, U, ci0, ci1, up, (unsigned)q);
    v4u hA = ld16(F.XN + m * DM + 16 * lane), hB = ld16(F.XN + m * DM + 16 * lane + 8);
    float ga0 = F.GATE[m * 128 + lane], ga1 = F.GATE[m * 128 + 64 + lane];
    float su0 = SU[ci0], sv0 = SV[ci0], su1 = SU[ci1], sv1 = SV[ci1];
#pragma unroll 1
    for (int t = 0; t < ntok; ++t) {
        const bool has_next = t + 1 < ntok;
        const size_t mn = m + (size_t)ngw;
        int ni0 = ci0, ni1 = ci1;
        if (has_next) { ni0 = F.IDX[mn * 128 + lane]; ni1 = F.IDX[mn * 128 + 64 + lane]; }
        float s1;
        um_h_to_lds(hA, hB, wl, lane, s1);
        v4u bf[8];
        { const int g = lane >> 4, n = lane & 3;
#pragma unroll
          for (int c = 0; c < 8; ++c) bf[c] = *(LAS const v4u*)(wl + UM_HB + n * 512 + 64 * c + 16 * g); }
        const int nn = lane & 15;
        const float lsc = nn == 0 ? s1 : (nn == 1 ? s1 * (1.0f / 6.0f) : (nn == 2 ? s1 * (1.0f / 36.0f) : (nn == 3 ? s1 * (1.0f / 216.0f) : 0.f)));
        float act0 = 0.f, act1 = 0.f;
        pg_load<3, true>(b3, U, ci0, ci1, up, (unsigned)q); um_consume<0>(b0, wl, bf, lsc, lane, act0, act1);
        pg_load<4, true>(b0, U, ci0, ci1, up, (unsigned)q); um_consume<1>(b1, wl, bf, lsc, lane, act0, act1);
        pg_load<5, true>(b1, U, ci0, ci1, up, (unsigned)q); um_consume<2>(b2, wl, bf, lsc, lane, act0, act1);
        pg_load<6, true>(b2, U, ci0, ci1, up, (unsigned)q); um_consume<3>(b3, wl, bf, lsc, lane, act0, act1);
        float nga0 = 0.f, nga1 = 0.f, nsu0 = 0.f, nsv0 = 0.f, nsu1 = 0.f, nsv1 = 0.f;
        if (has_next) {
            hA = ld16(F.XN + mn * DM + 16 * lane); hB = ld16(F.XN + mn * DM + 16 * lane + 8);
            nga0 = F.GATE[mn * 128 + lane]; nga1 = F.GATE[mn * 128 + 64 + lane];
            nsu0 = SU[ni0]; nsv0 = SV[ni0]; nsu1 = SU[ni1]; nsv1 = SV[ni1];
        }
        pg_load<7, true>(b3, U, ci0, ci1, up, (unsigned)q); um_consume<4>(b0, wl, bf, lsc, lane, act0, act1);
        if (has_next) pg_load<0, true>(b0, U, ni0, ni1, up, (unsigned)q);
        um_consume<5>(b1, wl, bf, lsc, lane, act0, act1);
        if (has_next) pg_load<1, true>(b1, U, ni0, ni1, up, (unsigned)q);
        um_consume<6>(b2, wl, bf, lsc, lane, act0, act1);
        if (has_next) pg_load<2, true>(b2, U, ni0, ni1, up, (unsigned)q);
        um_consume<7>(b3, wl, bf, lsc, lane, act0, act1);
        const float w0 = gelu_erf(act0 * su0) * ga0 * sv0, w1 = gelu_erf(act1 * su1) * ga1 * sv1;
        if (WBF16) { ((LAS unsigned short*)(wl + UM_W))[t * 128 + lane] = (unsigned short)f2bf(w0); ((LAS unsigned short*)(wl + UM_W))[t * 128 + 64 + lane] = (unsigned short)f2bf(w1); }
        else { ((LAS float*)(wl + UM_W))[t * 128 + lane] = w0; ((LAS float*)(wl + UM_W))[t * 128 + 64 + lane] = w1; }
        ci0 = ni0; ci1 = ni1; ga0 = nga0; ga1 = nga1; su0 = nsu0; sv0 = nsv0; su1 = nsu1; sv1 = nsv1; m = mn;
    }
}
#ifndef MK_N_LAUNCHES
#define MK_N_LAUNCHES 1
#endif
constexpr int NPH = 21;
#ifndef GEMM_ALIGN
#define GEMM_ALIGN true
#endif
#ifndef GEMM_SP2
#define GEMM_SP2 true
#endif
__host__ __device__ constexpr int rep_of(int k) { return ((PROBE_MASK >> k) & 1) ? PROBE_N : 1; }
constexpr int LDS_BYTES = 163840;
constexpr int LDSCTL_OFF = 155648, MISC_OFF = LDSCTL_OFF + 320;
struct Args { const float* in[23]; float* out; unsigned char* ws; int ph_lo, ph_hi; };


#define CAS __attribute__((address_space(4)))
__device__ __forceinline__ Ctx make_ctx(const CAS Args* ap, LAS unsigned char* lds) {
    Ctx F;
    F.lds = lds;
    { int t_ = threadIdx.x; asm volatile("" : "+v"(t_)); F.tid = t_; } F.lane = F.tid & 63; F.wave = __builtin_amdgcn_readfirstlane(F.tid >> 6);
    F.G = gridDim.x;
    { int bx = blockIdx.x; asm volatile("" : "+s"(bx)); const int vcu = (F.G % 8 == 0) ? (bx % 8) * (F.G / 8) + bx / 8 : bx; F.gw = vcu * NWAVES + F.wave; F.ngw = F.G * NWAVES; }
#define GIN(i) ((const GAS float*)ap->in[i])
    F.x = GIN(0); F.c = GIN(1); F.ctx = GIN(2); F.c_ctx = GIN(3); F.mod_w = GIN(4); F.mod_b = GIN(5); F.norm1_g = GIN(6); F.norm2_g = GIN(7);
    F.ab_w_in = GIN(8); F.ab_w_out = GIN(9); F.na_q_norm = GIN(10); F.na_k_norm = GIN(11); F.na_rpb = GIN(12); F.ret_log_decay = GIN(13);
    F.swa_w_in = GIN(14); F.swa_w_out = GIN(15); F.swa_q_norm = GIN(16); F.swa_k_norm = GIN(17); F.swa_sink = GIN(18);
    F.peer_w_q = GIN(19); F.peer_sub_keys = GIN(20); F.peer_u = GIN(21); F.peer_v = GIN(22);
#undef GIN
    F.out = (GAS float*)ap->out;
    GAS unsigned char* ws = (GAS unsigned char*)ap->ws;
    F.MOD = (GAS float*)(ws + WS_MOD); F.ROPE = (GAS float*)(ws + WS_ROPE); F.SUBK = (GAS bf16*)(ws + WS_SUBK);
    F.WIN0 = (GAS bf16*)(ws + WS_WIN0); F.WOUT0 = (GAS bf16*)(ws + WS_WOUT0); F.WQ0 = (GAS bf16*)(ws + WS_WQ0); F.WIN1 = (GAS bf16*)(ws + WS_WIN1); F.WOUT1 = (GAS bf16*)(ws + WS_WOUT1); F.WQ1 = (GAS bf16*)(ws + WS_WQ1);
    F.U8 = ws + WS_U; F.V8 = ws + WS_V; F.SU = (GAS float*)(ws + WS_SU); F.SV = (GAS float*)(ws + WS_SV); F.XN = (GAS bf16*)(ws + WS_XN); F.XS = (GAS bf16*)(ws + WS_XS); F.P = (GAS bf16*)(ws + WS_P); F.Q2 = (GAS bf16*)(ws + WS_Q2);
    F.IDX = (GAS int*)(ws + WS_IDX); F.GATE = (GAS float*)(ws + WS_GATE); F.TAV = (GAS bf16*)(ws + WS_TAV); F.TBK = (GAS bf16*)(ws + WS_TBK); F.TBV = (GAS bf16*)(ws + WS_TBV);
    F.KV = (GAS float*)(ws + WS_KV); F.ST = (GAS bf16*)(ws + WS_ST);
    return F;
}
#define PHASE_CTX const CAS Args* ap_ = (const CAS Args*)__builtin_amdgcn_kernarg_segment_ptr(); asm volatile("" : "+s"(ap_)); const Ctx F = make_ctx(ap_, (LAS unsigned char*)lds_raw); \
    LAS unsigned char* wl = F.lds + F.wave * 16384; (void)wl;

template <int L> __device__ __forceinline__ void peer_phases(int lo, int hi, unsigned char* lds_raw, const XcdBarrier& bar);
__device__ __forceinline__ void peer_front(int L, int lo, int hi, unsigned char* lds_raw, const XcdBarrier& bar);

__global__ void __launch_bounds__(NTHR, 2) mk_fwd(Args args) {
    extern __shared__ __attribute__((aligned(16))) unsigned char lds_raw[];
    for (int u = threadIdx.x; u < (LDS_BYTES - LDSCTL_OFF) / 4; u += NTHR) ((LAS unsigned*)((LAS unsigned char*)lds_raw + LDSCTL_OFF))[u] = 0u;
    __syncthreads();
    const int lo = args.ph_lo, hi = args.ph_hi;
    const bool multi = (hi - lo) > 1;
    XcdBarrier bar; bar.bar = (unsigned*)(args.ws + WS_CTL) + CW_BAR; bar.x = 0; bar.st = nullptr;
    if (multi) bar = xcd_barrier_post((unsigned*)(args.ws + WS_CTL) + CW_BAR, (volatile LAS unsigned*)((LAS unsigned char*)lds_raw + MISC_OFF) + 8);
#define IN(k) (lo <= (k) && (k) < hi)
#define SEAM(k) do { if (IN(k) && IN((k) + 1)) { xcd_barrier(bar); if (PROBE_BAR) { xcd_barrier(bar); xcd_barrier(bar); } } } while (0)

    if (IN(0)) for (int rep_ = 0; rep_ < rep_of(0); ++rep_) { PHASE_CTX p0_prologue(F); }
    SEAM(0);
    if (IN(1)) for (int rep_ = 0; rep_ < rep_of(1); ++rep_) { PHASE_CTX mod_phase<false>(F, F.x, F.ctx, MALL, F.norm1_g, F.MOD, 0, 1); }
    SEAM(1);
    if (IN(2)) for (int rep_ = 0; rep_ < rep_of(2); ++rep_) { PHASE_CTX pg8::Gemm g{F.XN, F.WIN0, MALL, AB_IN, DM}; pg8::StaticOrder S; S.init(MALL, AB_IN, F.G, (int)blockIdx.x);
        pg8::EpiBf16<0> E{F.P, AB_IN, nullptr, 0, 0, 1.f};
        pg8::gemm_phase<pg8::EpiBf16<0>, pg8::StaticOrder, GEMM_ALIGN, GEMM_SP2>(F.lds, g, S, E);
        if (rep_ == 0) { int ns; const int sl = idle_slot((MALL / 256) * (AB_IN / 256), F.G, (int)blockIdx.x, ns); if (sl >= 0) side_transposes(F, sl, ns); } }
    SEAM(2);
    if (IN(3)) for (int rep_ = 0; rep_ < rep_of(3); ++rep_) { PHASE_CTX
        post_stage_rope(F);
        for (int it = F.gw; it < 272 * 48; it += F.ngw) {
            const int tt = it / 48, s = it % 48, kind = s >> 3, hd = s & 7;
            PostSlot S;
            S.col = kind * 512 + hd * 64; S.nheads = 8; S.head = hd; S.nw = nullptr; S.rope = 0; S.scale = 1.f; S.tdst = nullptr; S.write_nat = 1;
            if (kind == 0) { S.nw = F.na_q_norm; S.scale = 0.125f; }
            else if (kind == 1) { S.nw = F.na_k_norm; }
            else if (kind == 2) { S.tdst = F.TAV; S.write_nat = 0; }
            else if (kind == 3) { S.rope = 1; S.scale = 0.125f; }
            else if (kind == 4) { S.rope = 1; S.tdst = F.TBK; }
            else { S.tdst = F.TBV; S.write_nat = 0; }
            post_item(F, F.P, AB_IN, tt, S, wl);
        } }
    SEAM(3);
    if (IN(4)) for (int rep_ = 0; rep_ < rep_of(4); ++rep_) { PHASE_CTX
        na_phase(F);
        for (int v = F.gw; v < 2176; v += F.ngw) { const int dir = v & 1, pf = (v >> 1) % 34, bh = (v >> 1) / 34; ret_r1_unit(F, bh, pf, dir); }
        }
    SEAM(4);
    if (IN(5)) for (int rep_ = 0; rep_ < rep_of(5); ++rep_) { PHASE_CTX ret_r2(F); }
    SEAM(5);
    if (IN(6)) for (int rep_ = 0; rep_ < rep_of(6); ++rep_) { PHASE_CTX ret_r3_phase(F); }
    SEAM(6);
    if (IN(7)) for (int rep_ = 0; rep_ < rep_of(7); ++rep_) { PHASE_CTX pg8::Gemm g{F.XN, F.WOUT0, MALL, DM, DM}; pg8::StaticOrder S; S.init(MALL, DM, F.G, (int)blockIdx.x);
        pg8::EpiRes<false> E{F.x, F.ctx, F.XS, F.MOD + 2 * 1024};
        pg8::gemm_phase<pg8::EpiRes<false>, pg8::StaticOrder, GEMM_ALIGN, GEMM_SP2>(F.lds, g, S, E);
        if (rep_ == 0) side_convert(F, 0); }
    SEAM(7);
    peer_phases<0>(lo, hi, lds_raw, bar);
    SEAM(11);
    if (IN(13)) for (int rep_ = 0; rep_ < rep_of(13); ++rep_) { PHASE_CTX pg8::Gemm g{F.XN, F.WIN1, MALL, SWA_IN, DM}; pg8::StaticOrder S; S.init(MALL, SWA_IN, F.G, (int)blockIdx.x);
        pg8::EpiBf16<0> E{F.P, SWA_IN, nullptr, 0, 0, 1.f};
        pg8::gemm_phase<pg8::EpiBf16<0>, pg8::StaticOrder, GEMM_ALIGN, GEMM_SP2>(F.lds, g, S, E);
        if (CONV3 && rep_ == 0) side_convert(F, 2); }
    SEAM(13);
    if (IN(14)) for (int rep_ = 0; rep_ < rep_of(14); ++rep_) { PHASE_CTX
        post_stage_rope(F);
        for (int it = F.gw; it < 272 * 24; it += F.ngw) {
            const int tt = it / 24, s = it % 24;
            PostSlot S;
            S.col = s * 64; S.nheads = 4; S.head = s & 3; S.nw = nullptr; S.rope = 0; S.scale = 1.f; S.tdst = nullptr; S.write_nat = 1;
            if (s < 16) { S.nw = F.swa_q_norm; S.rope = 1; S.scale = 0.125f; }
            else if (s < 20) { S.nw = F.swa_k_norm; S.rope = 1; }
            else { S.tdst = F.TAV; S.write_nat = 0; }
            post_item(F, F.P, SWA_IN, tt, S, wl);
        } }
    SEAM(14);
    if (IN(15)) for (int rep_ = 0; rep_ < rep_of(15); ++rep_) { PHASE_CTX swa_phase(F); }
    SEAM(15);
    if (IN(16)) for (int rep_ = 0; rep_ < rep_of(16); ++rep_) { PHASE_CTX pg8::Gemm g{F.XN, F.WOUT1, MLAT, DM, DM}; pg8::StaticOrder S; S.init(MLAT, DM, F.G, (int)blockIdx.x);
        pg8::EpiRes<true> E{nullptr, nullptr, F.XS, F.MOD + 5 * MODW + 2 * 1024};
        pg8::gemm_phase<pg8::EpiRes<true>, pg8::StaticOrder, GEMM_ALIGN, GEMM_SP2>(F.lds, g, S, E); }
    SEAM(16);
    peer_phases<1>(lo, hi, lds_raw, bar);
}
template <int L> __device__ __forceinline__ void peer_phases(int lo, int hi, unsigned char* lds_raw, const XcdBarrier& bar) {
    constexpr int q0 = L == 0 ? 8 : 17;
    constexpr int Mp = L == 0 ? MALL : MLAT;
    if (IN(q0)) for (int rep_ = 0; rep_ < rep_of(q0); ++rep_) { PHASE_CTX mod_phase<true>(F, nullptr, nullptr, Mp, F.norm2_g + (size_t)L * DM, F.MOD + (size_t)L * 5 * MODW, 3, 4); }
    SEAM(q0);
    if (IN(q0 + 1)) for (int rep_ = 0; rep_ < rep_of(q0 + 1); ++rep_) { PHASE_CTX pg8::Gemm g{F.XN, L == 0 ? F.WQ0 : F.WQ1, Mp, PQD, DM}; pg8::StaticOrder S; S.init(Mp, PQD, F.G, (int)blockIdx.x);
        pg8::EpiQfrag E{F.Q2};
        pg8::gemm_phase<pg8::EpiQfrag, pg8::StaticOrder, GEMM_ALIGN, GEMM_SP2>(F.lds, g, S, E);
        if (L == 0 && rep_ == 0) side_convert(F, 1); }
    SEAM(q0 + 1);
    if (IN(q0 + 2)) for (int rep_ = 0; rep_ < rep_of(q0 + 2); ++rep_) { PHASE_CTX peer_score_phase(F, L, Mp); }
    SEAM(q0 + 2);
    if (IN(q0 + 3)) for (int rep_ = 0; rep_ < rep_of(q0 + 3); ++rep_) { PHASE_CTX
        const GAS float* mod_l = F.MOD + (size_t)L * 5 * MODW;
        const bool part_ = true; const int gw_ = F.gw, ngw_ = F.ngw;
        if (part_) {
        LAS float* wsl = (LAS float*)wl;
        const bool shared4 = (L == 0) && (F.G == 256) && (PROBE_HALF == 0);
        const int Mown = shared4 ? MLAT : Mp;
        const int rm_ = (PROBE_RM && rep_) ? PROBE_RM : -1;
        const bool ns_ = (PROBE_RM || PROBE_VH) && rep_;
        for (int mb_ = gw_; mb_ < Mown; mb_ += ((UMFMA == 1) ? 8 : 4096) * ngw_) {
        const int me_ = (UMFMA == 1 && Mown - mb_ > 8 * ngw_) ? mb_ + 8 * ngw_ : Mown;
        { int nt = 0;
          for (int m = mb_; m < me_; m += ngw_, ++nt) { float w0, w1; peer_gather_u_mfma(F, L, (size_t)m, wl, w0, w1);
            wsl[nt * 128 + F.lane] = w0; wsl[nt * 128 + 64 + F.lane] = w1; } }
        LDS_WAIT();
        { int nt = 0;
          for (int m = mb_; m < me_; m += ngw_, ++nt) {
            const int cond = m < MLAT ? (m >> 12) : 4;
            const float w0 = wsl[nt * 128 + F.lane], w1 = wsl[nt * 128 + 64 + F.lane];
            const int vi0 = F.IDX[(size_t)m * 128 + F.lane] & rm_, vi1 = F.IDX[(size_t)m * 128 + 64 + F.lane] & rm_;
            if (L == 0) {
                const GAS float* mod1 = F.MOD + (size_t)5 * MODW + (size_t)cond * MODW;
                peer_gather_v_idx<true>(F, L, (size_t)m, vi0, vi1, w0, w1, mod_l + (size_t)cond * MODW + 5 * 1024, nullptr, F.norm1_g + DM, mod1, mod1 + 1024, ns_);
            } else {
                peer_gather_v_idx<false>(F, L, (size_t)m, vi0, vi1, w0, w1, mod_l + (size_t)cond * MODW + 5 * 1024, F.out + (size_t)m * DM, nullptr, nullptr, nullptr, ns_);
            }
          } }
        LDS_WAIT();
        }
        if (L == 0 && shared4) {
            const int vcu = F.gw >> 3, j = F.wave >> 1, bt = F.wave & 1;
            const size_t m = (size_t)MLAT + (size_t)vcu * 4 + j;
            float acc[32];
            if (bt == 0) { const float w = peer_gather_u_half<0>(F, L, m); peer_gather_v_half<0>(F, L, m, w, acc); }
            else { const float w = peer_gather_u_half<1>(F, L, m); peer_gather_v_half<1>(F, L, m, w, acc); }
            LAS float* xch = (LAS float*)(F.lds + (2 * j + 1) * 16384 + 8192);
            if (bt == 1) {
#pragma unroll
                for (int k = 0; k < 32; ++k) xch[k * 64 + F.lane] = acc[k];
            }
            __syncthreads();
            if (bt == 0) {
#pragma unroll
                for (int k = 0; k < 32; ++k) acc[k] += xch[k * 64 + F.lane];
                const GAS float* mod1 = F.MOD + (size_t)5 * MODW + (size_t)4 * MODW;
                peer_v_finish<true>(F, m, acc, mod_l + (size_t)4 * MODW + 5 * 1024, nullptr, F.norm1_g + DM, mod1, mod1 + 1024);
            }
        }
        }

    }
}
#undef IN
#undef SEAM

extern "C" void kernel_launch(void* const* d_in, const int* in_sizes, int n_in, void* d_out, int out_size, void* d_ws, size_t ws_size, hipStream_t stream) {
    static int grid = 0;
    if (grid == 0) {
        if (n_in != 23 || out_size != MLAT * DM || ws_size < WS_END) { fprintf(stderr, "kernel_launch: unexpected shapes (n_in %d, out %d, ws %zu); nothing launched\n", n_in, out_size, ws_size); grid = -1; return; }
        int dev = 0, cus = 0, per_cu = 0;
        if (hipGetDevice(&dev) != hipSuccess || hipDeviceGetAttribute(&cus, hipDeviceAttributeMultiprocessorCount, dev) != hipSuccess) { grid = -1; return; }
        if (hipFuncSetAttribute((const void*)mk_fwd, hipFuncAttributeMaxDynamicSharedMemorySize, LDS_BYTES) != hipSuccess) { fprintf(stderr, "kernel_launch: hipFuncSetAttribute failed\n"); grid = -1; return; }
        if (hipOccupancyMaxActiveBlocksPerMultiprocessor(&per_cu, (const void*)mk_fwd, NTHR, LDS_BYTES) != hipSuccess || per_cu < 1) { fprintf(stderr, "kernel_launch: occupancy query says %d\n", per_cu); }
        (void)hipGetLastError();
        grid = cus;
    }
    if (grid < 0) return;
    (void)hipMemsetAsync((char*)d_ws + WS_CTL, 0, CTL_ZERO_BYTES, stream);
    Args a{};
    for (int i = 0; i < 23; ++i) a.in[i] = (const float*)d_in[i];
    a.out = (float*)d_out; a.ws = (unsigned char*)d_ws;
#if MK_N_LAUNCHES == 1
    a.ph_lo = 0; a.ph_hi = NPH;
    hipLaunchKernelGGL(mk_fwd, dim3(grid), dim3(NTHR), LDS_BYTES, stream, a);
#else
    for (int p = 0; p < NPH; ++p) { a.ph_lo = p; a.ph_hi = p + 1; hipLaunchKernelGGL(mk_fwd, dim3(grid), dim3(NTHR), LDS_BYTES, stream, a); }
#endif
}
```
